# Optimizing an MI355X kernel written in HIP

```python
import math
import jax, jax.numpy as jnp
from jax import lax
import numpy as np

D_MODEL = 1024
BATCH = 4
SEQ = 8192
DEPTH = 4

N_MIXERS = 3
N_LAYERS_A = (DEPTH + 2) // 3
N_LAYERS_B = (DEPTH + 1) // 3
N_LAYERS_C = DEPTH // 3

A_HEADS = 8
A_DK = 128
A_DV = 128
A_QK_W = A_HEADS * A_DK
A_V_W = A_HEADS * A_DV
A_CONV = 4
A_CHUNK = 64
A_IN_W = 2 * A_QK_W + 2 * A_V_W + 2 * A_HEADS

B_DH = 64
B_HEADS = D_MODEL // (2 * B_DH)
B_BLOCK = 128
REL_BUCKETS = 32
REL_MAX_DIST = 128

C_CHUNK = 128
C_HALF = 2 * D_MODEL
C_GROUPS = 8
C_GW = C_HALF // C_GROUPS

N_EXPERTS = 16
N_GROUPS = 4
EXPERTS_PER_GROUP = N_EXPERTS // N_GROUPS
TOP_K = 2
D_EXPERT = 512

DN_ALPHA = (2 * DEPTH) ** 0.25
DN_BETA = (8 * DEPTH) ** -0.25
EPS = 1e-5

kernel_name = "hybrid_deltanet_diffattn_gmlp_groupmoe"


def layer_norm(x, g, b):
    xf = x.astype(jnp.float32)
    mu = jnp.mean(xf, -1, keepdims=True)
    var = jnp.mean(jnp.square(xf - mu), -1, keepdims=True)
    return ((xf - mu) * lax.rsqrt(var + EPS) * g + b).astype(x.dtype)


def rms_norm(x, g):
    xf = x.astype(jnp.float32)
    return (xf * lax.rsqrt(jnp.mean(xf * xf, -1, keepdims=True) + EPS) * g).astype(x.dtype)


def l2norm(x):
    xf = x.astype(jnp.float32)
    return xf * lax.rsqrt(jnp.sum(xf * xf, -1, keepdims=True) + 1e-6)


def causal_short_conv(x, w):
    kw = w.shape[0]
    s = x.shape[1]
    xp = jnp.pad(x, ((0, 0), (kw - 1, 0), (0, 0)))
    y = xp[:, 0:s] * w[0]
    for j in range(1, kw):
        y = y + xp[:, j:j + s] * w[j]
    return y


def gated_delta_rule(q, k, v, g, beta):
    b, s, h, dk = q.shape
    dv = v.shape[-1]
    c = A_CHUNK
    n = s // c
    f32 = jnp.float32

    def to_chunks(t):
        t = t.astype(f32).reshape((b, n, c, h) + t.shape[3:])
        return jnp.moveaxis(t, 3, 1)

    q = to_chunks(q) * dk ** -0.5
    k = to_chunks(k)
    v = to_chunks(v)
    beta = to_chunks(beta)
    g = jnp.cumsum(to_chunks(g), axis=-1)
    idx = jnp.arange(c)
    causal = idx[:, None] >= idx[None, :]
    strict = idx[:, None] > idx[None, :]
    decay = jnp.exp(jnp.where(causal, g[..., :, None] - g[..., None, :], -jnp.inf))
    kb = k * beta[..., None]
    a_mat = jnp.where(strict, jnp.einsum('bhncd,bhnmd->bhncm', kb, k) * decay, 0.0)
    rhs = jnp.concatenate([v * beta[..., None], kb * jnp.exp(g)[..., None]], axis=-1)
    sol = lax.linalg.triangular_solve(a_mat + jnp.eye(c, dtype=f32), rhs,
                                      left_side=True, lower=True, unit_diagonal=True)
    u, w = sol[..., :dv], sol[..., dv:]
    attn = jnp.einsum('bhncd,bhnmd->bhncm', q, k) * decay
    q_dec = q * jnp.exp(g)[..., None]
    g_last = g[..., -1]
    k_dec = k * jnp.exp(g_last[..., None] - g)[..., None]

    def step(state, xs):
        attn_c, qd, kd, u_c, w_c, gl = xs
        v_new = u_c - jnp.einsum('bhck,bhkv->bhcv', w_c, state)
        o = jnp.einsum('bhck,bhkv->bhcv', qd, state) + jnp.einsum('bhcm,bhmv->bhcv', attn_c, v_new)
        state = state * jnp.exp(gl)[..., None, None] + jnp.einsum('bhck,bhcv->bhkv', kd, v_new)
        return state, o

    xs = tuple(jnp.moveaxis(t, 2, 0) for t in (attn, q_dec, k_dec, u, w, g_last))
    s0 = jnp.zeros((b, h, dk, dv), f32)
    _, o = lax.scan(step, s0, xs)
    return jnp.transpose(o, (1, 0, 3, 2, 4)).reshape(b, s, h, dv)


def gated_deltanet_mixer(x, w_in, conv_w, a_log, dt_bias, norm_g, w_out):
    b, s, _ = x.shape
    proj = x @ w_in
    qkv, gate, a_raw, b_raw = jnp.split(
        proj, [2 * A_QK_W + A_V_W, 2 * A_QK_W + 2 * A_V_W, 2 * A_QK_W + 2 * A_V_W + A_HEADS], axis=-1)
    qkv = jax.nn.silu(causal_short_conv(qkv, conv_w))
    q, k, v = jnp.split(qkv, [A_QK_W, 2 * A_QK_W], axis=-1)
    q = l2norm(q.reshape(b, s, A_HEADS, A_DK))
    k = l2norm(k.reshape(b, s, A_HEADS, A_DK))
    v = v.reshape(b, s, A_HEADS, A_DV)
    g = -jnp.exp(a_log.astype(jnp.float32)) * jax.nn.softplus(a_raw.astype(jnp.float32) + dt_bias)
    beta = jax.nn.sigmoid(b_raw.astype(jnp.float32))
    o = gated_delta_rule(q, k, v, g, beta)
    o = rms_norm(o, norm_g) * jax.nn.silu(gate.reshape(b, s, A_HEADS, A_DV).astype(jnp.float32))
    return o.reshape(b, s, A_V_W).astype(x.dtype) @ w_out


def rel_position_bucket(rel):
    n = jnp.maximum(rel, 0)
    max_exact = REL_BUCKETS // 2
    large = max_exact + (jnp.log(jnp.maximum(n, 1).astype(jnp.float32) / max_exact)
                         / math.log(REL_MAX_DIST / max_exact) * (REL_BUCKETS - max_exact)).astype(jnp.int32)
    large = jnp.minimum(large, REL_BUCKETS - 1)
    return jnp.where(n < max_exact, n, large)


def diff_attention_mixer(x, w_in, lam, norm_g, w_out, rel_bias, lambda_init):
    b, s, _ = x.shape
    q, k, v = jnp.split(x @ w_in, 3, axis=-1)
    q = q.reshape(b, s, B_HEADS, 2, B_DH)
    k = k.reshape(b, s, B_HEADS, 2, B_DH)
    v = v.reshape(b, s, B_HEADS, 2 * B_DH)
    lamf = lam.astype(jnp.float32)
    lam_full = jnp.exp(jnp.sum(lamf[0] * lamf[1])) - jnp.exp(jnp.sum(lamf[2] * lamf[3])) + lambda_init
    nblk = s // B_BLOCK
    qb = jnp.moveaxis(q.reshape(b, nblk, B_BLOCK, B_HEADS, 2, B_DH), 1, 0)
    kpos = jnp.arange(s)

    def block(args):
        qi, q_blk = args
        qpos = qi * B_BLOCK + jnp.arange(B_BLOCK)
        rel = qpos[:, None] - kpos[None, :]
        bias = rel_bias.astype(jnp.float32)[rel_position_bucket(rel)]
        logits = (jnp.einsum('bqhmd,bkhmd->bhmqk', q_blk, k).astype(jnp.float32) * B_DH ** -0.5
                  + jnp.transpose(bias, (2, 0, 1))[None, :, None])
        logits = jnp.where(rel >= 0, logits, -jnp.inf)
        p = jax.nn.softmax(logits, axis=-1)
        attn = p[:, :, 0] - lam_full * p[:, :, 1]
        return jnp.einsum('bhqk,bkhd->bqhd', attn.astype(v.dtype), v)

    o = lax.map(block, (jnp.arange(nblk), qb))
    o = jnp.moveaxis(o, 0, 1).reshape(b, s, B_HEADS, 2 * B_DH)
    o = rms_norm(o, norm_g) * (1.0 - lambda_init)
    return o.reshape(b, s, D_MODEL).astype(x.dtype) @ w_out


def chunked_gmlp_mixer(x, w_in, ln_g, ln_b, w_s, b_s, w_out):
    b, s, _ = x.shape
    z = jax.nn.gelu(x @ w_in, approximate=False)
    u, v = jnp.split(z, 2, axis=-1)
    v = layer_norm(v, ln_g, ln_b)
    n = s // C_CHUNK
    v = v.reshape(b, n, C_CHUNK, C_GROUPS, C_GW)
    idx = jnp.arange(C_CHUNK)
    w_causal = jnp.where(idx[:, None] >= idx[None, :], w_s, 0.0)
    mixed = jnp.einsum('gts,bnsgc->bntgc', w_causal, v) + jnp.transpose(b_s)[:, :, None]
    return (u * mixed.reshape(b, s, C_HALF)) @ w_out


def grouped_moe(x, w_router, router_bias, w1, w3, w2):
    b, s, d = x.shape
    t = x.reshape(b * s, d)
    scores = jax.nn.sigmoid((t @ w_router).astype(jnp.float32))
    sel = scores + router_bias.astype(jnp.float32)
    grp_score = jnp.sum(lax.top_k(sel.reshape(-1, N_GROUPS, EXPERTS_PER_GROUP), TOP_K)[0], -1)
    best = jnp.argmax(grp_score, -1)
    in_group = (jnp.arange(N_EXPERTS) // EXPERTS_PER_GROUP)[None, :] == best[:, None]
    _, top_idx = lax.top_k(jnp.where(in_group, sel, -jnp.inf), TOP_K)
    top_w = jnp.take_along_axis(scores, top_idx, -1)
    top_w = top_w / jnp.sum(top_w, -1, keepdims=True)
    gates = jnp.einsum('tk,tke->te', top_w, jax.nn.one_hot(top_idx, N_EXPERTS, dtype=jnp.float32))
    out = jnp.zeros_like(t)
    for e in range(N_EXPERTS):
        h = jax.nn.silu(t @ w1[e]) * (t @ w3[e])
        out = out + gates[:, e:e + 1].astype(t.dtype) * (h @ w2[e])
    return out.reshape(b, s, d)


def setup_inputs(seed: int = 0) -> dict:
    key = jax.random.key(seed)
    ks = iter(jax.random.split(key, 40))
    f32 = jnp.float32

    def nrm(shape, scale):
        return jax.random.normal(next(ks), shape, f32) * scale

    def gain(shape):
        return 1.0 + nrm(shape, 0.02)

    nA, nB, nC = N_LAYERS_A, N_LAYERS_B, N_LAYERS_C
    a_decay = jax.random.uniform(next(ks), (nA, A_HEADS), f32, 1.0, 16.0)
    dt = jnp.exp(jax.random.uniform(next(ks), (nA, A_HEADS), f32, math.log(1e-3), math.log(1e-1)))
    return {
        "x": nrm((BATCH, SEQ, D_MODEL), 1.0),
        "ln_mix_g": gain((DEPTH, D_MODEL)),
        "ln_mix_b": nrm((DEPTH, D_MODEL), 0.02),
        "ln_ffn_g": gain((DEPTH, D_MODEL)),
        "ln_ffn_b": nrm((DEPTH, D_MODEL), 0.02),
        "a_w_in": nrm((nA, D_MODEL, A_IN_W), D_MODEL ** -0.5),
        "a_conv": nrm((nA, A_CONV, 2 * A_QK_W + A_V_W), A_CONV ** -0.5),
        "a_a_log": jnp.log(a_decay),
        "a_dt_bias": dt + jnp.log(-jnp.expm1(-dt)),
        "a_norm_g": gain((nA, A_DV)),
        "a_w_out": nrm((nA, A_V_W, D_MODEL), A_V_W ** -0.5 * DN_BETA),
        "b_w_in": nrm((nB, D_MODEL, 3 * D_MODEL), D_MODEL ** -0.5),
        "b_lambda": nrm((nB, 4, B_DH), 0.1),
        "b_norm_g": gain((nB, 2 * B_DH)),
        "b_w_out": nrm((nB, D_MODEL, D_MODEL), D_MODEL ** -0.5 * DN_BETA),
        "rel_bias": nrm((REL_BUCKETS, B_HEADS), 0.2),
        "c_w_in": nrm((nC, D_MODEL, 2 * C_HALF), D_MODEL ** -0.5),
        "c_ln_g": gain((nC, C_HALF)),
        "c_ln_b": nrm((nC, C_HALF), 0.02),
        "c_w_s": nrm((nC, C_GROUPS, C_CHUNK, C_CHUNK), C_CHUNK ** -0.5),
        "c_b_s": gain((nC, C_GROUPS, C_CHUNK)),
        "c_w_out": nrm((nC, C_HALF, D_MODEL), C_HALF ** -0.5 * DN_BETA),
        "w_router": nrm((D_MODEL, N_EXPERTS), D_MODEL ** -0.5),
        "router_bias": nrm((N_EXPERTS,), 0.01),
        "e_w1": nrm((DEPTH, N_EXPERTS, D_MODEL, D_EXPERT), D_MODEL ** -0.5),
        "e_w3": nrm((DEPTH, N_EXPERTS, D_MODEL, D_EXPERT), D_MODEL ** -0.5),
        "e_w2": nrm((DEPTH, N_EXPERTS, D_EXPERT, D_MODEL), D_EXPERT ** -0.5 * DN_BETA),
    }


def reference(x, ln_mix_g, ln_mix_b, ln_ffn_g, ln_ffn_b,
              a_w_in, a_conv, a_a_log, a_dt_bias, a_norm_g, a_w_out,
              b_w_in, b_lambda, b_norm_g, b_w_out, rel_bias,
              c_w_in, c_ln_g, c_ln_b, c_w_s, c_b_s, c_w_out,
              w_router, router_bias, e_w1, e_w3, e_w2):
    h = x
    for i in range(DEPTH):
        kind, j = i % N_MIXERS, i // N_MIXERS
        if kind == 0:
            y = gated_deltanet_mixer(h, a_w_in[j], a_conv[j], a_a_log[j], a_dt_bias[j],
                                     a_norm_g[j], a_w_out[j])
        elif kind == 1:
            lambda_init = 0.8 - 0.6 * math.exp(-0.3 * i)
            y = diff_attention_mixer(h, b_w_in[j], b_lambda[j], b_norm_g[j], b_w_out[j],
                                     rel_bias, lambda_init)
        else:
            y = chunked_gmlp_mixer(h, c_w_in[j], c_ln_g[j], c_ln_b[j], c_w_s[j], c_b_s[j], c_w_out[j])
        h = layer_norm(DN_ALPHA * h + y, ln_mix_g[i], ln_mix_b[i])
        m = grouped_moe(h, w_router, router_bias, e_w1[i], e_w3[i], e_w2[i])
        h = layer_norm(DN_ALPHA * h + m, ln_ffn_g[i], ln_ffn_b[i])
    return h
```

```cpp
#include <hip/hip_runtime.h>
#include <hip/hip_bf16.h>
#include <cstdio>
#include <cstdint>
#include <cmath>
namespace pg8 {
#define PG8_LAS __attribute__((address_space(3)))
typedef unsigned short bf16_t;
typedef short bf16x8 __attribute__((ext_vector_type(8)));
typedef float f32x4 __attribute__((ext_vector_type(4)));
typedef unsigned u32x4 __attribute__((ext_vector_type(4)));
constexpr int BM = 256, BK = 64, HALF = 128, HTB = HALF * BK * 2  , STAGE_BYTES = 8 * HTB, NXCD = 8, WGM = 8;

__host__ __device__ __forceinline__ int lds_byte(int r, int c) { const int st = (r >> 4) * 2 + (c >> 5), rr = r & 15, cc = c & 31, ob = rr * 64 + cc * 2; return st * 1024 + (ob ^ (((ob >> 9) & 1) << 5)); }
__host__ __device__ __forceinline__ void stage_rc(int b, int& R, int& C) { const int st = b / 1024, sb = b % 1024, swz = sb ^ (((sb >> 9) & 1) << 5); R = (st >> 1) * 16 + swz / 64; C = (st & 1) * 32 + (swz % 64) / 2; }
__host__ __device__ __forceinline__ int perm32(int rho) { const int n = rho >> 4, i = rho & 15; return 8 * (i >> 2) + 4 * n + (i & 3); }

struct Unit { int pm, pn; };
struct Gemm { const bf16_t* A; const bf16_t* Bt; int M, N, K; };

struct StaticOrder {
    int nM, nN, nwg, G, c;
    __host__ __device__ void init(int M, int N, int G_, int c_) { nM = M / BM; nN = N / BM; nwg = nM * nN; G = G_; c = c_; }
    __host__ __device__ bool next(int i, Unit& u) const {
        const long L = (long)i * G + c; if (L >= nwg) return false;
        int wgid = (int)L; { const int q = nwg / NXCD, r = nwg % NXCD, xcd = wgid % NXCD, off = wgid / NXCD; wgid = (xcd < r ? xcd * (q + 1) : r * (q + 1) + (xcd - r) * q) + off; }
        const int nig = WGM * nN, gid = wgid / nig, fm = gid * WGM, gsz = (nM - fm) < WGM ? (nM - fm) : WGM;
        u.pm = fm + ((wgid % nig) % gsz); u.pn = (wgid % nig) / gsz; return true;
    }
    __device__ __forceinline__ void a_ready(const Unit&) const {}
    __device__ __forceinline__ void done(const Unit&) const {}
    __device__ __forceinline__ size_t aoff(const Unit& u, size_t tstepA) const { return (size_t)u.pm * tstepA; }
    __device__ __forceinline__ size_t boff(const Unit& u, size_t tstepB) const { return (size_t)u.pn * tstepB; }
};

__device__ __forceinline__ unsigned cvt_pk_bf16(float lo, float hi) { unsigned r; asm volatile("v_cvt_pk_bf16_f32 %0, %1, %2" : "=v"(r) : "v"(lo), "v"(hi)); return r; }
typedef float f32x2 __attribute__((ext_vector_type(2)));
__device__ __forceinline__ f32x2 gelu_pk(f32x2 v) {
    const f32x2 av = __builtin_elementwise_abs(v), d = av * 0.2316418882f + 1.0f;
    f32x2 t; t.x = __builtin_amdgcn_rcpf(d.x); t.y = __builtin_amdgcn_rcpf(d.y);
    f32x2 q = t * 0.5307027145f + (-0.7265760135f); q = q * t + 0.7107068705f; q = q * t + (-0.142248368f); q = q * t + 0.127414796f; q = q * t;
    const f32x2 s = (v * v) * (-0.72134752044f);
    f32x2 e; e.x = __builtin_amdgcn_exp2f(s.x); e.y = __builtin_amdgcn_exp2f(s.y);
    const f32x2 m = v * (q * e), r = v - m;
    f32x2 o; o.x = v.x < 0.f ? m.x : r.x; o.y = v.y < 0.f ? m.y : r.y; return o;
}

template <int ACT  > struct EpiBf16 {
    static constexpr bool PERM = true, AFTER_DRAIN = false; static_assert(ACT == 0 || ACT == 1, "EpiBf16: ACT is 0 (none) or 1 (gelu_pk)");
    bf16_t* O; int ldc; const float* bias; int split_cols; size_t split_stride; float scale0;
    __device__ __forceinline__ void operator()(const f32x4 (&acc)[2][2][4][2], const Unit& u, int wr, int wc, int fr, int fq) const {
        const int row0 = u.pm * BM + wr * 64 + fr; int colt = u.pn * BM; bf16_t* base = O;
        float sc = 1.f; if (split_cols) { const int t = colt / split_cols; base += (size_t)t * split_stride; colt -= t * split_cols; if (t == 0) sc = scale0; }
        const int col0 = colt + wc * 32 + 8 * fq, bcol0 = u.pn * BM + wc * 32 + 8 * fq;
        f32x4 bv[2][2];
#pragma unroll
        for (int bj = 0; bj < 2; ++bj)
#pragma unroll
            for (int n = 0; n < 2; ++n) bv[bj][n] = bias ? *(const f32x4*)(bias + bcol0 + bj * HALF + 4 * n) : (f32x4){0.f, 0.f, 0.f, 0.f};
#pragma unroll
        for (int ai = 0; ai < 2; ++ai)
#pragma unroll
            for (int m = 0; m < 4; ++m) { bf16_t* rowp = base + (size_t)(row0 + ai * HALF + m * 16) * ldc + col0;
#pragma unroll
                for (int bj = 0; bj < 2; ++bj) { f32x4 v0 = acc[ai][bj][m][0] + bv[bj][0], v1 = acc[ai][bj][m][1] + bv[bj][1];
                    if (ACT == 1) { f32x2 a = gelu_pk((f32x2){v0[0], v0[1]}), b = gelu_pk((f32x2){v0[2], v0[3]}), c = gelu_pk((f32x2){v1[0], v1[1]}), d = gelu_pk((f32x2){v1[2], v1[3]});
                        v0 = (f32x4){a.x, a.y, b.x, b.y}; v1 = (f32x4){c.x, c.y, d.x, d.y}; }
                    v0 = v0 * sc; v1 = v1 * sc; u32x4 w; w.x = cvt_pk_bf16(v0[0], v0[1]); w.y = cvt_pk_bf16(v0[2], v0[3]); w.z = cvt_pk_bf16(v1[0], v1[1]); w.w = cvt_pk_bf16(v1[2], v1[3]);
                    *(u32x4*)(rowp + bj * HALF) = w; } }
    }
};

template <class Epi, class Sched, bool ALIGN_EPI = false, bool SP2 = false>
__device__ __forceinline__ void gemm_phase(PG8_LAS unsigned char* lds, const Gemm g, const Sched& S, const Epi& E) {
    const int tid = threadIdx.x, wid = __builtin_amdgcn_readfirstlane(tid >> 6), lane = tid & 63, wr = wid >> 2, wc = wid & 3, fr = lane & 15, fq = lane >> 4;
    const int K = g.K, nt = K / BK;
    unsigned voffA[2], voffB[2];
#pragma unroll
    for (int i = 0; i < 2; ++i) { int R, C; stage_rc(tid * 16 + i * 8192, R, C); const int Rb = Epi::PERM ? ((R & ~31) + perm32(R & 31)) : R;
        voffA[i] = (unsigned)(R * K + C) * 2u; voffB[i] = (unsigned)(Rb * K + C) * 2u; }
    const size_t kstep = (size_t)(BK * 2);
    const size_t hstep = (size_t)HALF * K * 2;
    const size_t tstep = 2 * hstep;
    const unsigned ldsw = (unsigned)wid * 1024u;
    const int aoff = lds_byte(wr * 64 + fr, fq * 8), boff = lds_byte(wc * 32 + fr, fq * 8);
#define PG8_SA(b, h) (((b) * 2 + (h)) * HTB)
#define PG8_SB(b, h) ((4 + (b) * 2 + (h)) * HTB)
#define PG8_STAGE(bufoff, gbase, voff) do { _Pragma("unroll") for (int _i = 0; _i < 2; ++_i) \
        __builtin_amdgcn_global_load_lds((const unsigned*)((const char*)(gbase) + (voff)[_i]), (PG8_LAS unsigned*)(lds + (bufoff) + ldsw + _i * 8192), 16, 0, 0); } while (0)
#define PG8_LDA(dst, b, h) do { _Pragma("unroll") for (int m = 0; m < 4; ++m) _Pragma("unroll") for (int k = 0; k < 2; ++k) dst[m][k] = *(const PG8_LAS bf16x8*)(lds + PG8_SA(b, h) + aoff + m * 2048 + k * 1024); } while (0)
#define PG8_LDB(dst, b, h) do { _Pragma("unroll") for (int n = 0; n < 2; ++n) _Pragma("unroll") for (int k = 0; k < 2; ++k) dst[n][k] = *(const PG8_LAS bf16x8*)(lds + PG8_SB(b, h) + boff + n * 2048 + k * 1024); } while (0)
#define PG8_MMA(ai, bj, At, Bt) do { __builtin_amdgcn_s_setprio(1); _Pragma("unroll") for (int m = 0; m < 4; ++m) _Pragma("unroll") for (int n = 0; n < 2; ++n) _Pragma("unroll") for (int k = 0; k < 2; ++k) \
        acc[ai][bj][m][n] = __builtin_amdgcn_mfma_f32_16x16x32_bf16(Bt[n][k], At[m][k], acc[ai][bj][m][n], 0, 0, 0); __builtin_amdgcn_s_setprio(0); } while (0)
#define PG8_WAIT_V(n) asm volatile("s_waitcnt vmcnt(" #n ")" ::: "memory")
#define PG8_WAIT_L(n) asm volatile("s_waitcnt lgkmcnt(" #n ")" ::: "memory")
#define PG8_BAR __builtin_amdgcn_s_barrier()
#define PG8_SCHED __builtin_amdgcn_sched_barrier(0)
    Unit cur, nxt; int ui = 0;
    if (!S.next(0, cur)) return;
    f32x4 acc[2][2][4][2];
#pragma unroll
    for (int a = 0; a < 2; ++a)
#pragma unroll
        for (int b = 0; b < 2; ++b)
#pragma unroll
            for (int m = 0; m < 4; ++m)
#pragma unroll
                for (int n = 0; n < 2; ++n) acc[a][b][m][n] = (f32x4){0.f, 0.f, 0.f, 0.f};
    bf16x8 At[4][2], B0[2][2], B1[2][2];
    const char* cA = (const char*)g.A + S.aoff(cur, tstep); const char* cB = (const char*)g.Bt + S.boff(cur, tstep);
    S.a_ready(cur);
    if constexpr (SP2) {
        PG8_STAGE(PG8_SB(0, 0), cB, voffB); PG8_STAGE(PG8_SB(0, 1), cB + hstep, voffB); PG8_STAGE(PG8_SA(0, 0), cA, voffA); PG8_STAGE(PG8_SA(0, 1), cA + hstep, voffA);
        if (wr == 1) PG8_BAR;
        PG8_WAIT_V(2); PG8_BAR;
        PG8_STAGE(PG8_SB(1, 0), cB + kstep, voffB); PG8_STAGE(PG8_SA(1, 0), cA + kstep, voffA); PG8_STAGE(PG8_SB(1, 1), cB + hstep + kstep, voffB);
        PG8_WAIT_V(6); PG8_BAR;
    } else {
        PG8_STAGE(PG8_SB(0, 0), cB, voffB); PG8_STAGE(PG8_SA(0, 0), cA, voffA); PG8_STAGE(PG8_SB(0, 1), cB + hstep, voffB); PG8_STAGE(PG8_SA(0, 1), cA + hstep, voffA);
        if (wr == 1) PG8_BAR;
        PG8_WAIT_V(4); PG8_BAR;
        PG8_STAGE(PG8_SB(1, 0), cB + kstep, voffB); PG8_STAGE(PG8_SA(1, 0), cA + kstep, voffA); PG8_STAGE(PG8_SB(1, 1), cB + hstep + kstep, voffB);
        PG8_WAIT_V(6); PG8_BAR;
    }
    for (;;) {
        const bool has_next = S.next(ui + 1, nxt);
        const char* nA = has_next ? (const char*)g.A + S.aoff(nxt, tstep) : cA; const char* nB = has_next ? (const char*)g.Bt + S.boff(nxt, tstep) : cB;
        for (int t = 0; t < nt; t += 2) {
            const bool last = (t == nt - 2);
            const char* a1 = cA + (size_t)(t + 1) * kstep;
            const char* a2 = last ? nA : cA + (size_t)(t + 2) * kstep; const char* b2 = last ? nB : cB + (size_t)(t + 2) * kstep;
            const char* a3 = a2 + kstep; const char* b3 = b2 + kstep;
            if (last && has_next) S.a_ready(nxt);
            if constexpr (SP2) {
            PG8_LDB(B0, 0, 0); PG8_LDB(B1, 0, 1); PG8_SCHED; PG8_LDA(At, 0, 0); PG8_STAGE(PG8_SA(1, 1), a1 + hstep, voffA);
            PG8_WAIT_V(8); PG8_WAIT_L(0); PG8_BAR; PG8_MMA(0, 0, At, B0); PG8_MMA(0, 1, At, B1); PG8_BAR; PG8_SCHED;
            PG8_LDA(At, 0, 1); PG8_STAGE(PG8_SB(0, 0), b2, voffB); PG8_STAGE(PG8_SB(0, 1), b2 + hstep, voffB); PG8_STAGE(PG8_SA(0, 0), a2, voffA);
            PG8_WAIT_V(8); PG8_WAIT_L(0); PG8_BAR; PG8_MMA(1, 0, At, B0); PG8_MMA(1, 1, At, B1); PG8_BAR; PG8_SCHED;
            PG8_LDB(B0, 1, 0); PG8_LDB(B1, 1, 1); PG8_SCHED; PG8_LDA(At, 1, 0); PG8_STAGE(PG8_SA(0, 1), a2 + hstep, voffA);
            PG8_WAIT_V(8); PG8_WAIT_L(0); PG8_BAR; PG8_MMA(0, 0, At, B0); PG8_MMA(0, 1, At, B1); PG8_BAR; PG8_SCHED;
            PG8_LDA(At, 1, 1); PG8_STAGE(PG8_SB(1, 0), b3, voffB); PG8_STAGE(PG8_SB(1, 1), b3 + hstep, voffB); PG8_STAGE(PG8_SA(1, 0), a3, voffA);
            PG8_WAIT_V(8); PG8_WAIT_L(0); PG8_BAR; PG8_MMA(1, 0, At, B0); PG8_MMA(1, 1, At, B1); PG8_BAR; PG8_SCHED;
            } else {
            PG8_LDB(B0, 0, 0); PG8_SCHED; PG8_LDA(At, 0, 0); PG8_STAGE(PG8_SA(1, 1), a1 + hstep, voffA);
            PG8_WAIT_L(8); PG8_BAR; PG8_WAIT_L(0); PG8_MMA(0, 0, At, B0); PG8_BAR; PG8_SCHED;
            PG8_LDB(B1, 0, 1); PG8_STAGE(PG8_SB(0, 0), b2, voffB);
            PG8_BAR; PG8_WAIT_L(0); PG8_MMA(0, 1, At, B1); PG8_BAR;
            PG8_LDA(At, 0, 1); PG8_STAGE(PG8_SA(0, 0), a2, voffA);
            PG8_BAR; PG8_WAIT_L(0); PG8_MMA(1, 0, At, B0); PG8_BAR; PG8_SCHED;
            PG8_STAGE(PG8_SB(0, 1), b2 + hstep, voffB);
            PG8_WAIT_V(6); PG8_BAR; PG8_MMA(1, 1, At, B1); PG8_BAR;
            PG8_LDB(B0, 1, 0); PG8_SCHED; PG8_LDA(At, 1, 0); PG8_STAGE(PG8_SA(0, 1), a2 + hstep, voffA);
            PG8_WAIT_L(8); PG8_BAR; PG8_WAIT_L(0); PG8_MMA(0, 0, At, B0); PG8_BAR; PG8_SCHED;
            PG8_LDB(B1, 1, 1); PG8_STAGE(PG8_SB(1, 0), b3, voffB);
            PG8_BAR; PG8_WAIT_L(0); PG8_MMA(0, 1, At, B1); PG8_BAR;
            PG8_LDA(At, 1, 1); PG8_STAGE(PG8_SA(1, 0), a3, voffA);
            PG8_BAR; PG8_WAIT_L(0); PG8_MMA(1, 0, At, B0); PG8_BAR; PG8_SCHED;
            PG8_STAGE(PG8_SB(1, 1), b3 + hstep, voffB);
            PG8_WAIT_V(6); PG8_BAR; PG8_MMA(1, 1, At, B1); PG8_BAR;
            }
        }
        if constexpr (ALIGN_EPI) { if (wr == 0) PG8_BAR; }
        if constexpr (!Epi::AFTER_DRAIN) { E(acc, cur, wr, wc, fr, fq); S.done(cur); }
        if (!has_next) break;
#pragma unroll
        for (int a = 0; a < 2; ++a)
#pragma unroll
            for (int b = 0; b < 2; ++b)
#pragma unroll
                for (int m = 0; m < 4; ++m)
#pragma unroll
                    for (int n = 0; n < 2; ++n) acc[a][b][m][n] = (f32x4){0.f, 0.f, 0.f, 0.f};
        cur = nxt; cA = nA; cB = nB; ++ui;
        if constexpr (ALIGN_EPI) { if (wr == 1) PG8_BAR; }
    }
    PG8_WAIT_V(0);
    if constexpr (!ALIGN_EPI) { if (wr == 0) PG8_BAR; }
    PG8_BAR;
    if constexpr (Epi::AFTER_DRAIN) { E.fused(acc, cur, wr, wc, fr, fq, lds, wid, lane); S.done(cur); }
#undef PG8_SA
#undef PG8_SB
#undef PG8_STAGE
#undef PG8_LDA
#undef PG8_LDB
#undef PG8_MMA
#undef PG8_WAIT_V
#undef PG8_WAIT_L
#undef PG8_BAR
#undef PG8_SCHED
}
}
#define PG8_SP2 true
#define PG8_ALIGN true
namespace attn_body {
using bf16=__hip_bfloat16;
using bf16x8=__attribute__((ext_vector_type(8)))short;
using s16x4=__attribute__((ext_vector_type(4)))short;
using f32x16=__attribute__((ext_vector_type(16)))float;
using u32x4=__attribute__((ext_vector_type(4)))unsigned;
constexpr int BATCH=4,NHEAD=16,SEQ=8192,D=64,DM=NHEAD*D;
constexpr int NW=8,QBLK=32,QB=QBLK*NW,KVBLK=64,NQB=SEQ/QB;
constexpr int ATTN_PITCH=DM, ATTN_UNIT_ROWS=QB;
__device__ __forceinline__ int crow(int r,int hi){return (r&3)+8*(r>>2)+4*hi;}
#define SBAR() __builtin_amdgcn_sched_barrier(0)
__device__ __forceinline__ void cmask(f32x16&p0,f32x16&p1,int jb,int qrel,int hi){
  const float NEG=-INFINITY; int kb=64*jb+4*hi;
  #pragma unroll
  for(int r=0;r<16;++r){int kv=kb+(r&3)+8*(r>>2); if(kv>qrel)p0[r]=NEG; if(kv+32>qrel)p1[r]=NEG;}
}

typedef __attribute__((address_space(3))) const float* lds_cfptr;
__device__ __forceinline__ void bmask(f32x16&p0,f32x16&p1,int jb6,int qrel,int hi,lds_cfptr lut){
  const float NEG=-INFINITY; const int kb=64*jb6-128+4*hi;
  #pragma unroll
  for(int r=0;r<16;++r){const int n0=qrel-(kb+(r&3)+8*(r>>2)), n1=n0-32;
    const float b0=lut[n0<0?0:n0], b1=lut[n1<0?0:n1];
    p0[r]=(n0>=0)?p0[r]+b0:NEG; p1[r]=(n1>=0)?p1[r]+b1:NEG;}
}

constexpr int NSLOT=3, SLOTB=8192;
constexpr int LDS_K=0, LDS_V=NSLOT*SLOTB, LDS_WS=2*NSLOT*SLOTB, LDS_OST=LDS_WS+NW*64*4, LDS_BYTES=LDS_OST+NW*4096;
constexpr float C2=0.125f*1.4426950408889634f;
__device__ __forceinline__ void glds16(const void*gsrc,unsigned lds_dst){unsigned keep;
  asm volatile("s_mov_b32 %0, m0\n\ts_mov_b32 m0, %2\n\ts_nop 0\n\tglobal_load_lds_dwordx4 %1, off\n\ts_mov_b32 m0, %0":"=&s"(keep):"v"(gsrc),"s"(lds_dst):"memory");}
__device__ __forceinline__ float max3f(float a,float b,float c){float r;asm("v_max3_f32 %0, %1, %2, %3":"=v"(r):"v"(a),"v"(b),"v"(c));return r;}
__device__ __forceinline__ float max2f(float a,float b){float r;asm("v_max_f32_e32 %0, %1, %2":"=v"(r):"v"(a),"v"(b));return r;}
__device__ __forceinline__ float fadd_s(float a,float b){float r;asm("v_add_f32_e32 %0, %1, %2":"=v"(r):"v"(a),"v"(b));return r;}
__device__ __forceinline__ float fsub_s(float a,float b){float r;asm("v_sub_f32_e32 %0, %1, %2":"=v"(r):"v"(a),"v"(b));return r;}
typedef float f32x2_t __attribute__((ext_vector_type(2))); typedef __bf16 bf16x2_t __attribute__((ext_vector_type(2)));
__device__ __forceinline__ unsigned cvtpk_s(float lo,float hi){f32x2_t v={lo,hi};bf16x2_t b=__builtin_convertvector(v,bf16x2_t);return __builtin_bit_cast(unsigned,b);}
#define WAIT_BAR(N) asm volatile("s_waitcnt vmcnt(" #N ") lgkmcnt(0)\n\ts_barrier":::"memory")

__device__ __forceinline__ void qkt(f32x16&p0,f32x16&p1,const char*Kslot,const bf16x8*qr,const f32x16&negm,int r32,int hi){
  const char*kb=Kslot+hi*1024+r32*16;
  #pragma unroll
  for(int d0=0;d0<4;++d0){
    const bf16x8 b0=*reinterpret_cast<const bf16x8*>(kb+d0*2048);
    const bf16x8 b1=*reinterpret_cast<const bf16x8*>(kb+d0*2048+512);
    if(d0==0){p0=__builtin_amdgcn_mfma_f32_32x32x16_bf16(b0,qr[0],negm,0,0,0);p1=__builtin_amdgcn_mfma_f32_32x32x16_bf16(b1,qr[0],negm,0,0,0);}
    else{p0=__builtin_amdgcn_mfma_f32_32x32x16_bf16(b0,qr[d0],p0,0,0,0);p1=__builtin_amdgcn_mfma_f32_32x32x16_bf16(b1,qr[d0],p1,0,0,0);}}
}
typedef __attribute__((address_space(3))) const char* lds_cptr;
typedef short v4i16_t __attribute__((ext_vector_type(4)));
__device__ __forceinline__ void kload8(bf16x8*kf,lds_cptr kp){
  kf[0]=*(const __attribute__((address_space(3))) bf16x8*)(kp);      kf[1]=*(const __attribute__((address_space(3))) bf16x8*)(kp+512);
  kf[2]=*(const __attribute__((address_space(3))) bf16x8*)(kp+2048); kf[3]=*(const __attribute__((address_space(3))) bf16x8*)(kp+2560);
  kf[4]=*(const __attribute__((address_space(3))) bf16x8*)(kp+4096); kf[5]=*(const __attribute__((address_space(3))) bf16x8*)(kp+4608);
  kf[6]=*(const __attribute__((address_space(3))) bf16x8*)(kp+6144); kf[7]=*(const __attribute__((address_space(3))) bf16x8*)(kp+6656);
}
__device__ __forceinline__ void kload2(bf16x8*kf,lds_cptr kp,int j){ kf[2*j]=*(const __attribute__((address_space(3))) bf16x8*)(kp+j*2048); kf[2*j+1]=*(const __attribute__((address_space(3))) bf16x8*)(kp+j*2048+512); }
__device__ __forceinline__ s16x4 vtr(lds_cptr p){ return __builtin_bit_cast(s16x4,__builtin_amdgcn_ds_read_tr16_b64_v4i16((__attribute__((address_space(3))) v4i16_t*)p)); }
__device__ __forceinline__ float rowmax(const f32x16&p0,const f32x16&p1){
  float a=max3f(p0[0],p0[1],p1[0]),b=max3f(p0[2],p0[3],p1[1]);a=max3f(a,p1[2],p1[3]);
  #pragma unroll
  for(int r=4;r<16;r+=4){a=max3f(a,p0[r],p0[r+1]);b=max3f(b,p0[r+2],p0[r+3]);a=max3f(a,p1[r],p1[r+1]);b=max3f(b,p1[r+2],p1[r+3]);}
  const float m=max2f(a,b);
  auto rr=__builtin_amdgcn_permlane32_swap(__float_as_uint(m),__float_as_uint(m),false,false);
  return max2f(__uint_as_float(rr[0]),__uint_as_float(rr[1]));
}
__device__ __forceinline__ void pv(f32x16*o,int vb,bf16x8 pa0,bf16x8 pa1,bf16x8 pa2,bf16x8 pa3){
  #pragma unroll
  for(int d0=0;d0<2;++d0){s16x4 lo[4],hi[4];
    #pragma unroll
    for(int ks=0;ks<4;++ks){
      asm volatile("ds_read_b64_tr_b16 %0,%1 offset:%c2":"=&v"(lo[ks]):"v"(vb),"i"(d0*4096+ks*1024):"memory");
      asm volatile("ds_read_b64_tr_b16 %0,%1 offset:%c2":"=&v"(hi[ks]):"v"(vb),"i"(d0*4096+ks*1024+512):"memory");}
    asm volatile("s_waitcnt lgkmcnt(0)":::"memory");SBAR();
    #define PK(k) (bf16x8){lo[k][0],lo[k][1],lo[k][2],lo[k][3],hi[k][0],hi[k][1],hi[k][2],hi[k][3]}
    o[d0]=__builtin_amdgcn_mfma_f32_32x32x16_bf16(pa0,PK(0),o[d0],0,0,0);
    o[d0]=__builtin_amdgcn_mfma_f32_32x32x16_bf16(pa1,PK(1),o[d0],0,0,0);
    o[d0]=__builtin_amdgcn_mfma_f32_32x32x16_bf16(pa2,PK(2),o[d0],0,0,0);
    o[d0]=__builtin_amdgcn_mfma_f32_32x32x16_bf16(pa3,PK(3),o[d0],0,0,0);
    #undef PK
  }
}

#ifndef ATTN_STORE16
#define ATTN_STORE16(p,v) (*(u32x4*)(p)=(v))
#endif
template<int THRL> __device__ __forceinline__ void attn_unit(int b,int h,int hv,int qb,const bf16*Q,const bf16*__restrict__ K,const bf16*__restrict__ V,bf16*O,char*shm,lds_cfptr lut){
  const int tid=threadIdx.x,lane=tid&63,r32=lane&31,hi=lane>>5; const int wid=__builtin_amdgcn_readfirstlane(tid>>6);
  const long rowbase=(long)b*SEQ; const int q0=qb*QB;
  const bf16*Qw=Q+(rowbase+q0+wid*QBLK)*DM+h*D;
  const bf16*Kh=K+rowbase*DM+h*D,*Vh=V+rowbase*DM+hv*D;
  const unsigned lds0=(unsigned)(uintptr_t)shm;
  float*wsf=(float*)(shm+LDS_WS)+wid*64;
  const bf16*ksrc=Kh+(long)lane*DM+wid*8;
  const bf16*vsrc=Vh+(long)(16*(wid&3)+(lane>>2))*DM+(wid>>2)*32+(lane&3)*8;
  const unsigned kdst=lds0+LDS_K+wid*1024, vdst=lds0+LDS_V+wid*1024;
  #define DMA_K(t,slot) glds16(ksrc+(long)(t)*KVBLK*DM,(unsigned)__builtin_amdgcn_readfirstlane(kdst+(slot)))
  #define DMA_V(t,slot) glds16(vsrc+(long)(t)*KVBLK*DM,(unsigned)__builtin_amdgcn_readfirstlane(vdst+(slot)))
  const int vb0=(int)(lds0+LDS_V)+((lane>>4)&1)*32+(lane&3)*8+(4*hi+((lane&15)>>2))*64;
  const char*Kbase=shm+LDS_K; bf16x8 kf[8];
  const lds_cptr shm3=(lds_cptr)shm; const lds_cptr kp0=shm3+LDS_K+hi*1024+r32*16; const lds_cptr vp0=shm3+LDS_V+((lane>>4)&1)*32+(lane&3)*8+(4*hi+((lane&15)>>2))*64;
  const int NT=(q0+QB)/KVBLK;
  DMA_K(0,0);DMA_V(0,0);DMA_K(1,SLOTB);
  bf16x8 qr[4];
  #pragma unroll
  for(int d0=0;d0<4;++d0)qr[d0]=*reinterpret_cast<const bf16x8*>(&Qw[(long)r32*DM+d0*16+hi*8]);
  float mhat=0.f,l_reg=0.f;f32x16 o[2];o[0]=f32x16{};o[1]=f32x16{};f32x16 negm=f32x16{};asm volatile("":"+v"(negm));
  const int qrel=wid*QBLK+r32;
  #define CMASK(P0,P1,t) do{int jb_=(t)-(NT-6); if(jb_>=0)bmask(P0,P1,jb_,qrel,hi,lut);}while(0)
  bool resc=false;
  #define START(P0,P1) do{ const float rm=rowmax(P0,P1); resc=false; \
    { const float dl=rm; mhat=fadd_s(mhat,dl); \
      _Pragma("unroll") for(int r=0;r<16;++r){P0[r]=fsub_s(P0[r],dl);P1[r]=fsub_s(P1[r],dl);} \
      _Pragma("unroll") for(int r=0;r<16;++r)negm[r]=-mhat; asm volatile("":"+v"(negm)); } \
    _Pragma("unroll") for(int r=0;r<16;++r)P0[r]=__builtin_amdgcn_exp2f(P0[r]); }while(0)
  #define RESC() do{ if(resc){ asm volatile("s_waitcnt lgkmcnt(0)":::"memory"); \
      _Pragma("unroll") for(int d_=0;d_<2;++d_) _Pragma("unroll") for(int r=0;r<16;++r)o[d_][r]*=wsf[crow(r,hi)]; } }while(0)
  f32x16 pA0,pA1,pB0,pB1;
  int sl_prev=0,sl_cur=0,sl_next=SLOTB;
  #define ROT() do{sl_prev=sl_cur;sl_cur=sl_next;sl_next=(sl_next==(NSLOT-1)*SLOTB)?0:sl_next+SLOTB;}while(0)
  DMA_K(2,2*SLOTB);
  WAIT_BAR(3);
  qkt(pA0,pA1,Kbase,qr,negm,r32,hi);asm volatile("s_nop 15\n\ts_nop 7":"+v"(pA0),"+v"(pA1));CMASK(pA0,pA1,0);
  START(pA0,pA1);
  _Pragma("unroll") for(int r=0;r<16;++r)pA1[r]=__builtin_amdgcn_exp2f(pA1[r]);
  WAIT_BAR(0);
  DMA_K(3,0);DMA_V(1,SLOTB);
  ROT();
  kload8(kf,kp0+sl_cur);
  WAIT_BAR(2);
  s16x4 vlo[8],vhi[8]; u32x4 pw0,pw1,pw2,pw3;
  #define PKW(P,B) cvtpk_s(P[B],P[B+1])
  #define PAF(k) __builtin_bit_cast(bf16x8,pw##k)
  #define VFR(i) (bf16x8){vlo[i][0],vlo[i][1],vlo[i][2],vlo[i][3],vhi[i][0],vhi[i][1],vhi[i][2],vhi[i][3]}
  #define PIN(x) asm volatile("":"+v"(x))
  #define MX3(a,b,c) __builtin_fmaxf(__builtin_fmaxf((a),(b)),(c))
  #define GAPA(MF,A0,A1,A2,A3,W0,W1,PW) do{ MF; sacc+=A0; sacc+=A1; sacc+=A2; sacc+=A3; PIN(sacc); W0; W1; PIN(PW); SBAR(); }while(0)
  #define EX(v) __builtin_amdgcn_exp2f(v)
  #define GAPB(MF,X,B) do{ MF; X[B]=EX(X[B]); X[B+1]=EX(X[B+1]); X[B+2]=EX(X[B+2]); X[B+3]=EX(X[B+3]); PIN(X); SBAR(); }while(0)
  #define VRD(i) do{ vlo[i]=vtr(vp_+(((i)>>2)*4096+((i)&3)*1024)); vhi[i]=vtr(vp_+(((i)>>2)*4096+((i)&3)*1024+512)); }while(0)
  #define KRD(G,j) do{ if(G){ kload2(kf,kp0+sl_next,j); SBAR(); } }while(0)
  #define STEP(C0,C1,P0,P1,t,GK,GV,GL) do{ SBAR(); \
    const lds_cptr vp_=vp0+sl_prev; \
    VRD(0); SBAR(); float sacc=(P0[0]+P0[1]); \
    GAPA(C0=__builtin_amdgcn_mfma_f32_32x32x16_bf16(kf[0],qr[0],negm,0,0,0), P0[2],P0[3],P0[4],P0[5],     pw0[0]=PKW(P0,0), pw0[1]=PKW(P0,2), pw0); \
    VRD(4); SBAR(); GAPA(C1=__builtin_amdgcn_mfma_f32_32x32x16_bf16(kf[1],qr[0],negm,0,0,0), P0[6],P0[7],P0[8],P0[9],     pw0[2]=PKW(P0,4), pw0[3]=PKW(P0,6), pw0); \
    VRD(1); SBAR(); GAPA(C0=__builtin_amdgcn_mfma_f32_32x32x16_bf16(kf[2],qr[1],C0,0,0,0),   P0[10],P0[11],P0[12],P0[13], pw1[0]=PKW(P0,8), pw1[1]=PKW(P0,10), pw1); \
    VRD(5); SBAR(); GAPA(C1=__builtin_amdgcn_mfma_f32_32x32x16_bf16(kf[3],qr[1],C1,0,0,0),   P0[14],P0[15],P1[0],P1[1],   pw1[2]=PKW(P0,12),pw1[3]=PKW(P0,14), pw1); \
    VRD(2); SBAR(); GAPA(C0=__builtin_amdgcn_mfma_f32_32x32x16_bf16(kf[4],qr[2],C0,0,0,0),   P1[2],P1[3],P1[4],P1[5],     pw2[0]=PKW(P1,0), pw2[1]=PKW(P1,2), pw2); \
    VRD(6); SBAR(); GAPA(C1=__builtin_amdgcn_mfma_f32_32x32x16_bf16(kf[5],qr[2],C1,0,0,0),   P1[6],P1[7],P1[8],P1[9],     pw2[2]=PKW(P1,4), pw2[3]=PKW(P1,6), pw2); \
    VRD(3); SBAR(); GAPA(C0=__builtin_amdgcn_mfma_f32_32x32x16_bf16(kf[6],qr[3],C0,0,0,0),   P1[10],P1[11],P1[12],P1[13], pw3[0]=PKW(P1,8), pw3[1]=PKW(P1,10), pw3); \
    VRD(7); SBAR(); GAPA(C1=__builtin_amdgcn_mfma_f32_32x32x16_bf16(kf[7],qr[3],C1,0,0,0),   P1[14],P1[15],0.f,0.f,       pw3[2]=PKW(P1,12),pw3[3]=PKW(P1,14), pw3); \
    l_reg+=sacc; \
    if(GK){DMA_K((t)+3,sl_cur);} if(GV){DMA_V((t)+1,sl_next);} \
    CMASK(C0,C1,t); \
    { float a=MX3(C0[0],C0[1],C1[0]),b=MX3(C0[2],C0[3],C1[1]); a=MX3(a,C1[2],C1[3]); \
      _Pragma("unroll") for(int r=4;r<16;r+=4){a=MX3(a,C0[r],C0[r+1]);b=MX3(b,C0[r+2],C0[r+3]);a=MX3(a,C1[r],C1[r+1]);b=MX3(b,C1[r+2],C1[r+3]);} \
      float rm=__builtin_fmaxf(a,b); { auto rr=__builtin_amdgcn_permlane32_swap(__float_as_uint(rm),__float_as_uint(rm),false,false); rm=__builtin_fmaxf(__uint_as_float(rr[0]),__uint_as_float(rr[1])); } \
      resc=false; \
      if(__builtin_expect(__any(rm>(float)THRL),0)){ const float dl=__builtin_fmaxf(rm,0.f); mhat+=dl; \
        _Pragma("unroll") for(int r=0;r<16;++r){C0[r]-=dl;C1[r]-=dl;} \
        _Pragma("unroll") for(int r=0;r<16;++r)negm[r]=-mhat; asm volatile("":"+v"(negm)); \
        const float f=__builtin_amdgcn_exp2f(-dl); l_reg*=f; if(hi==0)wsf[r32]=f; resc=true; } } \
    SBAR(); \
    GAPB(o[0]=__builtin_amdgcn_mfma_f32_32x32x16_bf16(PAF(0),VFR(0),o[0],0,0,0), C0,0); \
    GAPB(o[1]=__builtin_amdgcn_mfma_f32_32x32x16_bf16(PAF(0),VFR(4),o[1],0,0,0), C0,4); \
    KRD(GL,0); GAPB(o[0]=__builtin_amdgcn_mfma_f32_32x32x16_bf16(PAF(1),VFR(1),o[0],0,0,0), C0,8); \
    KRD(GL,1); GAPB(o[1]=__builtin_amdgcn_mfma_f32_32x32x16_bf16(PAF(1),VFR(5),o[1],0,0,0), C0,12); \
    KRD(GL,2); GAPB(o[0]=__builtin_amdgcn_mfma_f32_32x32x16_bf16(PAF(2),VFR(2),o[0],0,0,0), C1,0); \
    KRD(GL,3); GAPB(o[1]=__builtin_amdgcn_mfma_f32_32x32x16_bf16(PAF(2),VFR(6),o[1],0,0,0), C1,4); \
    GAPB(o[0]=__builtin_amdgcn_mfma_f32_32x32x16_bf16(PAF(3),VFR(3),o[0],0,0,0), C1,8); \
    GAPB(o[1]=__builtin_amdgcn_mfma_f32_32x32x16_bf16(PAF(3),VFR(7),o[1],0,0,0), C1,12); \
    }while(0)
  int t=1;
  #undef CMASK
  #define CMASK(P0,P1,t) do{}while(0)
  for(;t+7<NT;t+=2){
    STEP(pB0,pB1,pA0,pA1,t,true,true,true);     WAIT_BAR(2); RESC(); ROT();
    STEP(pA0,pA1,pB0,pB1,t+1,true,true,true);   WAIT_BAR(2); RESC(); ROT();
  }
  #undef CMASK
  #define CMASK(P0,P1,t) do{int jb_=(t)-(NT-6); if(jb_>=0)bmask(P0,P1,jb_,qrel,hi,lut);}while(0)
  #define ENDW(tt) do{ if((tt)+3<NT){WAIT_BAR(2);} else if((tt)+2<NT){WAIT_BAR(1);} else {WAIT_BAR(0);} }while(0)
  for(;t+1<NT;t+=2){
    STEP(pB0,pB1,pA0,pA1,t,(t+3<NT),(t+1<NT),(t+1<NT));       ENDW(t);   RESC(); ROT();
    STEP(pA0,pA1,pB0,pB1,t+1,(t+4<NT),(t+2<NT),(t+2<NT));     ENDW(t+1); RESC(); ROT();
  }
  STEP(pB0,pB1,pA0,pA1,NT-1,false,false,false); RESC();
  { float sacc=pB0[0]+pB0[1]; _Pragma("unroll") for(int r=2;r<16;++r)sacc+=pB0[r]; _Pragma("unroll") for(int r=0;r<16;++r)sacc+=pB1[r]; l_reg+=sacc;
    pw0=(u32x4){PKW(pB0,0),PKW(pB0,2),PKW(pB0,4),PKW(pB0,6)};pw1=(u32x4){PKW(pB0,8),PKW(pB0,10),PKW(pB0,12),PKW(pB0,14)};pw2=(u32x4){PKW(pB1,0),PKW(pB1,2),PKW(pB1,4),PKW(pB1,6)};pw3=(u32x4){PKW(pB1,8),PKW(pB1,10),PKW(pB1,12),PKW(pB1,14)};
    SBAR(); pv(o,vb0+sl_cur,PAF(0),PAF(1),PAF(2),PAF(3)); }
  #undef PKW
  #undef PAF
  #undef VFR
  #undef PIN
  #undef MX3
  #undef GAPA
  #undef GAPB
  #undef EX
  #undef VRD
  #undef KRD
  #undef STEP
  #undef ENDW
  {auto rr=__builtin_amdgcn_permlane32_swap(__float_as_uint(l_reg),__float_as_uint(l_reg),false,false);l_reg=__uint_as_float(rr[0])+__uint_as_float(rr[1]);}
  if(hi==0)wsf[32+r32]=l_reg;asm volatile("s_waitcnt lgkmcnt(0)":::"memory");
  float rli[16];
  #pragma unroll
  for(int r=0;r<16;++r)rli[r]=__builtin_amdgcn_rcpf(wsf[32+crow(r,hi)]);
  bf16*Ow=O+(rowbase+q0+wid*QBLK)*DM+hv*D;
  { bf16*stg=(bf16*)(shm+LDS_OST)+wid*2048;
    #pragma unroll
    for(int r=0;r<16;++r){const int orow=crow(r,hi);
      #pragma unroll
      for(int d0=0;d0<2;++d0)stg[orow*64+d0*32+r32]=__float2bfloat16(o[d0][r]*rli[r]);}
    asm volatile("s_waitcnt lgkmcnt(0)":::"memory");
    #pragma unroll
    for(int i=0;i<4;++i){const int row=i*8+(lane>>3),ch=lane&7; const u32x4 v=*(const u32x4*)(stg+row*64+ch*8); ATTN_STORE16(Ow+(long)row*DM+ch*8,v);} }
  asm volatile("s_waitcnt lgkmcnt(0)\n\ts_barrier":::"memory");
  #undef DMA_K
  #undef DMA_V
  #undef CMASK
  #undef START
  #undef RESC
  #undef ROT
}
constexpr int ATTN_LDS_BYTES=LDS_BYTES;
constexpr int LUT_OFF=86016, LUT_N=384;
struct AttnTensors { const bf16* Q; const bf16* K; const bf16* V; bf16* O0; bf16* O1; const float* lut_g; };
struct AttnUnit { int b, hq, hv, m, qb; };
struct StaticOrder {
  int vcu;
  __device__ __forceinline__ explicit StaticOrder(int grid,int block):vcu((block%8)*(grid/8)+block/8){}
  __device__ __forceinline__ bool next(int i,AttnUnit&u)const{ if(i>=16)return false; const int s=vcu&7, combo=(vcu>>3)*4+(i>>2), rem=combo&31, h=rem>>2, m=(rem>>1)&1, vh=rem&1, k=i&3;
    u.b=combo>>5; u.hq=2*h+m; u.hv=2*h+vh; u.m=m; u.qb=(k==0)?s:(k==1)?15-s:(k==2)?16+s:31-s; return true; }
  __device__ __forceinline__ void a_ready(const AttnUnit&)const{}
  __device__ __forceinline__ void done(const AttnUnit&)const{}
};
template<class Sched,int THRL=8> __device__ __forceinline__ void attn_phase(char*lds,const AttnTensors&T,const Sched&S){
  { float* l=(float*)(lds+LUT_OFF); for(int i=threadIdx.x;i<8*LUT_N;i+=blockDim.x) l[i]=T.lut_g[i]; }
  asm volatile("s_waitcnt vmcnt(0) lgkmcnt(0)\n\ts_barrier":::"memory");
  AttnUnit u;
  for(int i=0;S.next(i,u);++i){ S.a_ready(u); attn_unit<THRL>(u.b,u.hq,u.hv,u.qb,T.Q,T.K,T.V,u.m?T.O1:T.O0,lds,(lds_cfptr)(lds+LUT_OFF)+(u.hq>>1)*LUT_N); S.done(u); }
}
#undef SBAR
#undef WAIT_BAR
}
constexpr int NWAVES = 8, NTHR = 512;
constexpr int NB = 4, SEQ = 8192, T = NB * SEQ, D = 1024, DEPTH = 4, NEXP = 16;
constexpr int A_INW = 4112;
constexpr float DN_ALPHA = 1.6817928305074290f;
constexpr float LN_EPS = 1e-5f;
constexpr int MAXTILES = 272, MAXROWS = MAXTILES * 256;

constexpr size_t MiB = 1u << 20;
constexpr size_t WS_CTL = 0, CTL_ZERO_BYTES = 1 * MiB;
constexpr size_t WS_AB = 1 * MiB;
constexpr size_t WS_TOKE = 3 * MiB;
constexpr size_t WS_TOKP = WS_TOKE + 256 * 1024;
constexpr size_t WS_TOKW = WS_TOKP + 256 * 1024;
constexpr size_t WS_TOKR = WS_TOKW + 256 * 1024;
constexpr size_t WS_MISC = 4 * MiB;
constexpr size_t WS_LUT = WS_MISC + 4096;
constexpr size_t WS_EGL = WS_MISC + 32768;
constexpr size_t WS_WSB = WS_MISC + 65536;
constexpr size_t WS_HALO = 5 * MiB;
constexpr size_t HALO_T = (size_t)512 * 3 * 1024;
constexpr size_t WS_W = 16 * MiB;
constexpr size_t WS_W13 = 29 * MiB;
constexpr size_t WS_W2 = 61 * MiB;
constexpr size_t WS_H = 80 * MiB;
constexpr size_t WS_R = 144 * MiB;
constexpr size_t TD2 = (size_t)T * D * 2;
constexpr size_t WS_END = WS_R + 416 * MiB;
constexpr int CW_TMO = 0, CW_BAR = 4096, CW_CNT = 8192;

constexpr int LDS_BYTES = 147456;
constexpr int RING_BYTES = 131072;
constexpr int MISC_OFF = RING_BYTES + 320;

#define GAS __attribute__((address_space(1)))
#define LAS __attribute__((address_space(3)))
typedef unsigned short bf16;
typedef unsigned v4u __attribute__((ext_vector_type(4)));
typedef unsigned v2u __attribute__((ext_vector_type(2)));
typedef float f32x4 __attribute__((ext_vector_type(4)));
typedef float f32x2 __attribute__((ext_vector_type(2)));
typedef short bf16x8 __attribute__((ext_vector_type(8)));
typedef __bf16 bf16x2_t __attribute__((ext_vector_type(2)));
#define RLX_AGENT __ATOMIC_RELAXED, __HIP_MEMORY_SCOPE_AGENT
#define LDS_WAIT() asm volatile("s_waitcnt lgkmcnt(0)" ::: "memory")
#define VM_WAIT() asm volatile("s_waitcnt vmcnt(0)" ::: "memory")
#define MFMA16(a, b, c) __builtin_amdgcn_mfma_f32_16x16x32_bf16((a), (b), (c), 0, 0, 0)
__device__ __forceinline__ unsigned pk2(float lo, float hi) { f32x2 v = {lo, hi}; bf16x2_t b = __builtin_convertvector(v, bf16x2_t); return __builtin_bit_cast(unsigned, b); }
__device__ __forceinline__ float bflo(unsigned w) { return __uint_as_float(w << 16); }
__device__ __forceinline__ float bfhi(unsigned w) { return __uint_as_float(w & 0xffff0000u); }
__device__ __forceinline__ float bf1(bf16 b) { return __uint_as_float(((unsigned)b) << 16); }
__device__ __forceinline__ bf16 f2bf(float f) { return (bf16)(pk2(f, 0.f) & 0xffffu); }
__device__ __forceinline__ float wave_sum(float v) {
#pragma unroll
    for (int o = 1; o < 64; o <<= 1) v += __shfl_xor(v, o);
    return v;
}
__device__ __forceinline__ float sigmoidf_(float x) { return 1.f / (1.f + __expf(-x)); }
__device__ __forceinline__ float siluf_(float x) { return x / (1.f + __expf(-x)); }
#define XB_TMO      128
#define XB_XCNT(j)  (256  + 64 * (j))
#define XB_XSUB(j)  (1280 + 64 * (j))
#define XB_XGEN(j)  (2304 + 64 * (j))
#define XB_TOP      3328
#define XB_TOPGEN   3392
#define XCD_BAR_WORDS 3456
#define XB_SPIN_CAP (1u << 18)

__device__ __forceinline__ unsigned xb_ld(unsigned* p)              { return __hip_atomic_load(p, __ATOMIC_RELAXED, __HIP_MEMORY_SCOPE_AGENT); }
__device__ __forceinline__ unsigned xb_add(unsigned* p, unsigned v) { return __hip_atomic_fetch_add(p, v, __ATOMIC_RELAXED, __HIP_MEMORY_SCOPE_AGENT); }
__device__ __forceinline__ unsigned xb_xcc_id() { return (unsigned)__builtin_amdgcn_s_getreg((3 << 11) | 20) & 0xFu; }
#define XB_SPIN(cond, bar) do { unsigned _sp = 0; while (cond) { __builtin_amdgcn_s_sleep(1); \
    if ((++_sp & 255u) == 0u) { if (xb_ld(&(bar)[XB_TMO])) break; if (_sp > XB_SPIN_CAP) { atomicAdd(&(bar)[XB_TMO], 1u); break; } } } } while (0)

struct XcdBarrier {
    unsigned* bar; unsigned x;
    volatile LAS unsigned* st;
};

__device__ __forceinline__ XcdBarrier xcd_barrier_post(unsigned* bar, volatile LAS unsigned* st) {
    XcdBarrier b; b.bar = bar; b.x = xb_xcc_id(); b.st = st;
    if (threadIdx.x == 0) (void)xb_add(&bar[XB_XCNT(b.x)], 1u);
    return b;
}
__device__ __forceinline__ void xcd_barrier_complete(unsigned* bar, unsigned x, unsigned& nloc, unsigned& nx) {
    const unsigned G = gridDim.x * gridDim.y * gridDim.z;
    unsigned sum, cnt, mine, sp = 0u;
    for (;;) {
        sum = 0u; cnt = 0u; mine = 0u;
#pragma unroll
        for (unsigned j = 0; j < 16; ++j) { const unsigned c = xb_ld(&bar[XB_XCNT(j)]); sum += c; cnt += (c > 0u) ? 1u : 0u; mine = (j == x) ? c : mine; }
        if (sum == G) break;
        __builtin_amdgcn_s_sleep(1);
        if ((++sp & 255u) == 0u) { if (xb_ld(&bar[XB_TMO])) break; if (sp > XB_SPIN_CAP) { atomicAdd(&bar[XB_TMO], 1u); break; } }
    }
    nloc = mine > 0u ? mine : 1u; nx = cnt > 0u ? cnt : 1u;
}

__device__ __forceinline__ void xcd_barrier(const XcdBarrier& b) {
    asm volatile("s_waitcnt vmcnt(0)" ::: "memory");
    __syncthreads();
    if (threadIdx.x == 0) {
        unsigned* bar = b.bar;
        __builtin_amdgcn_s_waitcnt(0);
        unsigned nloc = b.st[0], nx = b.st[1];
        if (nloc == 0u) { xcd_barrier_complete(bar, b.x, nloc, nx); b.st[0] = nloc; b.st[1] = nx; }
        const unsigned old = xb_add(&bar[XB_XSUB(b.x)], 1u);
        const unsigned gen = old / nloc;
        if (old + 1u == (gen + 1u) * nloc) {
            __builtin_amdgcn_fence(__ATOMIC_RELEASE, "agent");
            asm volatile("s_waitcnt vmcnt(0)" ::: "memory");
            const unsigned og = xb_add(&bar[XB_TOP], 1u);
            const unsigned tg = og / nx;
            if (og + 1u == (tg + 1u) * nx) xb_add(&bar[XB_TOPGEN], 1u);
            else XB_SPIN(xb_ld(&bar[XB_TOPGEN]) == tg, bar);
            __builtin_amdgcn_fence(__ATOMIC_ACQUIRE, "agent");
            xb_add(&bar[XB_XGEN(b.x)], 1u);
            asm volatile("s_waitcnt vmcnt(0)" ::: "memory");
        } else {
            XB_SPIN(xb_ld(&bar[XB_XGEN(b.x)]) == gen, bar);
            __builtin_amdgcn_fence(__ATOMIC_ACQUIRE, "agent");
            asm volatile("s_waitcnt vmcnt(0)" ::: "memory");
        }
    }
    __syncthreads();
}
struct Frame {
    LAS unsigned char* lds;
    unsigned* ctl;
    unsigned char* ws;
    const float* in[27];
    float* out;
    int tid, lane, wave, vcu, G;
};
enum { I_X = 0, I_LNMG, I_LNMB, I_LNFG, I_LNFB, I_AWIN, I_ACONV, I_AALOG, I_ADT, I_ANG, I_AWOUT, I_BWIN, I_BLAM, I_BNG, I_BWOUT, I_REL, I_CWIN, I_CLNG, I_CLNB, I_CWS, I_CBS, I_CWOUT, I_WR, I_RB, I_EW1, I_EW3, I_EW2 };

__device__ __forceinline__ void tr_item(const float* W, int ldw, int k0, int n0, bf16* WT, size_t dst_row0, int K, LAS float* scr, int lane) {
#pragma unroll 8
    for (int i = 0; i < 32; ++i) { const int kk = 2 * i + (lane >> 5); scr[kk * 33 + (lane & 31)] = W[(size_t)(k0 + kk) * ldw + n0 + (lane & 31)]; }
    LDS_WAIT(); asm volatile("" ::: "memory");
    const int c = lane & 7;
#pragma unroll
    for (int j = 0; j < 4; ++j) { const int n = (lane >> 3) + 8 * j; const LAS float* s = scr + (8 * c) * 33 + n;
        v4u o; o.x = pk2(s[0 * 33], s[1 * 33]); o.y = pk2(s[2 * 33], s[3 * 33]); o.z = pk2(s[4 * 33], s[5 * 33]); o.w = pk2(s[6 * 33], s[7 * 33]);
        *(GAS v4u*)(WT + (dst_row0 + n) * K + k0 + 8 * c) = o; }
    LDS_WAIT(); asm volatile("" ::: "memory");
}
__device__ __forceinline__ void tr_matrix_item(const float* W, int K, int N, int ldw, bf16* WT, LAS float* scr, int item, int lane) {
    const int nblk = N / 32, kb = item / nblk, nb = item % nblk;
    tr_item(W, ldw, 64 * kb, 32 * nb, WT, (size_t)32 * nb, K, scr, lane);
}
__device__ __forceinline__ void phase_convert(Frame& F, int li) {
    LAS float* scr = (LAS float*)(F.lds + F.wave * 16384);
    const int gw = F.vcu * NWAVES + F.wave, NGW = F.G * NWAVES, lane = F.lane;
    const int kind = li % 3, j = li / 3;
    bf16* Wm = (bf16*)(F.ws + WS_W);
    {
        const float* w1 = F.in[I_EW1] + (size_t)li * NEXP * 1024 * 512; const float* w3 = F.in[I_EW3] + (size_t)li * NEXP * 1024 * 512; const float* w2 = F.in[I_EW2] + (size_t)li * NEXP * 512 * 1024;
        bf16* W13 = (bf16*)(F.ws + WS_W13); bf16* W2t = (bf16*)(F.ws + WS_W2);
        for (int it = gw; it < NEXP * 768; it += NGW) {
            const int e = it / 768, r = it % 768;
            if (r < 512) { const int w3sel = r >> 8, q = r & 255, kb = q >> 4, nb = q & 15, n0 = 32 * nb;
                const float* W = (w3sel ? w3 : w1) + (size_t)e * 1024 * 512;
                const size_t drow = (size_t)e * 1024 + (n0 >> 7) * 256 + (n0 & 127) + (w3sel ? 128 : 0);
                tr_item(W, 512, 64 * kb, n0, W13, drow, 1024, scr, lane); }
            else { const int q = r - 512, kb = q >> 5, nb = q & 31;
                tr_item(w2 + (size_t)e * 512 * 1024, 1024, 64 * kb, 32 * nb, W2t, (size_t)e * 1024 + 32 * nb, 512, scr, lane); }
        }
    }
    if (kind == 0) {
        const float* win = F.in[I_AWIN] + (size_t)j * 1024 * A_INW; const float* wout = F.in[I_AWOUT] + (size_t)j * 1024 * 1024;
        bf16* Win = Wm; bf16* Wout = Wm + (size_t)4128 * 1024;
        for (int it = gw; it < 16 * 128; it += NGW) tr_matrix_item(win, 1024, 4096, A_INW, Win, scr, it, lane);
        for (int it = gw; it < 16 * 32; it += NGW) tr_matrix_item(wout, 1024, 1024, 1024, Wout, scr, it, lane);
        for (int idx = gw * 64 + lane; idx < 16 * 1024; idx += NGW * 64) { const int n = idx >> 10, k = idx & 1023; Win[(size_t)(4096 + n) * 1024 + k] = f2bf(win[(size_t)k * A_INW + 4096 + n]); }
    } else if (kind == 1) {
        const float* win = F.in[I_BWIN] + (size_t)j * 1024 * 3072; const float* wout = F.in[I_BWOUT] + (size_t)j * 1024 * 1024;
        bf16* Win = Wm; bf16* Wout = Wm + (size_t)4128 * 1024;
        for (int it = gw; it < 16 * 96; it += NGW) tr_matrix_item(win, 1024, 3072, 3072, Win, scr, it, lane);
        for (int it = gw; it < 16 * 32; it += NGW) tr_matrix_item(wout, 1024, 1024, 1024, Wout, scr, it, lane);
        float* lut = (float*)(F.ws + WS_LUT); const float* rb = F.in[I_REL];
        for (int idx = gw * 64 + lane; idx < 8 * 384; idx += NGW * 64) { const int h = idx / 384, n = idx % 384;
            int bk = n; if (n >= 16) { bk = 16 + (int)(logf((float)n / 16.0f) / logf(8.0f) * 16.0f); bk = bk > 31 ? 31 : bk; }
            lut[idx] = (rb[bk * 8 + h] - rb[31 * 8 + h]) * 1.4426950408889634f; }
    } else {
        const float* win = F.in[I_CWIN] + (size_t)j * 1024 * 4096; const float* wout = F.in[I_CWOUT] + (size_t)j * 2048 * 1024;
        bf16* Win = Wm; bf16* Wout = Wm + (size_t)4128 * 1024;
        for (int it = gw; it < 16 * 128; it += NGW) tr_matrix_item(win, 1024, 4096, 4096, Win, scr, it, lane);
        for (int it = gw; it < 32 * 32; it += NGW) tr_matrix_item(wout, 2048, 1024, 1024, Wout, scr, it, lane);
        bf16* wsb = (bf16*)(F.ws + WS_WSB); const float* wsrc = F.in[I_CWS] + (size_t)j * 8 * 128 * 128;
        for (int idx = gw * 64 + lane; idx < 8 * 128 * 128; idx += NGW * 64) { const int t = (idx >> 7) & 127, s = idx & 127; wsb[idx] = f2bf(t >= s ? wsrc[idx] : 0.f); }
    }
}
__device__ __forceinline__ void phase_init(Frame& F) {
    const GAS f32x4* x = (const GAS f32x4*)F.in[I_X]; GAS v2u* h = (GAS v2u*)(F.ws + WS_H);
    const size_t n4 = (size_t)T * D / 4;
    for (size_t i = (size_t)blockIdx.x * NTHR + F.tid; i < n4; i += (size_t)F.G * NTHR) { const f32x4 v = x[i]; v2u o; o.x = pk2(v.x, v.y); o.y = pk2(v.z, v.w); h[i] = o; }
}

__device__ __forceinline__ void thin_gemm16(Frame& F, const bf16* A, const bf16* Wt, float* out) {
    const int gw = F.vcu * NWAVES + F.wave, NGW = F.G * NWAVES, lane = F.lane, fr = lane & 15, fq = lane >> 4;
    for (int rg = gw; rg < T / 16; rg += NGW) {
        const bf16* ap = A + (size_t)(rg * 16 + fr) * 1024 + 8 * fq; const bf16* bp = Wt + (size_t)fr * 1024 + 8 * fq;
        f32x4 acc = {0.f, 0.f, 0.f, 0.f};
#pragma unroll 8
        for (int s = 0; s < 32; ++s) { const bf16x8 a = *(const GAS bf16x8*)(ap + 32 * s), b = *(const GAS bf16x8*)(bp + 32 * s); acc = MFMA16(a, b, acc); }
#pragma unroll
        for (int r = 0; r < 4; ++r) out[(size_t)(rg * 16 + 4 * fq + r) * 16 + fr] = acc[r];
    }
}

__device__ __forceinline__ void ld_row_bf16(const bf16* row, int lane, float (&v)[16]) {
    const GAS v2u* p = (const GAS v2u*)row + lane;
#pragma unroll
    for (int j = 0; j < 4; ++j) { const v2u w = p[64 * j]; v[4 * j] = bflo(w.x); v[4 * j + 1] = bfhi(w.x); v[4 * j + 2] = bflo(w.y); v[4 * j + 3] = bfhi(w.y); }
}
__device__ __forceinline__ void ld_vec_f32(const float* p, int lane, float (&v)[16]) {
    const GAS f32x4* q = (const GAS f32x4*)p + lane;
#pragma unroll
    for (int j = 0; j < 4; ++j) { const f32x4 w = q[64 * j]; v[4 * j] = w.x; v[4 * j + 1] = w.y; v[4 * j + 2] = w.z; v[4 * j + 3] = w.w; }
}
__device__ __forceinline__ void ln16(float (&v)[16], const float (&g)[16], const float (&b)[16]) {
    float s = 0.f;
#pragma unroll
    for (int k = 0; k < 16; ++k) s += v[k];
    const float mean = wave_sum(s) * (1.f / 1024.f); float q = 0.f;
#pragma unroll
    for (int k = 0; k < 16; ++k) { v[k] -= mean; q += v[k] * v[k]; }
    const float rstd = 1.f / sqrtf(wave_sum(q) * (1.f / 1024.f) + LN_EPS);
#pragma unroll
    for (int k = 0; k < 16; ++k) v[k] = v[k] * rstd * g[k] + b[k];
}
__device__ __forceinline__ void st_row_bf16(bf16* row, int lane, const float (&v)[16]) {
    GAS v2u* p = (GAS v2u*)row + lane;
#pragma unroll
    for (int j = 0; j < 4; ++j) { v2u o; o.x = pk2(v[4 * j], v[4 * j + 1]); o.y = pk2(v[4 * j + 2], v[4 * j + 3]); p[64 * j] = o; }
}
__device__ __forceinline__ void phase_ln_mix(Frame& F, int li, const bf16* y, bool use_y) {
    LAS float* wr = (LAS float*)F.lds;
    LAS int* lcnt = (LAS int*)(F.lds + 65536);
    LAS int* lbase = lcnt + 16;
    LAS int* rinfo = lcnt + 64;
    LAS float* rw = (LAS float*)(rinfo + 512);
    const int tid = F.tid, lane = F.lane, wave = F.wave;
    const float* wrg = F.in[I_WR];
    for (int idx = tid; idx < 16384; idx += NTHR) { const int c = idx >> 4, e = idx & 15; wr[e * 1024 + c] = wrg[idx]; }
    float g[16], b[16];
    ld_vec_f32(F.in[I_LNMG] + li * 1024, lane, g); ld_vec_f32(F.in[I_LNMB] + li * 1024, lane, b);
    float rb[16];
#pragma unroll
    for (int e = 0; e < 16; ++e) rb[e] = F.in[I_RB][e];
    bf16* H = (bf16*)(F.ws + WS_H);
    unsigned* gcnt = F.ctl + CW_CNT + li * 1024;
    int* toke = (int*)(F.ws + WS_TOKE); int* tokp = (int*)(F.ws + WS_TOKP); float* tokw = (float*)(F.ws + WS_TOKW);
    __syncthreads();
    for (int rg = F.vcu; rg < T / 128; rg += F.G) {
        if (tid < 16) lcnt[tid] = 0;
        __syncthreads();
        for (int i = 0; i < 16; ++i) {
            const int lr = wave * 16 + i; const size_t row = (size_t)rg * 128 + lr;
            float v[16]; ld_row_bf16(H + row * 1024, lane, v);
            if (use_y) { float yv[16]; ld_row_bf16(y + row * 1024, lane, yv);
#pragma unroll
                for (int k = 0; k < 16; ++k) v[k] = DN_ALPHA * v[k] + yv[k]; }
            else {
#pragma unroll
                for (int k = 0; k < 16; ++k) v[k] = DN_ALPHA * v[k]; }
            ln16(v, g, b);
            st_row_bf16(H + row * 1024, lane, v);
            float lg[16];
#pragma unroll
            for (int e = 0; e < 16; ++e) { float p = 0.f;
#pragma unroll
                for (int j = 0; j < 4; ++j) { const f32x4 w = *(const LAS f32x4*)(wr + e * 1024 + 256 * j + 4 * lane); p += v[4 * j] * w.x + v[4 * j + 1] * w.y + v[4 * j + 2] * w.z + v[4 * j + 3] * w.w; }
                lg[e] = wave_sum(p); }
            float sc[16], sel[16];
#pragma unroll
            for (int e = 0; e < 16; ++e) { sc[e] = sigmoidf_(lg[e]); sel[e] = sc[e] + rb[e]; }
            int best = 0; float bestv = -INFINITY;
#pragma unroll
            for (int gq = 0; gq < 4; ++gq) { const float a0 = sel[4 * gq], a1 = sel[4 * gq + 1], a2 = sel[4 * gq + 2], a3 = sel[4 * gq + 3];
                const float mx = fmaxf(fmaxf(a0, a1), fmaxf(a2, a3)), mn = fminf(fminf(a0, a1), fminf(a2, a3));
                const float s4 = a0 + a1 + a2 + a3; const float mid_sum = s4 - mx - mn;
                const float second = fmaxf(fmaxf(fminf(a0, a1), fminf(a2, a3)), fminf(fmaxf(a0, a1), fmaxf(a2, a3)));
                (void)mid_sum; const float gs = mx + second;
                if (gs > bestv) { bestv = gs; best = gq; } }
            float c0 = -INFINITY, c1 = -INFINITY; int e0 = 0, e1 = 0; float s0 = 0.f, s1 = 0.f;
#pragma unroll
            for (int e = 0; e < 16; ++e) { const bool ing = (e >> 2) == best; const float x = sel[e];
                if (ing) { if (x > c0) { c1 = c0; e1 = e0; s1 = s0; c0 = x; e0 = e; s0 = sc[e]; } else if (x > c1) { c1 = x; e1 = e; s1 = sc[e]; } } }
            const float inv = 1.f / (s0 + s1);
            if (lane == 0) { const int p0 = __hip_atomic_fetch_add(&lcnt[e0], 1, __ATOMIC_RELAXED, __HIP_MEMORY_SCOPE_WORKGROUP), p1 = __hip_atomic_fetch_add(&lcnt[e1], 1, __ATOMIC_RELAXED, __HIP_MEMORY_SCOPE_WORKGROUP);
                rinfo[lr * 4] = e0; rinfo[lr * 4 + 1] = e1; rinfo[lr * 4 + 2] = p0; rinfo[lr * 4 + 3] = p1; rw[lr * 2] = s0 * inv; rw[lr * 2 + 1] = s1 * inv; }
        }
        __syncthreads();
        if (tid < 16) lbase[tid] = (int)__hip_atomic_fetch_add(gcnt + tid * 64, (unsigned)lcnt[tid], RLX_AGENT);
        __syncthreads();
        if (tid < 128) { const size_t row = (size_t)rg * 128 + tid; const int e0 = rinfo[tid * 4], e1 = rinfo[tid * 4 + 1];
            toke[row * 2] = e0; toke[row * 2 + 1] = e1; tokp[row * 2] = lbase[e0] + rinfo[tid * 4 + 2]; tokp[row * 2 + 1] = lbase[e1] + rinfo[tid * 4 + 3];
            tokw[row * 2] = rw[tid * 2]; tokw[row * 2 + 1] = rw[tid * 2 + 1]; }
        __syncthreads();
    }
}
__device__ __forceinline__ void phase_gather(Frame& F, int li, bf16* Xs) {
    LAS int* segoff = (LAS int*)F.lds;
    LAS int* cnts = segoff + 32;
    const int tid = F.tid, lane = F.lane;
    unsigned* gcnt = F.ctl + CW_CNT + li * 1024;
    if (tid < 16) cnts[tid] = (int)__hip_atomic_load(gcnt + tid * 64, RLX_AGENT);
    __syncthreads();
    if (tid == 0) { int o = 0; for (int e = 0; e < 16; ++e) { segoff[e] = o; o += (cnts[e] + 255) & ~255; } segoff[16] = o; }
    __syncthreads();
    int* misc = (int*)(F.ws + WS_MISC);
    if (blockIdx.x == 0) { const int nt = segoff[16] >> 8; if (tid == 0) misc[0] = nt;
        for (int p = tid; p < nt; p += NTHR) { int e = 0; for (int q = 1; q < 16; ++q) if (segoff[q] <= p * 256) e = q; misc[64 + p] = e; } }
    const int* toke = (const int*)(F.ws + WS_TOKE); const int* tokp = (const int*)(F.ws + WS_TOKP); int* tokr = (int*)(F.ws + WS_TOKR);
    const bf16* H = (const bf16*)(F.ws + WS_H);
    const int gw = F.vcu * NWAVES + F.wave, NGW = F.G * NWAVES;
    for (int slot = gw; slot < 2 * T; slot += NGW) {
        const int e = toke[slot], r = segoff[e] + tokp[slot];
        if (lane == 0) tokr[slot] = r;
        const GAS v4u* src = (const GAS v4u*)(H + (size_t)(slot >> 1) * 1024); GAS v4u* dst = (GAS v4u*)(Xs + (size_t)r * 1024);
        dst[lane] = src[lane]; dst[lane + 64] = src[lane + 64];
    }
    for (int pr = gw; pr < 16 * 256; pr += NGW) { const int e = pr >> 8, i = pr & 255; const int r = segoff[e] + cnts[e] + i;
        if (r < segoff[e + 1]) { GAS v4u* dst = (GAS v4u*)(Xs + (size_t)r * 1024); const v4u z = {0u, 0u, 0u, 0u}; dst[lane] = z; dst[lane + 64] = z; } }
}
__device__ __forceinline__ void phase_ln_ffn(Frame& F, int li, const bf16* Y2, bool use_m, bool last) {
    const int lane = F.lane, gw = F.vcu * NWAVES + F.wave, NGW = F.G * NWAVES;
    float g[16], b[16];
    ld_vec_f32(F.in[I_LNFG] + li * 1024, lane, g); ld_vec_f32(F.in[I_LNFB] + li * 1024, lane, b);
    bf16* H = (bf16*)(F.ws + WS_H);
    const int* tokr = (const int*)(F.ws + WS_TOKR); const float* tokw = (const float*)(F.ws + WS_TOKW);
    for (int row = gw; row < T; row += NGW) {
        float v[16]; ld_row_bf16(H + (size_t)row * 1024, lane, v);
        if (use_m) { const int r0 = tokr[2 * row], r1 = tokr[2 * row + 1]; const float w0 = tokw[2 * row], w1 = tokw[2 * row + 1];
            float a[16], c[16]; ld_row_bf16(Y2 + (size_t)r0 * 1024, lane, a); ld_row_bf16(Y2 + (size_t)r1 * 1024, lane, c);
#pragma unroll
            for (int k = 0; k < 16; ++k) v[k] = DN_ALPHA * v[k] + w0 * a[k] + w1 * c[k]; }
        else {
#pragma unroll
            for (int k = 0; k < 16; ++k) v[k] = DN_ALPHA * v[k]; }
        ln16(v, g, b);
        if (last) { GAS f32x4* o = (GAS f32x4*)(F.out + (size_t)row * 1024) + lane;
#pragma unroll
            for (int j = 0; j < 4; ++j) o[64 * j] = (f32x4){v[4 * j], v[4 * j + 1], v[4 * j + 2], v[4 * j + 3]}; }
        else st_row_bf16(H + (size_t)row * 1024, lane, v);
    }
}
namespace pg8 {
struct MoeOrder : StaticOrder {
    const int* tile_e; size_t estride;
    __device__ __forceinline__ size_t boff(const Unit& u, size_t tstepB) const { return (size_t)tile_e[u.pm] * estride + (size_t)u.pn * tstepB; }
};
struct EpiSwiGLU {
    static constexpr bool PERM = true, AFTER_DRAIN = false;
    bf16_t* O;
    __device__ __forceinline__ void operator()(const f32x4 (&acc)[2][2][4][2], const Unit& u, int wr, int wc, int fr, int fq) const {
        const int row0 = u.pm * BM + wr * 64 + fr, col0 = u.pn * 128 + wc * 32 + 8 * fq;
#pragma unroll
        for (int ai = 0; ai < 2; ++ai)
#pragma unroll
            for (int m = 0; m < 4; ++m) { bf16_t* rowp = O + (size_t)(row0 + ai * HALF + m * 16) * 512 + col0;
                float h[8];
#pragma unroll
                for (int n = 0; n < 2; ++n)
#pragma unroll
                    for (int q = 0; q < 4; ++q) { const float a = acc[ai][0][m][n][q], b = acc[ai][1][m][n][q]; h[4 * n + q] = a * __builtin_amdgcn_rcpf(1.f + __builtin_amdgcn_exp2f(-1.4426950408889634f * a)) * b; }
                u32x4 w; w.x = cvt_pk_bf16(h[0], h[1]); w.y = cvt_pk_bf16(h[2], h[3]); w.z = cvt_pk_bf16(h[4], h[5]); w.w = cvt_pk_bf16(h[6], h[7]);
                *(u32x4*)rowp = w; }
    }
};
struct EpiSplitHalo {
    static constexpr bool PERM = true, AFTER_DRAIN = false;
    bf16_t* O; size_t split_stride; bf16_t* halo; size_t halo_stride; float scale0;
    __device__ __forceinline__ void operator()(const f32x4 (&acc)[2][2][4][2], const Unit& u, int wr, int wc, int fr, int fq) const {
        const int row0 = u.pm * BM + wr * 64 + fr; const int t = (u.pn * BM) >> 10; const int colt = (u.pn * BM) & 1023;
        bf16_t* base = O + (size_t)t * split_stride; const int col0 = colt + wc * 32 + 8 * fq; const float sc = (t == 0) ? scale0 : 1.f;
#pragma unroll
        for (int ai = 0; ai < 2; ++ai)
#pragma unroll
            for (int m = 0; m < 4; ++m) { const int row = row0 + ai * HALF + m * 16; bf16_t* rowp = base + (size_t)row * 1024 + col0;
#pragma unroll
                for (int bj = 0; bj < 2; ++bj) { const f32x4 v0 = acc[ai][bj][m][0] * sc, v1 = acc[ai][bj][m][1] * sc;
                    u32x4 w; w.x = cvt_pk_bf16(v0[0], v0[1]); w.y = cvt_pk_bf16(v0[2], v0[3]); w.z = cvt_pk_bf16(v1[0], v1[1]); w.w = cvt_pk_bf16(v1[2], v1[3]);
                    *(u32x4*)(rowp + bj * HALF) = w;
                    if (halo != nullptr && m == 3 && fr >= 13 && t < 3) *(u32x4*)(halo + (size_t)t * halo_stride + ((size_t)(row >> 6) * 3 + ((row & 63) - 61)) * 1024 + col0 + bj * HALF) = w; } }
    }
};
}

namespace dn {
constexpr int QS = 272, TS = 144;
constexpr int L_QS = 0, L_KS = 17408, L_KST = 34816, L_VST = 53248, L_AM = 71680, L_AT = 88064, L_T1 = 97280, L_T2 = 106496, L_TAB = 115712;
}
__device__ __forceinline__ void ld_frag8(const LAS unsigned char* rowp, int c1, float (&x)[8]) {
    const v2u lo = *(const LAS v2u*)(rowp + 2 * c1), hi = *(const LAS v2u*)(rowp + 2 * c1 + 32);
    x[0] = bflo(lo.x); x[1] = bfhi(lo.x); x[2] = bflo(lo.y); x[3] = bfhi(lo.y); x[4] = bflo(hi.x); x[5] = bfhi(hi.x); x[6] = bflo(hi.y); x[7] = bfhi(hi.y);
}
__device__ __forceinline__ v4u pack8(const float (&x)[8]) { v4u o; o.x = pk2(x[0], x[1]); o.y = pk2(x[2], x[3]); o.z = pk2(x[4], x[5]); o.w = pk2(x[6], x[7]); return o; }

__device__ __forceinline__ void phase_delta_local(Frame& F, int j) {
    using namespace dn;
    LAS unsigned char* L = F.lds;
    LAS float* gcs = (LAS float*)(L + L_TAB); LAS float* betas = gcs + 64; LAS float* egs = gcs + 128; LAS float* eks = gcs + 192;
    LAS float* Am = (LAS float*)(L + L_AM);
    const int tid = F.tid, lane = F.lane, wave = F.wave, fr = lane & 15, fq = lane >> 4;
    bf16* Qp = (bf16*)(F.ws + WS_R); bf16* Kp = (bf16*)(F.ws + WS_R + TD2); bf16* Vp = (bf16*)(F.ws + WS_R + 2 * TD2);
    bf16* Ub = (bf16*)(F.ws + WS_R + 4 * TD2); bf16* ATb = (bf16*)(F.ws + WS_R + 5 * TD2);
    const bf16* halo = (const bf16*)(F.ws + WS_HALO); const float* AB = (const float*)(F.ws + WS_AB);
    const float* convw = F.in[I_ACONV] + (size_t)j * 4 * 3072; float* EGL = (float*)(F.ws + WS_EGL);
    for (int unit = F.vcu; unit < NB * 8 * 128; unit += F.G) {
        const int n = unit & 127, h = (unit >> 7) & 7, b = unit >> 10; const int ch = b * 128 + n; const size_t c0 = (size_t)ch * 64;
#pragma unroll 1
        for (int x = 0; x < 3; ++x) {
            const bf16* X = x == 0 ? Qp : (x == 1 ? Kp : Vp); const bf16* HX = halo + (size_t)x * HALO_T;
#pragma unroll
            for (int ii = 0; ii < 2; ++ii) {
                const int it = tid + NTHR * ii, r = it >> 4, gq = it & 15, col = h * 128 + gq * 8;
                float acc[8] = {0.f, 0.f, 0.f, 0.f, 0.f, 0.f, 0.f, 0.f};
#pragma unroll
                for (int jj = 0; jj < 4; ++jj) { const int rr = r - 3 + jj; v4u w = {0u, 0u, 0u, 0u};
                    if (rr >= 0) w = *(const GAS v4u*)(X + (c0 + rr) * 1024 + col);
                    else if (n > 0) w = *(const GAS v4u*)(HX + ((size_t)(ch - 1) * 3 + (rr + 3)) * 1024 + col);
                    const GAS f32x4* cw = (const GAS f32x4*)(convw + (size_t)jj * 3072 + x * 1024 + col); const f32x4 w0 = cw[0], w1 = cw[1];
                    acc[0] += bflo(w.x) * w0.x; acc[1] += bfhi(w.x) * w0.y; acc[2] += bflo(w.y) * w0.z; acc[3] += bfhi(w.y) * w0.w;
                    acc[4] += bflo(w.z) * w1.x; acc[5] += bfhi(w.z) * w1.y; acc[6] += bflo(w.w) * w1.z; acc[7] += bfhi(w.w) * w1.w; }
                float ss = 0.f;
#pragma unroll
                for (int e = 0; e < 8; ++e) { acc[e] = siluf_(acc[e]); ss += acc[e] * acc[e]; }
                if (x < 2) { ss += __shfl_xor(ss, 1); ss += __shfl_xor(ss, 2); ss += __shfl_xor(ss, 4); ss += __shfl_xor(ss, 8);
                    float rs = 1.f / sqrtf(ss + 1e-6f); if (x == 0) rs *= 0.08838834764831845f;
#pragma unroll
                    for (int e = 0; e < 8; ++e) acc[e] *= rs; }
                const v4u pk = pack8(acc);
                if (x == 0) *(LAS v4u*)(L + L_QS + r * QS + gq * 16) = pk;
                if (x == 1) *(LAS v4u*)(L + L_KS + r * QS + gq * 16) = pk;
                if (x >= 1) { LAS unsigned char* tb = L + (x == 1 ? L_KST : L_VST) + (gq * 8) * TS + r * 2;
                    const unsigned ww[4] = {pk.x, pk.y, pk.z, pk.w};
#pragma unroll
                    for (int e = 0; e < 4; ++e) { *(LAS bf16*)(tb + (2 * e) * TS) = (bf16)(ww[e] & 0xffffu); *(LAS bf16*)(tb + (2 * e + 1) * TS) = (bf16)(ww[e] >> 16); } }
            }
        }
        if (wave == 0) {
            const float a = AB[(c0 + lane) * 16 + h], bb = AB[(c0 + lane) * 16 + 8 + h];
            const float xs = a + F.in[I_ADT][j * 8 + h]; const float sp = xs > 20.f ? xs : log1pf(__expf(xs));
            float gi = -__expf(F.in[I_AALOG][j * 8 + h]) * sp;
#pragma unroll
            for (int o = 1; o < 64; o <<= 1) { const float t = __shfl_up(gi, o); if (lane >= o) gi += t; }
            const float gl = __shfl(gi, 63);
            gcs[lane] = gi; betas[lane] = sigmoidf_(bb); egs[lane] = __expf(gi); eks[lane] = __expf(gl - gi);
            if (lane == 0) EGL[(b * 8 + h) * 128 + n] = __expf(gl);
        }
        __syncthreads();
#pragma unroll
        for (int tt = 0; tt < 2; ++tt) {
            const int id = 2 * wave + tt, it = id >> 2, jt = id & 3;
            f32x4 kk = {0.f, 0.f, 0.f, 0.f}, qk = {0.f, 0.f, 0.f, 0.f};
#pragma unroll
            for (int s = 0; s < 4; ++s) {
                const bf16x8 bk = *(const LAS bf16x8*)(L + L_KS + (16 * jt + fr) * QS + (32 * s + 8 * fq) * 2);
                const bf16x8 ak = *(const LAS bf16x8*)(L + L_KS + (16 * it + fr) * QS + (32 * s + 8 * fq) * 2);
                const bf16x8 aq = *(const LAS bf16x8*)(L + L_QS + (16 * it + fr) * QS + (32 * s + 8 * fq) * 2);
                kk = MFMA16(ak, bk, kk); qk = MFMA16(aq, bk, qk); }
            const int jc = 16 * jt + fr; const float gj = gcs[jc];
#pragma unroll
            for (int r = 0; r < 4; ++r) { const int i = 16 * it + 4 * fq + r; const float dec = __expf(fminf(gcs[i] - gj, 0.f));
                Am[i * 64 + jc] = (i > jc) ? betas[i] * kk[r] * dec : 0.f;
                *(LAS bf16*)(L + L_AT + i * TS + jc * 2) = f2bf((i >= jc) ? qk[r] * dec : 0.f); }
        }
        __syncthreads();
        if (wave == 0) {
            LAS float* Tl = (LAS float*)(L + L_KS);
#pragma unroll 1
            for (int bi = 0; bi < 4; ++bi) {
                float acc[16];
#pragma unroll
                for (int r = 0; r < 16; ++r) acc[r] = (lane == 16 * bi + r) ? 1.f : 0.f;
#pragma unroll 1
                for (int j4 = 0; j4 < 4 * bi; ++j4) {
                    const float t0 = Tl[(4 * j4 + 0) * 64 + lane], t1 = Tl[(4 * j4 + 1) * 64 + lane], t2 = Tl[(4 * j4 + 2) * 64 + lane], t3 = Tl[(4 * j4 + 3) * 64 + lane];
#pragma unroll
                    for (int r = 0; r < 16; ++r) { const f32x4 a = *(const LAS f32x4*)(Am + (16 * bi + r) * 64 + 4 * j4); acc[r] -= (a.x * t0 + a.y * t1) + (a.z * t2 + a.w * t3); }
                }
                float Tr[16];
#pragma unroll
                for (int r = 0; r < 16; ++r) {
                    float t0 = acc[r], t1 = 0.f;
#pragma unroll
                    for (int q4 = 0; q4 < (r + 3) / 4; ++q4) { const f32x4 a = *(const LAS f32x4*)(Am + (16 * bi + r) * 64 + 16 * bi + 4 * q4);
                        if (4 * q4 + 0 < r) t0 -= a.x * Tr[4 * q4 + 0];
                        if (4 * q4 + 1 < r) t1 -= a.y * Tr[4 * q4 + 1];
                        if (4 * q4 + 2 < r) t0 -= a.z * Tr[4 * q4 + 2];
                        if (4 * q4 + 3 < r) t1 -= a.w * Tr[4 * q4 + 3]; }
                    Tr[r] = t0 + t1; Tl[(16 * bi + r) * 64 + lane] = Tr[r];
                }
            }
            const float bc = betas[lane], bec = bc * egs[lane];
#pragma unroll 4
            for (int i = 0; i < 64; ++i) { const float t = Tl[i * 64 + lane]; *(LAS bf16*)(L + L_T1 + i * TS + lane * 2) = f2bf(t * bc); *(LAS bf16*)(L + L_T2 + i * TS + lane * 2) = f2bf(t * bec); }
        } else {
            for (int f = wave - 1; f < 40; f += 7) {
                float x[8]; GAS v4u* dst;
                if (f < 16) { const int mt = f >> 2, s = f & 3, row = 16 * mt + fr; ld_frag8(L + L_QS + row * QS, 32 * s + 4 * fq, x); const float e = egs[row];
#pragma unroll
                    for (int q = 0; q < 8; ++q) x[q] *= e;
                    dst = (GAS v4u*)(Qp + (c0 + 4 * f + fq) * 1024 + h * 128 + fr * 8); }
                else if (f < 32) { const int g = f - 16, mt = g >> 1, s = g & 1, row = 16 * mt + fr, c1 = 32 * s + 4 * fq; ld_frag8(L + L_KST + row * TS, c1, x);
#pragma unroll
                    for (int q = 0; q < 8; ++q) x[q] *= eks[c1 + (q & 3) + 16 * (q >> 2)];
                    dst = (GAS v4u*)(Kp + (c0 + 4 * g + fq) * 1024 + h * 128 + fr * 8); }
                else { const int g = f - 32, mt = g >> 1, s = g & 1, row = 16 * mt + fr; ld_frag8(L + L_AT + row * TS, 32 * s + 4 * fq, x);
                    dst = (GAS v4u*)(ATb + ((size_t)unit * 8 + g) * 512 + lane * 8); }
                *dst = pack8(x);
            }
        }
        __syncthreads();
        {
            const int nt = wave; bf16x8 bv[2], bk[2];
#pragma unroll
            for (int s = 0; s < 2; ++s) { bv[s] = *(const LAS bf16x8*)(L + L_VST + (16 * nt + fr) * TS + (32 * s + 8 * fq) * 2); bk[s] = *(const LAS bf16x8*)(L + L_KST + (16 * nt + fr) * TS + (32 * s + 8 * fq) * 2); }
#pragma unroll
            for (int mt = 0; mt < 4; ++mt) {
                f32x4 u = {0.f, 0.f, 0.f, 0.f}, w = {0.f, 0.f, 0.f, 0.f};
#pragma unroll
                for (int s = 0; s < 2; ++s) { const bf16x8 a1 = *(const LAS bf16x8*)(L + L_T1 + (16 * mt + fr) * TS + (32 * s + 8 * fq) * 2), a2 = *(const LAS bf16x8*)(L + L_T2 + (16 * mt + fr) * TS + (32 * s + 8 * fq) * 2);
                    u = MFMA16(a1, bv[s], u); w = MFMA16(a2, bk[s], w); }
                v2u uo; uo.x = pk2(u[0], u[1]); uo.y = pk2(u[2], u[3]);
                *(GAS v2u*)(Ub + (((size_t)unit * 8 + nt) * 4 + mt) * 256 + lane * 4) = uo;
#pragma unroll
                for (int r = 0; r < 4; ++r) *(LAS bf16*)(L + L_QS + (16 * mt + 4 * fq + r) * QS + (16 * nt + fr) * 2) = f2bf(w[r]);
            }
        }
        __syncthreads();
#pragma unroll
        for (int k = 0; k < 2; ++k) { const int f = wave * 2 + k, mt = f >> 2, s = f & 3, row = 16 * mt + fr; float x[8]; ld_frag8(L + L_QS + row * QS, 32 * s + 4 * fq, x);
            *(GAS v4u*)(Vp + (c0 + 4 * f + fq) * 1024 + h * 128 + fr * 8) = pack8(x); }
        __syncthreads();
    }
}
__device__ __forceinline__ void phase_delta_scan(Frame& F) {
    if (F.wave != 0) return;
    const int lane = F.lane, fr = lane & 15, fq = lane >> 4;
    const int bh = F.vcu >> 3, sl = F.vcu & 7, h = bh & 7; const size_t cb = (size_t)(bh >> 3) * SEQ;
    if (bh >= 32) return;
    const bf16* Qp = (const bf16*)(F.ws + WS_R); const bf16* Kp = (const bf16*)(F.ws + WS_R + TD2); const bf16* Vp = (const bf16*)(F.ws + WS_R + 2 * TD2);
    const bf16* Ub = (const bf16*)(F.ws + WS_R + 4 * TD2); const bf16* ATb = (const bf16*)(F.ws + WS_R + 5 * TD2); bf16* Ob = (bf16*)(F.ws + WS_R + 5 * TD2 + 32 * MiB);
    const float* EGL = (const float*)(F.ws + WS_EGL) + bh * 128;
    LAS unsigned char* L = F.lds;
    constexpr int SLOT = 57344;
    const size_t lrow = (size_t)fq * 1024 + h * 128 + fr * 8;
#define DN_DMA(n_, slot_) do { const size_t r0_ = cb + (size_t)(n_) * 64; LAS unsigned char* d_ = L + (slot_) * SLOT; \
        _Pragma("unroll") for (int f = 0; f < 16; ++f) __builtin_amdgcn_global_load_lds((const unsigned*)(Vp + (r0_ + 4 * f) * 1024 + lrow), (LAS unsigned*)(d_ + f * 1024), 16, 0, 0); \
        _Pragma("unroll") for (int f = 0; f < 16; ++f) __builtin_amdgcn_global_load_lds((const unsigned*)(Qp + (r0_ + 4 * f) * 1024 + lrow), (LAS unsigned*)(d_ + 16384 + f * 1024), 16, 0, 0); \
        _Pragma("unroll") for (int f = 0; f < 16; ++f) __builtin_amdgcn_global_load_lds((const unsigned*)(Kp + (r0_ + 4 * f) * 1024 + lrow), (LAS unsigned*)(d_ + 32768 + f * 1024), 16, 0, 0); \
        const bf16* at_ = ATb + ((size_t)(bh * 128 + (n_)) * 8) * 512 + lane * 8; \
        _Pragma("unroll") for (int f = 0; f < 8; ++f) __builtin_amdgcn_global_load_lds((const unsigned*)(at_ + f * 512), (LAS unsigned*)(d_ + 49152 + f * 1024), 16, 0, 0); } while (0)
#define DN_LDU(dst_, n_) do { const bf16* u_ = Ub + (((size_t)(bh * 128 + (n_)) * 8 + sl) * 4) * 256 + lane * 4; \
        _Pragma("unroll") for (int t = 0; t < 4; ++t) dst_[t] = *(const GAS v2u*)(u_ + t * 256); } while (0)
    f32x4 Sa[8];
#pragma unroll
    for (int m = 0; m < 8; ++m) Sa[m] = (f32x4){0.f, 0.f, 0.f, 0.f};
    bf16x8 Sb[4];
#pragma unroll
    for (int s = 0; s < 4; ++s) Sb[s] = (bf16x8){0, 0, 0, 0, 0, 0, 0, 0};
    v2u ucur[4], unxt[4];
    DN_DMA(0, 0); DN_LDU(ucur, 0);
    for (int n = 0; n < 128; ++n) {
        const int slot = n & 1; const int nn = n + 1 < 128 ? n + 1 : n;
        DN_DMA(nn, slot ^ 1); DN_LDU(unxt, nn);
        asm volatile("s_waitcnt vmcnt(60)" ::: "memory");
        const LAS unsigned char* P = L + slot * SLOT + lane * 16;
        const float egl = EGL[n];
        f32x4 ws_[4], qs_[4];
#pragma unroll
        for (int t = 0; t < 4; ++t) { ws_[t] = (f32x4){0.f, 0.f, 0.f, 0.f}; qs_[t] = (f32x4){0.f, 0.f, 0.f, 0.f};
#pragma unroll
            for (int s = 0; s < 4; ++s) { const bf16x8 wf = *(const LAS bf16x8*)(P + (t * 4 + s) * 1024), qf = *(const LAS bf16x8*)(P + 16384 + (t * 4 + s) * 1024);
                ws_[t] = MFMA16(wf, Sb[s], ws_[t]); qs_[t] = MFMA16(qf, Sb[s], qs_[t]); } }
        f32x4 vn[4];
#pragma unroll
        for (int t = 0; t < 4; ++t) { vn[t][0] = bflo(ucur[t].x) - ws_[t][0]; vn[t][1] = bfhi(ucur[t].x) - ws_[t][1]; vn[t][2] = bflo(ucur[t].y) - ws_[t][2]; vn[t][3] = bfhi(ucur[t].y) - ws_[t][3]; }
        bf16x8 vb[2];
#pragma unroll
        for (int s = 0; s < 2; ++s) { v4u p; p.x = pk2(vn[2 * s][0], vn[2 * s][1]); p.y = pk2(vn[2 * s][2], vn[2 * s][3]); p.z = pk2(vn[2 * s + 1][0], vn[2 * s + 1][1]); p.w = pk2(vn[2 * s + 1][2], vn[2 * s + 1][3]); vb[s] = __builtin_bit_cast(bf16x8, p); }
#pragma unroll
        for (int t = 0; t < 4; ++t) {
#pragma unroll
            for (int s = 0; s < 2; ++s) { const bf16x8 af = *(const LAS bf16x8*)(P + 49152 + (t * 2 + s) * 1024); qs_[t] = MFMA16(af, vb[s], qs_[t]); }
#pragma unroll
            for (int r = 0; r < 4; ++r) Ob[(cb + (size_t)n * 64 + 16 * t + 4 * fq + r) * 1024 + h * 128 + sl * 16 + fr] = f2bf(qs_[t][r]); }
#pragma unroll
        for (int m = 0; m < 8; ++m) { Sa[m] = Sa[m] * egl;
#pragma unroll
            for (int s = 0; s < 2; ++s) { const bf16x8 kf = *(const LAS bf16x8*)(P + 32768 + (m * 2 + s) * 1024); Sa[m] = MFMA16(kf, vb[s], Sa[m]); } }
#pragma unroll
        for (int s = 0; s < 4; ++s) { v4u p; p.x = pk2(Sa[2 * s][0], Sa[2 * s][1]); p.y = pk2(Sa[2 * s][2], Sa[2 * s][3]); p.z = pk2(Sa[2 * s + 1][0], Sa[2 * s + 1][1]); p.w = pk2(Sa[2 * s + 1][2], Sa[2 * s + 1][3]); Sb[s] = __builtin_bit_cast(bf16x8, p); }
#pragma unroll
        for (int t = 0; t < 4; ++t) ucur[t] = unxt[t];
        asm volatile("s_waitcnt lgkmcnt(0)" ::: "memory");
    }
    asm volatile("s_waitcnt vmcnt(0)" ::: "memory");
#undef DN_DMA
#undef DN_LDU
}
__device__ __forceinline__ void phase_delta_normgate(Frame& F, int j, const bf16* O, const bf16* G, bf16* ON) {
    const int lane = F.lane, gw = F.vcu * NWAVES + F.wave, NGW = F.G * NWAVES;
    float ng[16];
#pragma unroll
    for (int k = 0; k < 16; ++k) ng[k] = F.in[I_ANG][j * 128 + (lane & 7) * 16 + k];
    for (int row = gw; row < T; row += NGW) {
        const GAS v4u* op = (const GAS v4u*)(O + (size_t)row * 1024 + lane * 16); const GAS v4u* gp = (const GAS v4u*)(G + (size_t)row * 1024 + lane * 16);
        const v4u o0 = op[0], o1 = op[1], g0 = gp[0], g1 = gp[1];
        const unsigned ow[8] = {o0.x, o0.y, o0.z, o0.w, o1.x, o1.y, o1.z, o1.w}, gwv[8] = {g0.x, g0.y, g0.z, g0.w, g1.x, g1.y, g1.z, g1.w};
        float v[16], gt[16]; float ss = 0.f;
#pragma unroll
        for (int k = 0; k < 8; ++k) { v[2 * k] = bflo(ow[k]); v[2 * k + 1] = bfhi(ow[k]); gt[2 * k] = bflo(gwv[k]); gt[2 * k + 1] = bfhi(gwv[k]); ss += v[2 * k] * v[2 * k] + v[2 * k + 1] * v[2 * k + 1]; }
        ss += __shfl_xor(ss, 1); ss += __shfl_xor(ss, 2); ss += __shfl_xor(ss, 4);
        const float rs = 1.f / sqrtf(ss * (1.f / 128.f) + LN_EPS);
        unsigned w[8];
#pragma unroll
        for (int k = 0; k < 8; ++k) w[k] = pk2(v[2 * k] * rs * ng[2 * k] * siluf_(gt[2 * k]), v[2 * k + 1] * rs * ng[2 * k + 1] * siluf_(gt[2 * k + 1]));
        GAS v4u* dp = (GAS v4u*)(ON + (size_t)row * 1024 + lane * 16);
        dp[0] = (v4u){w[0], w[1], w[2], w[3]}; dp[1] = (v4u){w[4], w[5], w[6], w[7]};
    }
}
__device__ __forceinline__ void phase_diff_combine(Frame& F, int j, int li, const bf16* O0, const bf16* O1, bf16* ON) {
    const int lane = F.lane, gw = F.vcu * NWAVES + F.wave, NGW = F.G * NWAVES;
    const float* lam = F.in[I_BLAM] + j * 256;
    float p01 = lam[lane] * lam[64 + lane], p23 = lam[128 + lane] * lam[192 + lane];
    p01 = wave_sum(p01); p23 = wave_sum(p23);
    const float lambda_init = 0.8f - 0.6f * expf(-0.3f * (float)li);
    const float lamf = expf(p01) - expf(p23) + lambda_init, osc = 1.f - lambda_init;
    float ng[16];
#pragma unroll
    for (int k = 0; k < 16; ++k) ng[k] = F.in[I_BNG][j * 128 + (lane & 7) * 16 + k] * osc;
    for (int row = gw; row < T; row += NGW) {
        const GAS v4u* ap = (const GAS v4u*)(O0 + (size_t)row * 1024 + lane * 16); const GAS v4u* bp = (const GAS v4u*)(O1 + (size_t)row * 1024 + lane * 16);
        const v4u a0 = ap[0], a1 = ap[1], b0 = bp[0], b1 = bp[1];
        const unsigned aw[8] = {a0.x, a0.y, a0.z, a0.w, a1.x, a1.y, a1.z, a1.w}, bw[8] = {b0.x, b0.y, b0.z, b0.w, b1.x, b1.y, b1.z, b1.w};
        float v[16]; float ss = 0.f;
#pragma unroll
        for (int k = 0; k < 8; ++k) { v[2 * k] = bflo(aw[k]) - lamf * bflo(bw[k]); v[2 * k + 1] = bfhi(aw[k]) - lamf * bfhi(bw[k]); ss += v[2 * k] * v[2 * k] + v[2 * k + 1] * v[2 * k + 1]; }
        ss += __shfl_xor(ss, 1); ss += __shfl_xor(ss, 2); ss += __shfl_xor(ss, 4);
        const float rs = 1.f / sqrtf(ss * (1.f / 128.f) + LN_EPS);
        unsigned w[8];
#pragma unroll
        for (int k = 0; k < 8; ++k) w[k] = pk2(v[2 * k] * rs * ng[2 * k], v[2 * k + 1] * rs * ng[2 * k + 1]);
        GAS v4u* dp = (GAS v4u*)(ON + (size_t)row * 1024 + lane * 16);
        dp[0] = (v4u){w[0], w[1], w[2], w[3]}; dp[1] = (v4u){w[4], w[5], w[6], w[7]};
    }
}
__device__ __forceinline__ void phase_gmlp_spatial(Frame& F, int j, const bf16* U, const bf16* V, bf16* UG) {
    LAS unsigned char* L = F.lds;
    LAS float* st = (LAS float*)(L + 72 * 1024);
    constexpr int VT = 272;
    const int tid = F.tid, lane = F.lane, wave = F.wave, fr = lane & 15, fq = lane >> 4;
    const float* lng = F.in[I_CLNG] + j * 2048; const float* lnb = F.in[I_CLNB] + j * 2048; const float* bs = F.in[I_CBS] + j * 8 * 128;
    const bf16* wsb = (const bf16*)(F.ws + WS_WSB);
    for (int unit = F.vcu; unit < T / 128; unit += F.G) {
        const size_t R0 = (size_t)unit * 128;
        for (int i = 0; i < 16; ++i) { const int lr = wave * 16 + i; const GAS v4u* p = (const GAS v4u*)(V + (R0 + lr) * 2048) + lane;
            float x[32]; float s = 0.f;
#pragma unroll
            for (int q = 0; q < 4; ++q) { const v4u w = p[64 * q]; const unsigned ww[4] = {w.x, w.y, w.z, w.w};
#pragma unroll
                for (int e = 0; e < 4; ++e) { x[8 * q + 2 * e] = bflo(ww[e]); x[8 * q + 2 * e + 1] = bfhi(ww[e]); s += x[8 * q + 2 * e] + x[8 * q + 2 * e + 1]; } }
            const float mean = wave_sum(s) * (1.f / 2048.f); float qv = 0.f;
#pragma unroll
            for (int k = 0; k < 32; ++k) { const float d = x[k] - mean; qv += d * d; }
            const float rstd = 1.f / sqrtf(wave_sum(qv) * (1.f / 2048.f) + LN_EPS);
            if (lane == 0) { st[2 * lr] = mean; st[2 * lr + 1] = rstd; } }
        __syncthreads();
        for (int g = 0; g < 8; ++g) {
#pragma unroll 2
            for (int k = 0; k < 8; ++k) { const int it = tid + NTHR * k, s = it & 127, cg = it >> 7, col = g * 256 + cg * 8;
                const v4u w = *(const GAS v4u*)(V + (R0 + s) * 2048 + col); const unsigned ww[4] = {w.x, w.y, w.z, w.w};
                const float mean = st[2 * s], rstd = st[2 * s + 1];
                const GAS f32x4* gp = (const GAS f32x4*)(lng + col); const GAS f32x4* bp = (const GAS f32x4*)(lnb + col);
                const f32x4 g0 = gp[0], g1 = gp[1], b0 = bp[0], b1 = bp[1];
                const float gg[8] = {g0.x, g0.y, g0.z, g0.w, g1.x, g1.y, g1.z, g1.w}, bb[8] = {b0.x, b0.y, b0.z, b0.w, b1.x, b1.y, b1.z, b1.w};
                LAS unsigned char* tb = L + (cg * 8) * VT + s * 2;
#pragma unroll
                for (int e = 0; e < 4; ++e) { *(LAS bf16*)(tb + (2 * e) * VT) = f2bf((bflo(ww[e]) - mean) * rstd * gg[2 * e] + bb[2 * e]); *(LAS bf16*)(tb + (2 * e + 1) * VT) = f2bf((bfhi(ww[e]) - mean) * rstd * gg[2 * e + 1] + bb[2 * e + 1]); } }
            bf16x8 af[4];
#pragma unroll
            for (int s = 0; s < 4; ++s) af[s] = *(const GAS bf16x8*)(wsb + ((size_t)g * 128 + 16 * wave + fr) * 128 + 32 * s + 8 * fq);
            __syncthreads();
            f32x4 acc[16];
#pragma unroll
            for (int nt = 0; nt < 16; ++nt) { acc[nt] = (f32x4){0.f, 0.f, 0.f, 0.f};
#pragma unroll
                for (int s = 0; s < 4; ++s) { const bf16x8 bfr = *(const LAS bf16x8*)(L + (16 * nt + fr) * VT + (32 * s + 8 * fq) * 2); acc[nt] = MFMA16(af[s], bfr, acc[nt]); } }
            float bt[4];
#pragma unroll
            for (int r = 0; r < 4; ++r) bt[r] = bs[g * 128 + 16 * wave + 4 * fq + r];
            __syncthreads();
#pragma unroll
            for (int nt = 0; nt < 16; ++nt)
#pragma unroll
                for (int r = 0; r < 4; ++r) *(LAS bf16*)(L + (16 * wave + 4 * fq + r) * 528 + (16 * nt + fr) * 2) = f2bf(acc[nt][r] + bt[r]);
            __syncthreads();
#pragma unroll 2
            for (int k = 0; k < 8; ++k) { const int it = tid + NTHR * k, t = it >> 5, cg = it & 31; const size_t go = (R0 + t) * 2048 + g * 256 + cg * 8;
                const v4u m = *(const LAS v4u*)(L + t * 528 + cg * 16); const v4u u = *(const GAS v4u*)(U + go);
                v4u o; o.x = pk2(bflo(m.x) * bflo(u.x), bfhi(m.x) * bfhi(u.x)); o.y = pk2(bflo(m.y) * bflo(u.y), bfhi(m.y) * bfhi(u.y));
                o.z = pk2(bflo(m.z) * bflo(u.z), bfhi(m.z) * bfhi(u.z)); o.w = pk2(bflo(m.w) * bflo(u.w), bfhi(m.w) * bfhi(u.w));
                *(GAS v4u*)(UG + go) = o; }
            __syncthreads();
        }
    }
}
#ifndef MK_FUSED
#define MK_FUSED 1
#endif
#ifndef MK_ENABLE
#define MK_ENABLE 15
#endif
constexpr int PH_PER_LAYER = 16, NPH = 1 + DEPTH * PH_PER_LAYER;
struct Args { const float* in[27]; float* out; unsigned char* ws; int ph_lo, ph_hi; };
__host__ __device__ inline bool phase_valid(int p) {
    if (p == 0) return true;
    const int li = (p - 1) / PH_PER_LAYER, lp = (p - 1) % PH_PER_LAYER, kind = li % 3;
    if (lp == 0) return true;
    if (lp >= 1 && lp <= 5) { if (!((MK_ENABLE >> kind) & 1)) return false; return kind == 0 ? true : (kind == 1 ? lp <= 4 : lp <= 3); }
    if (lp == 8 || lp == 12) return true;
    if (lp >= 9 && lp <= 11) return (MK_ENABLE & 8) != 0;
    return false;
}
#define IN(p) (lo <= (p) && (p) < hi && phase_valid(p))
#define SEAM() do { if (fused) xcd_barrier(bar); } while (0)
template <int LI> __device__ __forceinline__ void layer_body(Frame& F, const XcdBarrier& bar, unsigned char* ldsg, const int lo, const int hi, const bool fused) {
    bf16* H = (bf16*)(F.ws + WS_H); bf16* Wm = (bf16*)(F.ws + WS_W); bf16* Wout = Wm + (size_t)4128 * 1024;
    unsigned char* R = F.ws + WS_R;
        constexpr int li = LI, kind = LI % 3, j = LI / 3, pb = 1 + LI * PH_PER_LAYER;
        const bool mix_on = ((MK_ENABLE >> kind) & 1) != 0, moe_on = (MK_ENABLE & 8) != 0;
        if (IN(pb + 0)) { phase_convert(F, li); SEAM(); }
        bf16* Y = (bf16*)(R + (kind == 1 ? 0 : 2 * TD2));
        if (kind != 2 && IN(pb + 1)) {
            const int N = (kind == 0) ? 4096 : 3072;
            pg8::Gemm g{H, Wm, T, N, D}; pg8::StaticOrder S; S.init(T, N, F.G, (int)blockIdx.x);
            pg8::EpiSplitHalo E{(bf16*)R, (size_t)T * D, kind == 0 ? (bf16*)(F.ws + WS_HALO) : nullptr, HALO_T, kind == 0 ? 1.f : attn_body::C2};
            pg8::gemm_phase<pg8::EpiSplitHalo, pg8::StaticOrder, true, true>(F.lds, g, S, E);
            if (kind == 0) thin_gemm16(F, H, Wm + (size_t)4096 * 1024, (float*)(F.ws + WS_AB));
            SEAM();
        }
        if (kind == 0) {
            if (IN(pb + 2)) { phase_delta_local(F, j); SEAM(); }
            if (IN(pb + 3)) { phase_delta_scan(F); SEAM(); }
            if (IN(pb + 4)) { phase_delta_normgate(F, j, (const bf16*)(R + 5 * TD2 + 32 * MiB), (const bf16*)(R + 3 * TD2), (bf16*)(R + TD2)); SEAM(); }
        } else if (kind == 1) {
            if (IN(pb + 2)) {
                const attn_body::AttnTensors AT{(const attn_body::bf16*)R, (const attn_body::bf16*)(R + TD2), (const attn_body::bf16*)(R + 2 * TD2), (attn_body::bf16*)(R + 3 * TD2), (attn_body::bf16*)(R + 4 * TD2), (const float*)(F.ws + WS_LUT)};
                const attn_body::StaticOrder S((int)F.G, (int)blockIdx.x);
                attn_body::attn_phase<attn_body::StaticOrder>((char*)ldsg, AT, S);
                SEAM();
            }
            if (IN(pb + 3)) { phase_diff_combine(F, j, li, (const bf16*)(R + 3 * TD2), (const bf16*)(R + 4 * TD2), (bf16*)(R + 5 * TD2)); SEAM(); }
        } else {
            if (IN(pb + 1)) {
                pg8::Gemm g{H, Wm, T, 4096, D}; pg8::StaticOrder S; S.init(T, 4096, F.G, (int)blockIdx.x);
                pg8::EpiBf16<1> E{(bf16*)R, 2048, nullptr, 2048, (size_t)T * 2048, 1.f};
                pg8::gemm_phase<pg8::EpiBf16<1>, pg8::StaticOrder, true, true>(F.lds, g, S, E);
                SEAM();
            }
            if (IN(pb + 2)) { phase_gmlp_spatial(F, j, (const bf16*)R, (const bf16*)(R + 2 * TD2), (bf16*)(R + 4 * TD2)); SEAM(); }
        }
        { const int po = pb + (kind == 0 ? 5 : (kind == 1 ? 4 : 3));
          if (IN(po)) {
            const bf16* A = (const bf16*)(R + (kind == 0 ? TD2 : (kind == 1 ? 5 * TD2 : 4 * TD2))); const int K = (kind == 2) ? 2048 : 1024;
            pg8::Gemm g{A, Wout, T, D, K}; pg8::StaticOrder S; S.init(T, D, F.G, (int)blockIdx.x);
            pg8::EpiBf16<0> E{Y, D, nullptr, 0, 0, 1.f};
            pg8::gemm_phase<pg8::EpiBf16<0>, pg8::StaticOrder, true, true>(F.lds, g, S, E);
            SEAM();
          } }
        if (IN(pb + 8)) { phase_ln_mix(F, li, Y, mix_on); SEAM(); }
        bf16* Xs = (bf16*)R; bf16* H1 = (bf16*)(R + 136 * MiB); bf16* Y2 = (bf16*)(R + 204 * MiB);
        const int* misc = (const int*)(F.ws + WS_MISC);
        if (IN(pb + 9)) { phase_gather(F, li, Xs); SEAM(); }
        if (IN(pb + 10)) {
            const int nt = __builtin_amdgcn_readfirstlane(misc[0]);
            pg8::Gemm g{Xs, (const bf16*)(F.ws + WS_W13), nt * 256, 1024, 1024}; pg8::MoeOrder S; S.init(nt * 256, 1024, F.G, (int)blockIdx.x); S.tile_e = misc + 64; S.estride = (size_t)1024 * 1024 * 2;
            pg8::EpiSwiGLU E{H1};
            pg8::gemm_phase<pg8::EpiSwiGLU, pg8::MoeOrder, true, true>(F.lds, g, S, E);
            SEAM();
        }
        if (IN(pb + 11)) {
            const int nt = __builtin_amdgcn_readfirstlane(misc[0]);
            pg8::Gemm g{H1, (const bf16*)(F.ws + WS_W2), nt * 256, 1024, 512}; pg8::MoeOrder S; S.init(nt * 256, 1024, F.G, (int)blockIdx.x); S.tile_e = misc + 64; S.estride = (size_t)1024 * 512 * 2;
            pg8::EpiBf16<0> E{Y2, D, nullptr, 0, 0, 1.f};
            pg8::gemm_phase<pg8::EpiBf16<0>, pg8::MoeOrder, true, true>(F.lds, g, S, E);
            SEAM();
        }
        if (IN(pb + 12)) { phase_ln_ffn(F, li, Y2, moe_on, li == DEPTH - 1); if (li != DEPTH - 1) SEAM(); }
}
__global__ void __launch_bounds__(NTHR, 2) mk_fwd(Args args) {
    extern __shared__ __attribute__((aligned(16))) unsigned char lds[];
    Frame F;
    F.lds = (LAS unsigned char*)lds;
    F.tid = threadIdx.x; F.lane = F.tid & 63; F.wave = __builtin_amdgcn_readfirstlane(F.tid >> 6);
    F.G = gridDim.x; { const int bx = blockIdx.x; F.vcu = (F.G % 8 == 0) ? (bx % 8) * (F.G / 8) + bx / 8 : bx; }
    F.ws = args.ws; F.ctl = (unsigned*)(args.ws + WS_CTL); F.out = args.out;
#pragma unroll
    for (int i = 0; i < 27; ++i) F.in[i] = args.in[i];
    volatile LAS unsigned* MISC = (volatile LAS unsigned*)(F.lds + MISC_OFF);
    for (int u = F.tid; u < (LDS_BYTES - RING_BYTES) / 4; u += NTHR) ((LAS unsigned*)(F.lds + RING_BYTES))[u] = 0u;
    __syncthreads();
    const int lo = args.ph_lo, hi = args.ph_hi; const bool fused = (hi - lo) > 1;
    XcdBarrier bar; bar.bar = F.ctl + CW_BAR; bar.x = 0; bar.st = nullptr;
    if (fused) bar = xcd_barrier_post(F.ctl + CW_BAR, MISC + 8);
    bf16* H = (bf16*)(F.ws + WS_H); bf16* Wm = (bf16*)(F.ws + WS_W); bf16* Wout = Wm + (size_t)4128 * 1024;
    unsigned char* R = F.ws + WS_R;

    if (IN(0)) { phase_init(F); SEAM(); }
    layer_body<0>(F, bar, lds, lo, hi, fused);
    layer_body<1>(F, bar, lds, lo, hi, fused);
    layer_body<2>(F, bar, lds, lo, hi, fused);
    layer_body<3>(F, bar, lds, lo, hi, fused);
#undef IN
#undef SEAM
}

extern "C" void kernel_launch(void* const* d_in, const int* in_sizes, int n_in, void* d_out, int out_size, void* d_ws, size_t ws_size, hipStream_t stream) {
    static int grid = 0;
    if (grid == 0) {
        if (n_in != 27 || in_sizes[0] != T * D || out_size != T * D || ws_size < WS_END) { fprintf(stderr, "kernel_launch: unexpected shapes (n_in %d, in0 %d, out %d, ws %zu < %zu); nothing launched\n", n_in, n_in > 0 ? in_sizes[0] : -1, out_size, ws_size, (size_t)WS_END); grid = -1; return; }
        int dev = 0, cus = 0;
        if (hipGetDevice(&dev) != hipSuccess || hipDeviceGetAttribute(&cus, hipDeviceAttributeMultiprocessorCount, dev) != hipSuccess) { grid = -1; return; }
        if (hipFuncSetAttribute((const void*)mk_fwd, hipFuncAttributeMaxDynamicSharedMemorySize, LDS_BYTES) != hipSuccess) { fprintf(stderr, "kernel_launch: hipFuncSetAttribute failed\n"); grid = -1; return; }
        int per_cu = 0;
        if (hipOccupancyMaxActiveBlocksPerMultiprocessor(&per_cu, (const void*)mk_fwd, NTHR, LDS_BYTES) != hipSuccess || per_cu < 1) fprintf(stderr, "kernel_launch: occupancy query reports %d\n", per_cu);
        (void)hipGetLastError();
        grid = cus;
        if (grid != 256) fprintf(stderr, "kernel_launch: %d CUs (built for 256)\n", grid);
    }
    if (grid < 0) return;
    if (hipMemsetAsync((char*)d_ws + WS_CTL, 0, CTL_ZERO_BYTES, stream) != hipSuccess) return;
    Args a{};
    for (int i = 0; i < 27; ++i) a.in[i] = (const float*)d_in[i];
    a.out = (float*)d_out; a.ws = (unsigned char*)d_ws;
#if MK_FUSED
    a.ph_lo = 0; a.ph_hi = NPH;
    hipLaunchKernelGGL(mk_fwd, dim3(grid), dim3(NTHR), LDS_BYTES, stream, a);
#else
    for (int p = 0; p < NPH; ++p) { if (!phase_valid(p)) continue; a.ph_lo = p; a.ph_hi = p + 1; hipLaunchKernelGGL(mk_fwd, dim3(grid), dim3(NTHR), LDS_BYTES, stream, a); }
#endif
}
```

```cpp
#include <hip/hip_runtime.h>
#include <hip/hip_bf16.h>
#include <cstdio>
#include <cstdint>
#include <cmath>
namespace pg8 {
#define PG8_LAS __attribute__((address_space(3)))
typedef unsigned short bf16_t;
typedef short bf16x8 __attribute__((ext_vector_type(8)));
typedef float f32x4 __attribute__((ext_vector_type(4)));
typedef unsigned u32x4 __attribute__((ext_vector_type(4)));
constexpr int BM = 256, BK = 64, HALF = 128, HTB = HALF * BK * 2  , STAGE_BYTES = 8 * HTB, NXCD = 8, WGM = 8;

__host__ __device__ __forceinline__ int lds_byte(int r, int c) { const int st = (r >> 4) * 2 + (c >> 5), rr = r & 15, cc = c & 31, ob = rr * 64 + cc * 2; return st * 1024 + (ob ^ (((ob >> 9) & 1) << 5)); }
__host__ __device__ __forceinline__ void stage_rc(int b, int& R, int& C) { const int st = b / 1024, sb = b % 1024, swz = sb ^ (((sb >> 9) & 1) << 5); R = (st >> 1) * 16 + swz / 64; C = (st & 1) * 32 + (swz % 64) / 2; }
__host__ __device__ __forceinline__ int perm32(int rho) { const int n = rho >> 4, i = rho & 15; return 8 * (i >> 2) + 4 * n + (i & 3); }

struct Unit { int pm, pn; };
struct Gemm { const bf16_t* A; const bf16_t* Bt; int M, N, K; };

struct StaticOrder {
    int nM, nN, nwg, G, c;
    __host__ __device__ void init(int M, int N, int G_, int c_) { nM = M / BM; nN = N / BM; nwg = nM * nN; G = G_; c = c_; }
    __host__ __device__ bool next(int i, Unit& u) const {
        const long L = (long)i * G + c; if (L >= nwg) return false;
        int wgid = (int)L; { const int q = nwg / NXCD, r = nwg % NXCD, xcd = wgid % NXCD, off = wgid / NXCD; wgid = (xcd < r ? xcd * (q + 1) : r * (q + 1) + (xcd - r) * q) + off; }
        const int nig = WGM * nN, gid = wgid / nig, fm = gid * WGM, gsz = (nM - fm) < WGM ? (nM - fm) : WGM;
        u.pm = fm + ((wgid % nig) % gsz); u.pn = (wgid % nig) / gsz; return true;
    }
    __device__ __forceinline__ void a_ready(const Unit&) const {}
    __device__ __forceinline__ void done(const Unit&) const {}
    __device__ __forceinline__ size_t aoff(const Unit& u, size_t tstepA) const { return (size_t)u.pm * tstepA; }
    __device__ __forceinline__ size_t boff(const Unit& u, size_t tstepB) const { return (size_t)u.pn * tstepB; }
    __device__ __forceinline__ unsigned arow_off(const Unit&, int) const { return 0u; }
};

__device__ __forceinline__ unsigned cvt_pk_bf16(float lo, float hi) { unsigned r; asm volatile("v_cvt_pk_bf16_f32 %0, %1, %2" : "=v"(r) : "v"(lo), "v"(hi)); return r; }
typedef float f32x2 __attribute__((ext_vector_type(2)));
#ifndef PG8_PLAIN_STORES
__device__ __forceinline__ void st16_wt(void* p, const u32x4& w) { asm volatile("global_store_dwordx4 %0, %1, off sc1\n\ts_nop 1" :: "v"(p), "v"(w) : "memory"); }
#else
__device__ __forceinline__ void st16_wt(void* p, const u32x4& w) { *(u32x4*)p = w; }
#endif

__device__ __forceinline__ f32x2 gelu_pk(f32x2 v) {
    const f32x2 av = __builtin_elementwise_abs(v), d = av * 0.2316418882f + 1.0f;
    f32x2 t; t.x = __builtin_amdgcn_rcpf(d.x); t.y = __builtin_amdgcn_rcpf(d.y);
    f32x2 q = t * 0.5307027145f + (-0.7265760135f); q = q * t + 0.7107068705f; q = q * t + (-0.142248368f); q = q * t + 0.127414796f; q = q * t;
    const f32x2 s = (v * v) * (-0.72134752044f);
    f32x2 e; e.x = __builtin_amdgcn_exp2f(s.x); e.y = __builtin_amdgcn_exp2f(s.y);
    const f32x2 m = v * (q * e), r = v - m;
    f32x2 o; o.x = v.x < 0.f ? m.x : r.x; o.y = v.y < 0.f ? m.y : r.y; return o;
}

typedef int i32x4 __attribute__((ext_vector_type(4)));
__device__ __forceinline__ f32x4 dq4(const f32x4& a, float srow, const f32x4& scol) { const i32x4 v = __builtin_bit_cast(i32x4, a); return (f32x4){(float)v[0], (float)v[1], (float)v[2], (float)v[3]} * srow * scol; }
__device__ __forceinline__ void stage_scales_dma(PG8_LAS unsigned char* ldsc, const float* rs, const float* cs, int lane) {
    __builtin_amdgcn_global_load_lds((const unsigned*)(rs + 4 * lane), (PG8_LAS unsigned*)ldsc, 16, 0, 0);
    __builtin_amdgcn_global_load_lds((const unsigned*)(cs + 4 * lane), (PG8_LAS unsigned*)(ldsc + 1024), 16, 0, 0);
}
template <int ACT  > struct EpiBf16 {
    static constexpr int PERM = 1, AFTER_DRAIN = false; static constexpr int NSTORE = 16;     static_assert(ACT == 0 || ACT == 1, "EpiBf16: ACT is 0 (none) or 1 (gelu_pk)");
    bf16_t* O; int ldc; const float* bias; int split_cols; size_t split_stride; float scale0; const float* sa = nullptr; const float* sb = nullptr;
    __device__ __forceinline__ void stage_scales(PG8_LAS unsigned char* ldsc, const Unit& u, int lane) const { if (sa) stage_scales_dma(ldsc, sa + u.pm * BM, sb + u.pn * BM, lane); }
    __device__ __forceinline__ void operator()(const f32x4 (&acc)[2][2][4][2], const Unit& u, int wr, int wc, int fr, int fq, const PG8_LAS unsigned char* ldsc) const {
        const int row0 = u.pm * BM + wr * 64 + fr; int colt = u.pn * BM; bf16_t* base = O;
        float sc = 1.f; if (split_cols) { const int t = colt / split_cols; base += (size_t)t * split_stride; colt -= t * split_cols; if (t == 0) sc = scale0; }
        const int col0 = colt + wc * 32 + 8 * fq, bcol0 = u.pn * BM + wc * 32 + 8 * fq;
        f32x4 bv[2][2];
#pragma unroll
        for (int bj = 0; bj < 2; ++bj)
#pragma unroll
            for (int n = 0; n < 2; ++n) bv[bj][n] = bias ? *(const f32x4*)(bias + bcol0 + bj * HALF + 4 * n) : (f32x4){0.f, 0.f, 0.f, 0.f};
        float srw[2][4]; f32x4 scl[2][2];
        { const PG8_LAS float* lr = (const PG8_LAS float*)ldsc + wr * 64 + fr; const PG8_LAS float* lc = (const PG8_LAS float*)(ldsc + 1024) + wc * 32 + 8 * fq;
#pragma unroll
          for (int ai = 0; ai < 2; ++ai)
#pragma unroll
              for (int m = 0; m < 4; ++m) srw[ai][m] = sa ? lr[ai * HALF + m * 16] : 1.f;
#pragma unroll
          for (int bj = 0; bj < 2; ++bj)
#pragma unroll
              for (int n = 0; n < 2; ++n) scl[bj][n] = sa ? *(const PG8_LAS f32x4*)(lc + bj * HALF + 4 * n) : (f32x4){1.f, 1.f, 1.f, 1.f}; }
#pragma unroll
        for (int ai = 0; ai < 2; ++ai)
#pragma unroll
            for (int m = 0; m < 4; ++m) { bf16_t* rowp = base + (size_t)(row0 + ai * HALF + m * 16) * ldc + col0;
#pragma unroll
                for (int bj = 0; bj < 2; ++bj) { f32x4 v0, v1; if (sa) { const float sr = srw[ai][m]; v0 = dq4(acc[ai][bj][m][0], sr, scl[bj][0]) + bv[bj][0]; v1 = dq4(acc[ai][bj][m][1], sr, scl[bj][1]) + bv[bj][1]; } else { v0 = acc[ai][bj][m][0] + bv[bj][0]; v1 = acc[ai][bj][m][1] + bv[bj][1]; }
                    if (ACT == 1) { f32x2 a = gelu_pk((f32x2){v0[0], v0[1]}), b = gelu_pk((f32x2){v0[2], v0[3]}), c = gelu_pk((f32x2){v1[0], v1[1]}), d = gelu_pk((f32x2){v1[2], v1[3]});
                        v0 = (f32x4){a.x, a.y, b.x, b.y}; v1 = (f32x4){c.x, c.y, d.x, d.y}; }
                    v0 = v0 * sc; v1 = v1 * sc; u32x4 w; w.x = cvt_pk_bf16(v0[0], v0[1]); w.y = cvt_pk_bf16(v0[2], v0[3]); w.z = cvt_pk_bf16(v1[0], v1[1]); w.w = cvt_pk_bf16(v1[2], v1[3]);
                    st16_wt(rowp + bj * HALF, w); } }
    }
};

template <bool I8> __device__ __forceinline__ f32x4 mma_step(const bf16x8& a, const bf16x8& b, const f32x4& c) {
    if constexpr (I8) return __builtin_bit_cast(f32x4, __builtin_amdgcn_mfma_i32_16x16x64_i8(__builtin_bit_cast(i32x4, a), __builtin_bit_cast(i32x4, b), __builtin_bit_cast(i32x4, c), 0, 0, 0));
    else return __builtin_amdgcn_mfma_f32_16x16x32_bf16(a, b, c, 0, 0, 0);
}
template <class Epi, class Sched, bool ALIGN_EPI = false, bool SP2 = false, bool I8 = false, bool GATHER = false>
__device__ __forceinline__ void gemm_phase(PG8_LAS unsigned char* lds, const Gemm g, const Sched& S, const Epi& E, const int tid_in) {
    const int tid = tid_in, wid = __builtin_amdgcn_readfirstlane(tid >> 6), lane = tid & 63, wr = wid >> 2, wc = wid & 3, fr = lane & 15, fq = lane >> 4;
    const int K = g.K, nt = K / BK;
    unsigned voffA[2], voffB[2], voffB1[2];
#pragma unroll
    for (int i = 0; i < 2; ++i) { int R, C; stage_rc(tid * 16 + i * 8192, R, C); const int Rb = Epi::PERM == 1 ? ((R & ~31) + perm32(R & 31)) : R;
        voffA[i] = (unsigned)(R * K + C) * 2u;
        if constexpr (Epi::PERM == 2) { const int cb = (R >> 5) * 64 + 16 * ((R & 15) >> 2) + 4 * ((R >> 4) & 1) + (R & 3); voffB[i] = (unsigned)(cb * K + C) * 2u; voffB1[i] = (unsigned)((cb + 8) * K + C) * 2u; }
        else { voffB[i] = (unsigned)(Rb * K + C) * 2u; voffB1[i] = voffB[i] + (unsigned)(HALF * K * 2); } }
    const size_t kstep = (size_t)(BK * 2);
    const size_t hstep = (size_t)HALF * K * 2;
    const size_t tstep = 2 * hstep;
    const unsigned ldsw = (unsigned)wid * 1024u;
    const int aoff = lds_byte(wr * 64 + fr, fq * 8), boff = lds_byte(wc * 32 + fr, fq * 8);
#define PG8_SA(b, h) (((b) * 2 + (h)) * HTB)
#define PG8_SB(b, h) ((4 + (b) * 2 + (h)) * HTB)
#define PG8_STAGE(bufoff, gbase, voff) do { _Pragma("unroll") for (int _i = 0; _i < 2; ++_i) \
        __builtin_amdgcn_global_load_lds((const unsigned*)((const char*)(gbase) + (voff)[_i]), (PG8_LAS unsigned*)(lds + (bufoff) + ldsw + _i * 8192), 16, 0, 0); } while (0)
#define PG8_STAGE_A(bufoff, gptr, kb, vo) do { if constexpr (GATHER) { _Pragma("unroll") for (int _i = 0; _i < 2; ++_i) \
        __builtin_amdgcn_global_load_lds((const unsigned*)((const char*)g.A + (kb) + (vo)[_i]), (PG8_LAS unsigned*)(lds + (bufoff) + ldsw + _i * 8192), 16, 0, 0); } else PG8_STAGE(bufoff, gptr, voffA); } while (0)
#define PG8_LDA(dst, b, h) do { _Pragma("unroll") for (int m = 0; m < 4; ++m) _Pragma("unroll") for (int k = 0; k < 2; ++k) dst[m][k] = *(const PG8_LAS bf16x8*)(lds + PG8_SA(b, h) + aoff + m * 2048 + k * 1024); } while (0)
#define PG8_LDB(dst, b, h) do { _Pragma("unroll") for (int n = 0; n < 2; ++n) _Pragma("unroll") for (int k = 0; k < 2; ++k) dst[n][k] = *(const PG8_LAS bf16x8*)(lds + PG8_SB(b, h) + boff + n * 2048 + k * 1024); } while (0)
#define PG8_MMA(ai, bj, At, Bt) do { __builtin_amdgcn_s_setprio(1); _Pragma("unroll") for (int m = 0; m < 4; ++m) _Pragma("unroll") for (int n = 0; n < 2; ++n) _Pragma("unroll") for (int k = 0; k < 2; ++k) \
        acc[ai][bj][m][n] = mma_step<I8>(Bt[n][k], At[m][k], acc[ai][bj][m][n]); __builtin_amdgcn_s_setprio(0); } while (0)
#define PG8_WAIT_V(n) asm volatile("s_waitcnt vmcnt(" #n ")" ::: "memory")
#define PG8_WAIT_VS() do { if constexpr (Epi::NSTORE == 16) asm volatile("s_cmp_eq_u32 %0, 0\n\ts_cbranch_scc1 1f\n\ts_waitcnt vmcnt(24)\n\ts_branch 2f\n1:\n\ts_waitcnt vmcnt(8)\n2:" :: "s"(__builtin_amdgcn_readfirstlane(stores_pending)) : "memory", "scc"); \
        else if constexpr (Epi::NSTORE == 8) asm volatile("s_cmp_eq_u32 %0, 0\n\ts_cbranch_scc1 1f\n\ts_waitcnt vmcnt(16)\n\ts_branch 2f\n1:\n\ts_waitcnt vmcnt(8)\n2:" :: "s"(__builtin_amdgcn_readfirstlane(stores_pending)) : "memory", "scc"); \
        else asm volatile("s_waitcnt vmcnt(8)" ::: "memory"); } while (0)
#define PG8_WAIT_L(n) asm volatile("s_waitcnt lgkmcnt(" #n ")" ::: "memory")
#define PG8_BAR __builtin_amdgcn_s_barrier()
#define PG8_SCHED __builtin_amdgcn_sched_barrier(0)
    Unit cur, nxt; int ui = 0;
    if (!S.next(0, cur)) return;
    f32x4 acc[2][2][4][2];
#pragma unroll
    for (int a = 0; a < 2; ++a)
#pragma unroll
        for (int b = 0; b < 2; ++b)
#pragma unroll
            for (int m = 0; m < 4; ++m)
#pragma unroll
                for (int n = 0; n < 2; ++n) acc[a][b][m][n] = (f32x4){0.f, 0.f, 0.f, 0.f};
    bf16x8 At[4][2], B0[2][2], B1[2][2];
    const char* cA = (const char*)g.A + S.aoff(cur, tstep); const char* cB = (const char*)g.Bt + S.boff(cur, tstep);
    unsigned ca[2][2] = {{0u, 0u}, {0u, 0u}}, na[2][2] = {{0u, 0u}, {0u, 0u}};
    if constexpr (GATHER) {
#pragma unroll
        for (int h2 = 0; h2 < 2; ++h2)
#pragma unroll
            for (int i = 0; i < 2; ++i) { int R, C; stage_rc(tid * 16 + i * 8192, R, C); ca[h2][i] = S.arow_off(cur, 128 * h2 + R) + (unsigned)C * 2u; } }
    S.a_ready(cur);
    if constexpr (SP2) {
        PG8_STAGE(PG8_SB(0, 0), cB, voffB); PG8_STAGE(PG8_SB(0, 1), cB, voffB1); PG8_STAGE_A(PG8_SA(0, 0), cA, 0, ca[0]); PG8_STAGE_A(PG8_SA(0, 1), cA + hstep, 0, ca[1]);
        if (wr == 1) PG8_BAR;
        PG8_WAIT_V(2); PG8_BAR;
        PG8_STAGE(PG8_SB(1, 0), cB + kstep, voffB); PG8_STAGE_A(PG8_SA(1, 0), cA + kstep, kstep, ca[0]); PG8_STAGE(PG8_SB(1, 1), cB + kstep, voffB1);
        PG8_WAIT_V(6); PG8_BAR;
    } else {
        PG8_STAGE(PG8_SB(0, 0), cB, voffB); PG8_STAGE(PG8_SA(0, 0), cA, voffA); PG8_STAGE(PG8_SB(0, 1), cB, voffB1); PG8_STAGE(PG8_SA(0, 1), cA + hstep, voffA);
        if (wr == 1) PG8_BAR;
        PG8_WAIT_V(4); PG8_BAR;
        PG8_STAGE(PG8_SB(1, 0), cB + kstep, voffB); PG8_STAGE(PG8_SA(1, 0), cA + kstep, voffA); PG8_STAGE(PG8_SB(1, 1), cB + kstep, voffB1);
        PG8_WAIT_V(6); PG8_BAR;
    }
    for (;;) {
        const bool has_next = S.next(ui + 1, nxt);
        const char* nA = has_next ? (const char*)g.A + S.aoff(nxt, tstep) : cA; const char* nB = has_next ? (const char*)g.Bt + S.boff(nxt, tstep) : cB;
        if constexpr (GATHER) {
#pragma unroll
            for (int h2 = 0; h2 < 2; ++h2)
#pragma unroll
                for (int i = 0; i < 2; ++i) { int R, C; stage_rc(tid * 16 + i * 8192, R, C); na[h2][i] = has_next ? S.arow_off(nxt, 128 * h2 + R) + (unsigned)C * 2u : ca[h2][i]; } }
        for (int t = 0; t < nt; t += 2) {
            const bool last = (t == nt - 2); const int stores_pending = __builtin_amdgcn_readfirstlane((SP2 && (t == 0) && (ui > 0) && !Epi::AFTER_DRAIN) ? 1 : 0);
            const char* a1 = cA + (size_t)(t + 1) * kstep;
            const char* a2 = last ? nA : cA + (size_t)(t + 2) * kstep; const char* b2 = last ? nB : cB + (size_t)(t + 2) * kstep;
            const char* a3 = a2 + kstep; const char* b3 = b2 + kstep;
            if (last && has_next) S.a_ready(nxt);
            if (last && wid == 0) E.stage_scales(lds + STAGE_BYTES, cur, lane);
            const size_t k2 = last ? (size_t)0 : (size_t)(t + 2) * kstep; unsigned sa0[2], sa1[2];
#pragma unroll
            for (int i = 0; i < 2; ++i) { sa0[i] = last ? na[0][i] : ca[0][i]; sa1[i] = last ? na[1][i] : ca[1][i]; }
            if constexpr (SP2) {
            PG8_LDB(B0, 0, 0); PG8_LDB(B1, 0, 1); PG8_SCHED; PG8_LDA(At, 0, 0); if (!stores_pending) PG8_STAGE_A(PG8_SA(1, 1), a1 + hstep, (size_t)(t + 1) * kstep, ca[1]);
            PG8_WAIT_VS(); PG8_WAIT_L(0); PG8_BAR; PG8_MMA(0, 0, At, B0); PG8_MMA(0, 1, At, B1); PG8_BAR; PG8_SCHED;
            PG8_LDA(At, 0, 1); PG8_STAGE(PG8_SB(0, 0), b2, voffB); PG8_STAGE(PG8_SB(0, 1), b2, voffB1); PG8_STAGE_A(PG8_SA(0, 0), a2, k2, sa0);
            PG8_WAIT_VS(); PG8_WAIT_L(0); PG8_BAR; PG8_MMA(1, 0, At, B0); PG8_MMA(1, 1, At, B1); PG8_BAR; PG8_SCHED;
            PG8_LDB(B0, 1, 0); PG8_LDB(B1, 1, 1); PG8_SCHED; PG8_LDA(At, 1, 0); PG8_STAGE_A(PG8_SA(0, 1), a2 + hstep, k2, sa1);
            PG8_WAIT_VS(); PG8_WAIT_L(0); PG8_BAR; PG8_MMA(0, 0, At, B0); PG8_MMA(0, 1, At, B1); PG8_BAR; PG8_SCHED;
            PG8_LDA(At, 1, 1); PG8_STAGE(PG8_SB(1, 0), b3, voffB); PG8_STAGE(PG8_SB(1, 1), b3, voffB1); PG8_STAGE_A(PG8_SA(1, 0), a3, k2 + kstep, sa0);
            PG8_WAIT_V(8); PG8_WAIT_L(0); PG8_BAR; PG8_MMA(1, 0, At, B0); PG8_MMA(1, 1, At, B1); PG8_BAR; PG8_SCHED;
            } else {
            PG8_LDB(B0, 0, 0); PG8_SCHED; PG8_LDA(At, 0, 0); PG8_STAGE(PG8_SA(1, 1), a1 + hstep, voffA);
            PG8_WAIT_L(8); PG8_BAR; PG8_WAIT_L(0); PG8_MMA(0, 0, At, B0); PG8_BAR; PG8_SCHED;
            PG8_LDB(B1, 0, 1); PG8_STAGE(PG8_SB(0, 0), b2, voffB);
            PG8_BAR; PG8_WAIT_L(0); PG8_MMA(0, 1, At, B1); PG8_BAR;
            PG8_LDA(At, 0, 1); PG8_STAGE(PG8_SA(0, 0), a2, voffA);
            PG8_BAR; PG8_WAIT_L(0); PG8_MMA(1, 0, At, B0); PG8_BAR; PG8_SCHED;
            PG8_STAGE(PG8_SB(0, 1), b2, voffB1);
            PG8_WAIT_V(6); PG8_BAR; PG8_MMA(1, 1, At, B1); PG8_BAR;
            PG8_LDB(B0, 1, 0); PG8_SCHED; PG8_LDA(At, 1, 0); PG8_STAGE(PG8_SA(0, 1), a2 + hstep, voffA);
            PG8_WAIT_L(8); PG8_BAR; PG8_WAIT_L(0); PG8_MMA(0, 0, At, B0); PG8_BAR; PG8_SCHED;
            PG8_LDB(B1, 1, 1); PG8_STAGE(PG8_SB(1, 0), b3, voffB);
            PG8_BAR; PG8_WAIT_L(0); PG8_MMA(0, 1, At, B1); PG8_BAR;
            PG8_LDA(At, 1, 1); PG8_STAGE(PG8_SA(1, 0), a3, voffA);
            PG8_BAR; PG8_WAIT_L(0); PG8_MMA(1, 0, At, B0); PG8_BAR; PG8_SCHED;
            PG8_STAGE(PG8_SB(1, 1), b3, voffB1);
            PG8_WAIT_V(6); PG8_BAR; PG8_MMA(1, 1, At, B1); PG8_BAR;
            }
        }
        if constexpr (SP2 && !Epi::AFTER_DRAIN) { if (has_next) PG8_STAGE_A(PG8_SA(1, 1), nA + kstep + hstep, kstep, na[1]); }
        if constexpr (ALIGN_EPI) { if (wr == 0) PG8_BAR; }
        if constexpr (!Epi::AFTER_DRAIN) { E(acc, cur, wr, wc, fr, fq, lds + STAGE_BYTES); S.done(cur); }
        if (!has_next) break;
#pragma unroll
        for (int a = 0; a < 2; ++a)
#pragma unroll
            for (int b = 0; b < 2; ++b)
#pragma unroll
                for (int m = 0; m < 4; ++m)
#pragma unroll
                    for (int n = 0; n < 2; ++n) acc[a][b][m][n] = (f32x4){0.f, 0.f, 0.f, 0.f};
        cur = nxt; cA = nA; cB = nB; ++ui;
        if constexpr (GATHER) {
#pragma unroll
            for (int h2 = 0; h2 < 2; ++h2)
#pragma unroll
                for (int i = 0; i < 2; ++i) ca[h2][i] = na[h2][i]; }
        if constexpr (ALIGN_EPI) { if (wr == 1) PG8_BAR; }
    }
    PG8_WAIT_V(0);
    if constexpr (!ALIGN_EPI) { if (wr == 0) PG8_BAR; }
    PG8_BAR;
    if constexpr (Epi::AFTER_DRAIN) { E.fused(acc, cur, wr, wc, fr, fq, lds, wid, lane); S.done(cur); }
#undef PG8_SA
#undef PG8_SB
#undef PG8_STAGE
#undef PG8_STAGE_A
#undef PG8_LDA
#undef PG8_LDB
#undef PG8_MMA
#undef PG8_WAIT_V
#undef PG8_WAIT_VS
#undef PG8_WAIT_L
#undef PG8_BAR
#undef PG8_SCHED
}
}
namespace attn_body {
using bf16=__hip_bfloat16;
using bf16x8=__attribute__((ext_vector_type(8)))short;
using s16x4=__attribute__((ext_vector_type(4)))short;
using f32x16=__attribute__((ext_vector_type(16)))float;
using u32x4=__attribute__((ext_vector_type(4)))unsigned;
constexpr int BATCH=4,NHEAD=16,SEQ=8192,D=64,DM=NHEAD*D;
constexpr int NW=8,QBLK=32,QB=QBLK*NW,KVBLK=64,NQB=SEQ/QB;
constexpr int ATTN_PITCH=DM, ATTN_UNIT_ROWS=QB;
__device__ __forceinline__ int crow(int r,int hi){return (r&3)+8*(r>>2)+4*hi;}
#define SBAR() __builtin_amdgcn_sched_barrier(0)
__device__ __forceinline__ void cmask(f32x16&p0,f32x16&p1,int jb,int qrel,int hi){
  const float NEG=-INFINITY; int kb=64*jb+4*hi;
  #pragma unroll
  for(int r=0;r<16;++r){int kv=kb+(r&3)+8*(r>>2); if(kv>qrel)p0[r]=NEG; if(kv+32>qrel)p1[r]=NEG;}
}

typedef __attribute__((address_space(3))) const float* lds_cfptr;
__device__ __forceinline__ void bmask(f32x16&p0,f32x16&p1,int jb6,int qrel,int hi,lds_cfptr lut){
  const float NEG=-INFINITY; const int kb=64*jb6-128+4*hi;
  #pragma unroll
  for(int r=0;r<16;++r){const int n0=qrel-(kb+(r&3)+8*(r>>2)), n1=n0-32;
    const float b0=lut[n0<0?0:n0], b1=lut[n1<0?0:n1];
    p0[r]=(n0>=0)?p0[r]+b0:NEG; p1[r]=(n1>=0)?p1[r]+b1:NEG;}
}

constexpr int NSLOT=3, SLOTB=8192;
constexpr int LDS_K=0, LDS_V=NSLOT*SLOTB, LDS_WS=3*NSLOT*SLOTB, LDS_OST=LDS_WS+NW*64*4, LDS_BYTES=LDS_OST+NW*4096;
constexpr float C2=0.125f*1.4426950408889634f;
__device__ __forceinline__ void glds16(const void*gsrc,unsigned lds_dst){unsigned keep;
  asm volatile("s_mov_b32 %0, m0\n\ts_mov_b32 m0, %2\n\ts_nop 0\n\tglobal_load_lds_dwordx4 %1, off\n\ts_mov_b32 m0, %0":"=&s"(keep):"v"(gsrc),"s"(lds_dst):"memory");}
__device__ __forceinline__ float max3f(float a,float b,float c){float r;asm("v_max3_f32 %0, %1, %2, %3":"=v"(r):"v"(a),"v"(b),"v"(c));return r;}
__device__ __forceinline__ float max2f(float a,float b){float r;asm("v_max_f32_e32 %0, %1, %2":"=v"(r):"v"(a),"v"(b));return r;}
__device__ __forceinline__ float fadd_s(float a,float b){float r;asm("v_add_f32_e32 %0, %1, %2":"=v"(r):"v"(a),"v"(b));return r;}
__device__ __forceinline__ float fsub_s(float a,float b){float r;asm("v_sub_f32_e32 %0, %1, %2":"=v"(r):"v"(a),"v"(b));return r;}
typedef float f32x2_t __attribute__((ext_vector_type(2))); typedef __bf16 bf16x2_t __attribute__((ext_vector_type(2)));
__device__ __forceinline__ unsigned cvtpk_s(float lo,float hi){f32x2_t v={lo,hi};bf16x2_t b=__builtin_convertvector(v,bf16x2_t);return __builtin_bit_cast(unsigned,b);}
#define WAIT_BAR(N) asm volatile("s_waitcnt vmcnt(" #N ") lgkmcnt(0)\n\ts_barrier":::"memory")

__device__ __forceinline__ void qkt(f32x16&p0,f32x16&p1,const char*Kslot,const bf16x8*qr,int r32,int hi){ const f32x16 negm=f32x16{};
  const char*kb=Kslot+hi*1024+r32*16;
  #pragma unroll
  for(int d0=0;d0<4;++d0){
    const bf16x8 b0=*reinterpret_cast<const bf16x8*>(kb+d0*2048);
    const bf16x8 b1=*reinterpret_cast<const bf16x8*>(kb+d0*2048+512);
    if(d0==0){p0=__builtin_amdgcn_mfma_f32_32x32x16_bf16(b0,qr[0],negm,0,0,0);p1=__builtin_amdgcn_mfma_f32_32x32x16_bf16(b1,qr[0],negm,0,0,0);}
    else{p0=__builtin_amdgcn_mfma_f32_32x32x16_bf16(b0,qr[d0],p0,0,0,0);p1=__builtin_amdgcn_mfma_f32_32x32x16_bf16(b1,qr[d0],p1,0,0,0);}}
}
typedef __attribute__((address_space(3))) const char* lds_cptr;
typedef short v4i16_t __attribute__((ext_vector_type(4)));
__device__ __forceinline__ void kload8(bf16x8*kf,lds_cptr kp){
  kf[0]=*(const __attribute__((address_space(3))) bf16x8*)(kp);      kf[1]=*(const __attribute__((address_space(3))) bf16x8*)(kp+512);
  kf[2]=*(const __attribute__((address_space(3))) bf16x8*)(kp+2048); kf[3]=*(const __attribute__((address_space(3))) bf16x8*)(kp+2560);
  kf[4]=*(const __attribute__((address_space(3))) bf16x8*)(kp+4096); kf[5]=*(const __attribute__((address_space(3))) bf16x8*)(kp+4608);
  kf[6]=*(const __attribute__((address_space(3))) bf16x8*)(kp+6144); kf[7]=*(const __attribute__((address_space(3))) bf16x8*)(kp+6656);
}
__device__ __forceinline__ void kload2(bf16x8*kf,lds_cptr kp,int j){ kf[2*j]=*(const __attribute__((address_space(3))) bf16x8*)(kp+j*2048); kf[2*j+1]=*(const __attribute__((address_space(3))) bf16x8*)(kp+j*2048+512); }
__device__ __forceinline__ s16x4 vtr(lds_cptr p){ return __builtin_bit_cast(s16x4,__builtin_amdgcn_ds_read_tr16_b64_v4i16((__attribute__((address_space(3))) v4i16_t*)p)); }
__device__ __forceinline__ float rowmax(const f32x16&p0,const f32x16&p1){
  float a=max3f(p0[0],p0[1],p1[0]),b=max3f(p0[2],p0[3],p1[1]);a=max3f(a,p1[2],p1[3]);
  #pragma unroll
  for(int r=4;r<16;r+=4){a=max3f(a,p0[r],p0[r+1]);b=max3f(b,p0[r+2],p0[r+3]);a=max3f(a,p1[r],p1[r+1]);b=max3f(b,p1[r+2],p1[r+3]);}
  const float m=max2f(a,b);
  auto rr=__builtin_amdgcn_permlane32_swap(__float_as_uint(m),__float_as_uint(m),false,false);
  return max2f(__uint_as_float(rr[0]),__uint_as_float(rr[1]));
}
__device__ __forceinline__ void pv(f32x16*o,int vb,bf16x8 pa0,bf16x8 pa1,bf16x8 pa2,bf16x8 pa3){
  #pragma unroll
  for(int d0=0;d0<2;++d0){s16x4 lo[4],hi[4];
    #pragma unroll
    for(int ks=0;ks<4;++ks){
      asm volatile("ds_read_b64_tr_b16 %0,%1 offset:%c2":"=&v"(lo[ks]):"v"(vb),"i"(d0*4096+ks*1024):"memory");
      asm volatile("ds_read_b64_tr_b16 %0,%1 offset:%c2":"=&v"(hi[ks]):"v"(vb),"i"(d0*4096+ks*1024+512):"memory");}
    asm volatile("s_waitcnt lgkmcnt(0)":::"memory");SBAR();
    #define PK(k) (bf16x8){lo[k][0],lo[k][1],lo[k][2],lo[k][3],hi[k][0],hi[k][1],hi[k][2],hi[k][3]}
    o[d0]=__builtin_amdgcn_mfma_f32_32x32x16_bf16(pa0,PK(0),o[d0],0,0,0);
    o[d0]=__builtin_amdgcn_mfma_f32_32x32x16_bf16(pa1,PK(1),o[d0],0,0,0);
    o[d0]=__builtin_amdgcn_mfma_f32_32x32x16_bf16(pa2,PK(2),o[d0],0,0,0);
    o[d0]=__builtin_amdgcn_mfma_f32_32x32x16_bf16(pa3,PK(3),o[d0],0,0,0);
    #undef PK
  }
}

#ifndef ATTN_STORE16
#define ATTN_STORE16(p,v) (*(u32x4*)(p)=(v))
#endif
template<int THRL> __device__ __forceinline__ void attn_unit(int b,int h,int hv,int qb,const bf16*Q,const bf16*__restrict__ K,const bf16*__restrict__ V,bf16*O,char*shm,lds_cfptr lut,const int tid_in){
  const int tid=tid_in,lane=tid&63,r32=lane&31,hi=lane>>5; const int wid=__builtin_amdgcn_readfirstlane(tid>>6);
  const long rowbase=(long)b*SEQ; const int q0=qb*QB;
  const bf16*Qw=Q+(rowbase+q0+wid*QBLK)*DM+h*D;
  const bf16*Kh=K+rowbase*DM+h*D,*Vh=V+rowbase*DM+hv*2*D;
  const unsigned lds0=(unsigned)(uintptr_t)shm;
  float*wsf=(float*)(shm+LDS_WS)+wid*64;
  const bf16*ksrc=Kh+(long)lane*DM+wid*8;
  const bf16*vsrc=Vh+(long)(16*(wid&3)+(lane>>2))*DM+(wid>>2)*32+(lane&3)*8;
  const unsigned kdst=lds0+LDS_K+wid*1024, vdst=lds0+LDS_V+wid*1024;
  #define DMA_K(t,slot) glds16(ksrc+(long)(t)*KVBLK*DM,(unsigned)__builtin_amdgcn_readfirstlane(kdst+(slot)))
  #define DMA_V(t,slot) do{ glds16(vsrc+(long)(t)*KVBLK*DM,(unsigned)__builtin_amdgcn_readfirstlane(vdst+2*(slot))); glds16(vsrc+(long)(t)*KVBLK*DM+64,(unsigned)__builtin_amdgcn_readfirstlane(vdst+2*(slot)+SLOTB)); }while(0)
  const int vb0=(int)(lds0+LDS_V)+((lane>>4)&1)*32+(lane&3)*8+(4*hi+((lane&15)>>2))*64;
  const char*Kbase=shm+LDS_K; bf16x8 kf[8];
  const lds_cptr shm3=(lds_cptr)shm; const lds_cptr kp0=shm3+LDS_K+hi*1024+r32*16; const lds_cptr vp0=shm3+LDS_V+((lane>>4)&1)*32+(lane&3)*8+(4*hi+((lane&15)>>2))*64;
  const int NT=(q0+QB)/KVBLK;
  DMA_K(0,0);DMA_V(0,0);DMA_K(1,SLOTB);
  bf16x8 qr[4];
  #pragma unroll
  for(int d0=0;d0<4;++d0)qr[d0]=*reinterpret_cast<const bf16x8*>(&Qw[(long)r32*DM+d0*16+hi*8]);
  { bf16x8*qst=(bf16x8*)(shm+LDS_OST+wid*4096)+lane; qst[0]=qr[0]; qst[64]=qr[1]; qst[128]=qr[2]; qst[192]=qr[3]; }
  const lds_cptr qp0=(lds_cptr)shm+LDS_OST+wid*4096+lane*16;
  #define QLD(d) (*(const __attribute__((address_space(3))) bf16x8*)(qp0+(d)*1024))
  float mhat=0.f,l_reg=0.f;f32x16 o[4];o[0]=f32x16{};o[1]=f32x16{};o[2]=f32x16{};o[3]=f32x16{};const f32x16 zero16=f32x16{};
  const int qrel=wid*QBLK+r32;
  #define CMASK(P0,P1,t) do{int jb_=(t)-(NT-6); if(jb_>=0)bmask(P0,P1,jb_,qrel,hi,lut);}while(0)
  bool resc=false;
  #define START(P0,P1) do{ resc=false; \
    _Pragma("unroll") for(int r=0;r<16;++r)P0[r]=__builtin_amdgcn_exp2f(P0[r]); }while(0)
  #define RESC() do{ if(resc){ asm volatile("s_waitcnt lgkmcnt(0)":::"memory"); \
      _Pragma("unroll") for(int d_=0;d_<4;++d_) _Pragma("unroll") for(int r=0;r<16;++r)o[d_][r]*=wsf[crow(r,hi)]; } }while(0)
  f32x16 pA0,pA1,pB0,pB1;
  int sl_prev=0,sl_cur=0,sl_next=SLOTB;
  #define ROT() do{sl_prev=sl_cur;sl_cur=sl_next;sl_next=(sl_next==(NSLOT-1)*SLOTB)?0:sl_next+SLOTB;}while(0)
  DMA_K(2,2*SLOTB);
  WAIT_BAR(4);
  qkt(pA0,pA1,Kbase,qr,r32,hi);asm volatile("s_nop 15\n\ts_nop 7":"+v"(pA0),"+v"(pA1));CMASK(pA0,pA1,0);
  START(pA0,pA1);
  _Pragma("unroll") for(int r=0;r<16;++r)pA1[r]=__builtin_amdgcn_exp2f(pA1[r]);
  WAIT_BAR(0);
  DMA_K(3,0);DMA_V(1,SLOTB);
  ROT();
  kload8(kf,kp0+sl_cur);
  WAIT_BAR(3);
  s16x4 vlo[8],vhi[8]; u32x4 pw0,pw1,pw2,pw3;
  #define PKW(P,B) cvtpk_s(P[B],P[B+1])
  #define PAF(k) __builtin_bit_cast(bf16x8,pw##k)
  #define VFR(i) (bf16x8){vlo[i][0],vlo[i][1],vlo[i][2],vlo[i][3],vhi[i][0],vhi[i][1],vhi[i][2],vhi[i][3]}
  #define PIN(x) asm volatile("":"+v"(x))
  #define MX3(a,b,c) __builtin_fmaxf(__builtin_fmaxf((a),(b)),(c))
  #define GAPA(MF,A0,A1,A2,A3,W0,W1,PW) do{ MF; sacc+=A0; sacc+=A1; sacc+=A2; sacc+=A3; PIN(sacc); W0; W1; PIN(PW); SBAR(); }while(0)
  #define EX(v) __builtin_amdgcn_exp2f(v)
  #define GAPB(MF,X,B) do{ MF; X[B]=EX(X[B]); X[B+1]=EX(X[B+1]); X[B+2]=EX(X[B+2]); X[B+3]=EX(X[B+3]); PIN(X); SBAR(); }while(0)
  #define VRD(i) do{ vlo[i]=vtr(vp_+(((i)>>2)*4096+((i)&3)*1024)); vhi[i]=vtr(vp_+(((i)>>2)*4096+((i)&3)*1024+512)); }while(0)
  #define VRDB(i) do{ vlo[i]=vtr(vp_+(SLOTB+((i)>>2)*4096+((i)&3)*1024)); vhi[i]=vtr(vp_+(SLOTB+((i)>>2)*4096+((i)&3)*1024+512)); }while(0)
  #define KRD(G,j) do{ if(G){ kload2(kf,kp0+sl_next,j); SBAR(); } }while(0)
  #define STEP(C0,C1,P0,P1,t,GK,GV,GL) do{ SBAR(); \
    const lds_cptr vp_=vp0+2*sl_prev; \
    bf16x8 qa_=QLD(0), qb_=QLD(1); VRD(0); SBAR(); float sacc=(P0[0]+P0[1]); \
    GAPA(C0=__builtin_amdgcn_mfma_f32_32x32x16_bf16(kf[0],qa_,zero16,0,0,0), P0[2],P0[3],P0[4],P0[5],     pw0[0]=PKW(P0,0), pw0[1]=PKW(P0,2), pw0); \
    VRD(4); SBAR(); GAPA(C1=__builtin_amdgcn_mfma_f32_32x32x16_bf16(kf[1],qa_,zero16,0,0,0), P0[6],P0[7],P0[8],P0[9],     pw0[2]=PKW(P0,4), pw0[3]=PKW(P0,6), pw0); \
    qa_=QLD(2); VRD(1); SBAR(); GAPA(C0=__builtin_amdgcn_mfma_f32_32x32x16_bf16(kf[2],qb_,C0,0,0,0),   P0[10],P0[11],P0[12],P0[13], pw1[0]=PKW(P0,8), pw1[1]=PKW(P0,10), pw1); \
    VRD(5); SBAR(); GAPA(C1=__builtin_amdgcn_mfma_f32_32x32x16_bf16(kf[3],qb_,C1,0,0,0),   P0[14],P0[15],P1[0],P1[1],   pw1[2]=PKW(P0,12),pw1[3]=PKW(P0,14), pw1); \
    qb_=QLD(3); VRD(2); SBAR(); GAPA(C0=__builtin_amdgcn_mfma_f32_32x32x16_bf16(kf[4],qa_,C0,0,0,0),   P1[2],P1[3],P1[4],P1[5],     pw2[0]=PKW(P1,0), pw2[1]=PKW(P1,2), pw2); \
    VRD(6); SBAR(); GAPA(C1=__builtin_amdgcn_mfma_f32_32x32x16_bf16(kf[5],qa_,C1,0,0,0),   P1[6],P1[7],P1[8],P1[9],     pw2[2]=PKW(P1,4), pw2[3]=PKW(P1,6), pw2); \
    VRD(3); SBAR(); GAPA(C0=__builtin_amdgcn_mfma_f32_32x32x16_bf16(kf[6],qb_,C0,0,0,0),   P1[10],P1[11],P1[12],P1[13], pw3[0]=PKW(P1,8), pw3[1]=PKW(P1,10), pw3); \
    VRD(7); SBAR(); GAPA(C1=__builtin_amdgcn_mfma_f32_32x32x16_bf16(kf[7],qb_,C1,0,0,0),   P1[14],P1[15],0.f,0.f,       pw3[2]=PKW(P1,12),pw3[3]=PKW(P1,14), pw3); \
    l_reg+=sacc; \
    if(GK){DMA_K((t)+3,sl_cur);} if(GV){DMA_V((t)+1,sl_next);} \
    CMASK(C0,C1,t); \
    resc=false; \
    SBAR(); \
    GAPB(o[0]=__builtin_amdgcn_mfma_f32_32x32x16_bf16(PAF(0),VFR(0),o[0],0,0,0), C0,0); VRDB(0); SBAR(); \
    GAPB(o[1]=__builtin_amdgcn_mfma_f32_32x32x16_bf16(PAF(0),VFR(4),o[1],0,0,0), C0,4); VRDB(4); SBAR(); \
    KRD(GL,0); GAPB(o[0]=__builtin_amdgcn_mfma_f32_32x32x16_bf16(PAF(1),VFR(1),o[0],0,0,0), C0,8); VRDB(1); SBAR(); \
    KRD(GL,1); GAPB(o[1]=__builtin_amdgcn_mfma_f32_32x32x16_bf16(PAF(1),VFR(5),o[1],0,0,0), C0,12); VRDB(5); SBAR(); \
    KRD(GL,2); GAPB(o[0]=__builtin_amdgcn_mfma_f32_32x32x16_bf16(PAF(2),VFR(2),o[0],0,0,0), C1,0); VRDB(2); SBAR(); \
    KRD(GL,3); GAPB(o[1]=__builtin_amdgcn_mfma_f32_32x32x16_bf16(PAF(2),VFR(6),o[1],0,0,0), C1,4); VRDB(6); SBAR(); \
    GAPB(o[0]=__builtin_amdgcn_mfma_f32_32x32x16_bf16(PAF(3),VFR(3),o[0],0,0,0), C1,8); VRDB(3); SBAR(); \
    GAPB(o[1]=__builtin_amdgcn_mfma_f32_32x32x16_bf16(PAF(3),VFR(7),o[1],0,0,0), C1,12); VRDB(7); SBAR(); \
      \
    o[2]=__builtin_amdgcn_mfma_f32_32x32x16_bf16(PAF(0),VFR(0),o[2],0,0,0); \
    o[3]=__builtin_amdgcn_mfma_f32_32x32x16_bf16(PAF(0),VFR(4),o[3],0,0,0); \
    o[2]=__builtin_amdgcn_mfma_f32_32x32x16_bf16(PAF(1),VFR(1),o[2],0,0,0); \
    o[3]=__builtin_amdgcn_mfma_f32_32x32x16_bf16(PAF(1),VFR(5),o[3],0,0,0); \
    o[2]=__builtin_amdgcn_mfma_f32_32x32x16_bf16(PAF(2),VFR(2),o[2],0,0,0); \
    o[3]=__builtin_amdgcn_mfma_f32_32x32x16_bf16(PAF(2),VFR(6),o[3],0,0,0); \
    o[2]=__builtin_amdgcn_mfma_f32_32x32x16_bf16(PAF(3),VFR(3),o[2],0,0,0); \
    o[3]=__builtin_amdgcn_mfma_f32_32x32x16_bf16(PAF(3),VFR(7),o[3],0,0,0); \
    }while(0)
  int t=1;
  #undef CMASK
  #define CMASK(P0,P1,t) do{}while(0)
  for(;t+7<NT;t+=2){
    STEP(pB0,pB1,pA0,pA1,t,true,true,true);     WAIT_BAR(3); RESC(); ROT();
    STEP(pA0,pA1,pB0,pB1,t+1,true,true,true);   WAIT_BAR(3); RESC(); ROT();
  }
  #undef CMASK
  #define CMASK(P0,P1,t) do{int jb_=(t)-(NT-6); if(jb_>=0)bmask(P0,P1,jb_,qrel,hi,lut);}while(0)
  #define ENDW(tt) do{ if((tt)+3<NT){WAIT_BAR(3);} else if((tt)+2<NT){WAIT_BAR(2);} else {WAIT_BAR(0);} }while(0)
  for(;t+1<NT;t+=2){
    STEP(pB0,pB1,pA0,pA1,t,(t+3<NT),(t+1<NT),(t+1<NT));       ENDW(t);   RESC(); ROT();
    STEP(pA0,pA1,pB0,pB1,t+1,(t+4<NT),(t+2<NT),(t+2<NT));     ENDW(t+1); RESC(); ROT();
  }
  STEP(pB0,pB1,pA0,pA1,NT-1,false,false,false); RESC();
  { float sacc=pB0[0]+pB0[1]; _Pragma("unroll") for(int r=2;r<16;++r)sacc+=pB0[r]; _Pragma("unroll") for(int r=0;r<16;++r)sacc+=pB1[r]; l_reg+=sacc;
    pw0=(u32x4){PKW(pB0,0),PKW(pB0,2),PKW(pB0,4),PKW(pB0,6)};pw1=(u32x4){PKW(pB0,8),PKW(pB0,10),PKW(pB0,12),PKW(pB0,14)};pw2=(u32x4){PKW(pB1,0),PKW(pB1,2),PKW(pB1,4),PKW(pB1,6)};pw3=(u32x4){PKW(pB1,8),PKW(pB1,10),PKW(pB1,12),PKW(pB1,14)};
    SBAR(); pv(o,vb0+2*sl_cur,PAF(0),PAF(1),PAF(2),PAF(3)); pv(o+2,vb0+2*sl_cur+SLOTB,PAF(0),PAF(1),PAF(2),PAF(3)); }
  #undef PKW
  #undef PAF
  #undef VFR
  #undef PIN
  #undef MX3
  #undef GAPA
  #undef GAPB
  #undef EX
  #undef VRD
  #undef VRDB
  #undef QLD
  #undef KRD
  #undef STEP
  #undef ENDW
  {auto rr=__builtin_amdgcn_permlane32_swap(__float_as_uint(l_reg),__float_as_uint(l_reg),false,false);l_reg=__uint_as_float(rr[0])+__uint_as_float(rr[1]);}
  if(hi==0)wsf[32+r32]=l_reg;asm volatile("s_waitcnt lgkmcnt(0)":::"memory");
  float rli[16];
  #pragma unroll
  for(int r=0;r<16;++r)rli[r]=__builtin_amdgcn_rcpf(wsf[32+crow(r,hi)]);
  bf16*Ow=O+(rowbase+q0+wid*QBLK)*DM+hv*2*D;
  { bf16*stg=(bf16*)(shm+LDS_OST)+wid*2048;
    #pragma unroll
    for(int hf=0;hf<2;++hf){
    #pragma unroll
    for(int r=0;r<16;++r){const int orow=crow(r,hi);
      #pragma unroll
      for(int d0=0;d0<2;++d0)stg[orow*64+d0*32+r32]=__float2bfloat16(o[2*hf+d0][r]*rli[r]);}
    asm volatile("s_waitcnt lgkmcnt(0)":::"memory");
    #pragma unroll
    for(int i=0;i<4;++i){const int row=i*8+(lane>>3),ch=lane&7; const u32x4 v=*(const u32x4*)(stg+row*64+ch*8); ATTN_STORE16(Ow+(long)row*DM+hf*64+ch*8,v);}
    asm volatile("s_waitcnt lgkmcnt(0)":::"memory"); } }
  asm volatile("s_waitcnt lgkmcnt(0)\n\ts_barrier":::"memory");
  #undef DMA_K
  #undef DMA_V
  #undef CMASK
  #undef START
  #undef RESC
  #undef ROT
}
constexpr int ATTN_LDS_BYTES=LDS_BYTES;
constexpr int LUT_OFF=110592, LUT_N=384;
struct AttnTensors { const bf16* Q; const bf16* K; const bf16* V; bf16* O0; bf16* O1; const float* lut_g; };
struct AttnUnit { int b, hq, hv, m, qb; };
struct StaticOrder {
  int vcu;
  __device__ __forceinline__ explicit StaticOrder(int grid,int block):vcu((block%8)*(grid/8)+block/8){}
  __device__ __forceinline__ bool next(int i,AttnUnit&u)const{ if(i>=8)return false; const int s=vcu&7, combo=(vcu>>3)*2+(i>>2), rem=combo&15, h=rem>>1, m=rem&1, k=i&3;
    u.b=combo>>4; u.hq=2*h+m; u.hv=h; u.m=m; u.qb=(k==0)?s:(k==1)?15-s:(k==2)?16+s:31-s; return true; }
  __device__ __forceinline__ void a_ready(const AttnUnit&)const{}
  __device__ __forceinline__ void done(const AttnUnit&)const{}
};
template<class Sched,int THRL=8> __device__ __forceinline__ void attn_phase(char*lds,const AttnTensors&T,const Sched&S,const int tid_in){
  { float* l=(float*)(lds+LUT_OFF); for(int i=tid_in;i<8*LUT_N;i+=512) l[i]=T.lut_g[i]; }
  asm volatile("s_waitcnt vmcnt(0) lgkmcnt(0)\n\ts_barrier":::"memory");
  AttnUnit u;
  for(int i=0;S.next(i,u);++i){ S.a_ready(u); attn_unit<THRL>(u.b,u.hq,u.hv,u.qb,T.Q,T.K,T.V,u.m?T.O1:T.O0,lds,(lds_cfptr)(lds+LUT_OFF)+(u.hq>>1)*LUT_N,tid_in); S.done(u); }
}
#undef SBAR
#undef WAIT_BAR
}
#ifndef PROBE_MASK
#define PROBE_MASK 0
#endif
constexpr int NWAVES = 8, NTHR = 512;
constexpr int NB = 4, SEQ = 8192, T = NB * SEQ, D = 1024, DEPTH = 4, NEXP = 16;
constexpr int A_INW = 4112;
constexpr float DN_ALPHA = 1.6817928305074290f;
constexpr float LN_EPS = 1e-5f;
constexpr int MAXTILES = 272, MAXROWS = MAXTILES * 256;

constexpr size_t MiB = 1u << 20;
constexpr size_t WS_CTL = 0, CTL_ZERO_BYTES = 1 * MiB;
constexpr size_t WS_AB = 1 * MiB;
constexpr size_t WS_TOKE = 3 * MiB;
constexpr size_t WS_TOKP = WS_TOKE + 256 * 1024;
constexpr size_t WS_TOKW = WS_TOKP + 256 * 1024;
constexpr size_t WS_TOKR = WS_TOKW + 256 * 1024;
constexpr size_t WS_MISC = 4 * MiB;
constexpr size_t WS_LUT = WS_MISC + 4096;
constexpr size_t WS_WSUM = WS_MISC + 16384;
constexpr size_t WS_EGL = WS_MISC + 32768;
constexpr size_t WS_HS = WS_MISC + 512 * 1024;
constexpr size_t WS_SBW = WS_MISC + 704 * 1024;
constexpr size_t WS_XSC = 14 * MiB;
constexpr size_t WS_SB13 = 14 * MiB + 512 * 1024;
constexpr size_t WS_ONS = 14 * MiB + 768 * 1024;
constexpr size_t WS_SBO = 14 * MiB + 1024 * 1024;
constexpr size_t WS_H8 = 144 * MiB + 384 * MiB;
constexpr size_t WS_WSB = WS_MISC + 65536;
constexpr size_t WS_RTOK = 20 * MiB;
constexpr size_t WS_RSC = 22 * MiB;
constexpr size_t WS_HALO = 5 * MiB;
constexpr size_t HALO_T = (size_t)512 * 3 * 1024;
constexpr size_t WS_W = 16 * MiB;
constexpr size_t WS_W13 = 29 * MiB;
constexpr size_t WS_W2 = 61 * MiB;
constexpr size_t WS_H = 80 * MiB;
constexpr size_t WS_R = 144 * MiB;
constexpr size_t TD2 = (size_t)T * D * 2;
constexpr size_t WS_END = WS_R + 416 * MiB;
constexpr int CW_TMO = 0, CW_BAR = 4096, CW_CNT = 8192, CW_CMAX = 65536;

constexpr int LDS_BYTES = 147456;
constexpr int RING_BYTES = 131072;
constexpr int MOE_TAB_OFF = 143360;
constexpr int MISC_OFF = LDS_BYTES - 256;

#define GAS __attribute__((address_space(1)))
#define LAS __attribute__((address_space(3)))
typedef unsigned short bf16;
typedef unsigned v4u __attribute__((ext_vector_type(4)));
typedef unsigned v2u __attribute__((ext_vector_type(2)));
typedef float f32x4 __attribute__((ext_vector_type(4)));
typedef float f32x2 __attribute__((ext_vector_type(2)));
typedef short bf16x8 __attribute__((ext_vector_type(8)));
typedef __bf16 bf16x2_t __attribute__((ext_vector_type(2)));
#define RLX_AGENT __ATOMIC_RELAXED, __HIP_MEMORY_SCOPE_AGENT
#define LDS_WAIT() asm volatile("s_waitcnt lgkmcnt(0)" ::: "memory")
#define VM_WAIT() asm volatile("s_waitcnt vmcnt(0)" ::: "memory")
#define MFMA16(a, b, c) __builtin_amdgcn_mfma_f32_16x16x32_bf16((a), (b), (c), 0, 0, 0)
__device__ __forceinline__ unsigned pk2(float lo, float hi) { f32x2 v = {lo, hi}; bf16x2_t b = __builtin_convertvector(v, bf16x2_t); return __builtin_bit_cast(unsigned, b); }
__device__ __forceinline__ float bflo(unsigned w) { return __uint_as_float(w << 16); }
__device__ __forceinline__ float bfhi(unsigned w) { return __uint_as_float(w & 0xffff0000u); }
__device__ __forceinline__ float bf1(bf16 b) { return __uint_as_float(((unsigned)b) << 16); }
__device__ __forceinline__ bf16 f2bf(float f) { return (bf16)(pk2(f, 0.f) & 0xffffu); }
__device__ __forceinline__ float wave_sum(float v) {
#pragma unroll
    for (int o = 1; o < 64; o <<= 1) v += __shfl_xor(v, o);
    return v;
}
__device__ __forceinline__ float sigmoidf_(float x) { return __builtin_amdgcn_rcpf(1.f + __builtin_amdgcn_exp2f(-1.4426950408889634f * x)); }
__device__ __forceinline__ float siluf_(float x) { return x * __builtin_amdgcn_rcpf(1.f + __builtin_amdgcn_exp2f(-1.4426950408889634f * x)); }
__device__ __forceinline__ float rsqrtf_(float x) { return __builtin_amdgcn_rsqf(x); }
#define XB_TMO      128
#define XB_XCNT(j)  (256  + 64 * (j))
#define XB_XSUB(j)  (1280 + 64 * (j))
#define XB_XGEN(j)  (2304 + 64 * (j))
#define XB_TOP      3328
#define XB_TOPGEN   3392
#define XCD_BAR_WORDS 3456
#define XB_SPIN_CAP (1u << 18)

__device__ __forceinline__ unsigned xb_ld(unsigned* p)              { return __hip_atomic_load(p, __ATOMIC_RELAXED, __HIP_MEMORY_SCOPE_AGENT); }
__device__ __forceinline__ unsigned xb_add(unsigned* p, unsigned v) { return __hip_atomic_fetch_add(p, v, __ATOMIC_RELAXED, __HIP_MEMORY_SCOPE_AGENT); }
__device__ __forceinline__ unsigned xb_xcc_id() { return (unsigned)__builtin_amdgcn_s_getreg((3 << 11) | 20) & 0xFu; }
#define XB_SPIN(cond, bar) do { unsigned _sp = 0; while (cond) { __builtin_amdgcn_s_sleep(1); \
    if ((++_sp & 255u) == 0u) { if (xb_ld(&(bar)[XB_TMO])) break; if (_sp > XB_SPIN_CAP) { atomicAdd(&(bar)[XB_TMO], 1u); break; } } } } while (0)

struct XcdBarrier {
    unsigned* bar; unsigned x; int wave;
    volatile LAS unsigned* st;
};

__device__ __forceinline__ bool xb_thread0(int wave) { return wave == 0 && __builtin_amdgcn_mbcnt_hi(~0u, __builtin_amdgcn_mbcnt_lo(~0u, 0u)) == 0u; }
__device__ __forceinline__ XcdBarrier xcd_barrier_post(unsigned* bar, volatile LAS unsigned* st, int wave) {
    XcdBarrier b; b.bar = bar; b.x = xb_xcc_id(); b.st = st; b.wave = wave;
    if (xb_thread0(wave)) (void)xb_add(&bar[XB_XCNT(b.x)], 1u);
    return b;
}
__device__ __forceinline__ void xcd_barrier_complete(unsigned* bar, unsigned x, unsigned& nloc, unsigned& nx) {
    const unsigned G = gridDim.x * gridDim.y * gridDim.z;
    unsigned sum, cnt, mine, sp = 0u;
    for (;;) {
        sum = 0u; cnt = 0u; mine = 0u;
#pragma unroll
        for (unsigned j = 0; j < 16; ++j) { const unsigned c = xb_ld(&bar[XB_XCNT(j)]); sum += c; cnt += (c > 0u) ? 1u : 0u; mine = (j == x) ? c : mine; }
        if (sum == G) break;
        __builtin_amdgcn_s_sleep(1);
        if ((++sp & 255u) == 0u) { if (xb_ld(&bar[XB_TMO])) break; if (sp > XB_SPIN_CAP) { atomicAdd(&bar[XB_TMO], 1u); break; } }
    }
    nloc = mine > 0u ? mine : 1u; nx = cnt > 0u ? cnt : 1u;
}

__device__ __forceinline__ void xcd_barrier(const XcdBarrier& b) {
    asm volatile("s_waitcnt vmcnt(0)" ::: "memory");
    __syncthreads();
    if (xb_thread0(b.wave)) {
        unsigned* bar = b.bar;
        __builtin_amdgcn_s_waitcnt(0);
        unsigned nloc = b.st[0], nx = b.st[1];
        if (nloc == 0u) { xcd_barrier_complete(bar, b.x, nloc, nx); b.st[0] = nloc; b.st[1] = nx; }
        const unsigned old = xb_add(&bar[XB_XSUB(b.x)], 1u);
        const unsigned gen = old / nloc;
        if (old + 1u == (gen + 1u) * nloc) {
            __builtin_amdgcn_fence(__ATOMIC_RELEASE, "agent");
            asm volatile("s_waitcnt vmcnt(0)" ::: "memory");
            const unsigned og = xb_add(&bar[XB_TOP], 1u);
            const unsigned tg = og / nx;
            if (og + 1u == (tg + 1u) * nx) xb_add(&bar[XB_TOPGEN], 1u);
            else XB_SPIN(xb_ld(&bar[XB_TOPGEN]) == tg, bar);
            __builtin_amdgcn_fence(__ATOMIC_ACQUIRE, "agent");
            xb_add(&bar[XB_XGEN(b.x)], 1u);
            asm volatile("s_waitcnt vmcnt(0)" ::: "memory");
        } else {
            XB_SPIN(xb_ld(&bar[XB_XGEN(b.x)]) == gen, bar);
            __builtin_amdgcn_fence(__ATOMIC_ACQUIRE, "agent");
            asm volatile("s_waitcnt vmcnt(0)" ::: "memory");
        }
    }
    __syncthreads();
}
struct Frame {
    LAS unsigned char* lds;
    unsigned* ctl;
    unsigned char* ws;
    const float* in[27];
    float* out;
    int tid, lane, wave, vcu, G;
};
enum { I_X = 0, I_LNMG, I_LNMB, I_LNFG, I_LNFB, I_AWIN, I_ACONV, I_AALOG, I_ADT, I_ANG, I_AWOUT, I_BWIN, I_BLAM, I_BNG, I_BWOUT, I_REL, I_CWIN, I_CLNG, I_CLNB, I_CWS, I_CBS, I_CWOUT, I_WR, I_RB, I_EW1, I_EW3, I_EW2 };

__device__ __forceinline__ void tr_item(const float* W, int ldw, int k0, int n0, bf16* WT, size_t dst_row0, int K, LAS float* scr, int lane) {
#pragma unroll 8
    for (int i = 0; i < 32; ++i) { const int kk = 2 * i + (lane >> 5); scr[kk * 33 + (lane & 31)] = W[(size_t)(k0 + kk) * ldw + n0 + (lane & 31)]; }
    LDS_WAIT(); asm volatile("" ::: "memory");
    const int c = lane & 7;
#pragma unroll
    for (int j = 0; j < 4; ++j) { const int n = (lane >> 3) + 8 * j; const LAS float* s = scr + (8 * c) * 33 + n;
        v4u o; o.x = pk2(s[0 * 33], s[1 * 33]); o.y = pk2(s[2 * 33], s[3 * 33]); o.z = pk2(s[4 * 33], s[5 * 33]); o.w = pk2(s[6 * 33], s[7 * 33]);
        *(GAS v4u*)(WT + (dst_row0 + n) * K + k0 + 8 * c) = o; }
    LDS_WAIT(); asm volatile("" ::: "memory");
}
__device__ __forceinline__ void tr_matrix_item(const float* W, int K, int N, int ldw, bf16* WT, LAS float* scr, int item, int lane) {
    const int nblk = N / 32, kb = item / nblk, nb = item % nblk;
    tr_item(W, ldw, 64 * kb, 32 * nb, WT, (size_t)32 * nb, K, scr, lane);
}
__device__ __forceinline__ void colmax_matrix(Frame& F, const float* W, int K, int N, int ldw, unsigned* cm) {
    const int gw = F.vcu * NWAVES + F.wave, NGW = F.G * NWAVES, lane = F.lane, nb_n = N / 256;
    for (int it = gw; it < (K / 64) * nb_n; it += NGW) { const int kb = it / nb_n, nb = it % nb_n; const float* p = W + (size_t)(kb * 64) * ldw + nb * 256 + 4 * lane; f32x4 m = {0.f, 0.f, 0.f, 0.f};
#pragma unroll 16
        for (int kk = 0; kk < 64; ++kk) { const f32x4 v = *(const GAS f32x4*)(p + (size_t)kk * ldw); m = __builtin_elementwise_max(m, __builtin_elementwise_abs(v)); }
#pragma unroll
        for (int e = 0; e < 4; ++e) __hip_atomic_fetch_max(cm + nb * 256 + 4 * lane + e, __float_as_uint(m[e]), RLX_AGENT); }
}
__device__ __forceinline__ unsigned q8x4(float a, float b, float c, float d) {
    const int qa = (int)rintf(fminf(fmaxf(a, -127.f), 127.f)), qb = (int)rintf(fminf(fmaxf(b, -127.f), 127.f)), qc = (int)rintf(fminf(fmaxf(c, -127.f), 127.f)), qd = (int)rintf(fminf(fmaxf(d, -127.f), 127.f));
    return (unsigned)(qa & 0xff) | ((unsigned)(qb & 0xff) << 8) | ((unsigned)(qc & 0xff) << 16) | ((unsigned)(qd & 0xff) << 24);
}
__device__ __forceinline__ void cv_load64(const float* W, int ldw, int k0, int n0, int lane, f32x4 (&v)[16]) {
#pragma unroll
    for (int i = 0; i < 16; ++i) v[i] = *(const GAS f32x4*)(W + (size_t)(k0 + 4 * i + (lane >> 4)) * ldw + n0 + 4 * (lane & 15));
}
template <bool I8> __device__ __forceinline__ void cv_finish64(const f32x4 (&v)[16], int k0, int n0, void* dst, size_t dst_row0, int Kp, const unsigned* cm, float* sbout, LAS float* scr, int lane) {
#pragma unroll
    for (int i = 0; i < 16; ++i) *(LAS f32x4*)(scr + (4 * i + (lane >> 4)) * 68 + 4 * (lane & 15)) = v[i];
    LDS_WAIT(); asm volatile("" ::: "memory");
    const LAS float* s = scr + lane;
    if constexpr (I8) {
        const float mx = __uint_as_float(cm[n0 + lane]); const float inv = mx > 0.f ? 127.f / mx : 0.f;
        GAS v4u* o = (GAS v4u*)((unsigned char*)dst + (dst_row0 + lane) * Kp + k0);
#pragma unroll
        for (int c = 0; c < 4; ++c) { v4u w;
            w.x = q8x4(s[(16 * c + 0) * 68] * inv, s[(16 * c + 1) * 68] * inv, s[(16 * c + 2) * 68] * inv, s[(16 * c + 3) * 68] * inv); w.y = q8x4(s[(16 * c + 4) * 68] * inv, s[(16 * c + 5) * 68] * inv, s[(16 * c + 6) * 68] * inv, s[(16 * c + 7) * 68] * inv);
            w.z = q8x4(s[(16 * c + 8) * 68] * inv, s[(16 * c + 9) * 68] * inv, s[(16 * c + 10) * 68] * inv, s[(16 * c + 11) * 68] * inv); w.w = q8x4(s[(16 * c + 12) * 68] * inv, s[(16 * c + 13) * 68] * inv, s[(16 * c + 14) * 68] * inv, s[(16 * c + 15) * 68] * inv);
            o[c] = w; }
        if (k0 == 0) sbout[n0 + lane] = mx * (1.f / 127.f);
    } else {
        GAS v4u* o = (GAS v4u*)((bf16*)dst + (dst_row0 + lane) * Kp + k0);
#pragma unroll
        for (int c = 0; c < 8; ++c) { v4u w;
            w.x = pk2(s[(8 * c + 0) * 68], s[(8 * c + 1) * 68]); w.y = pk2(s[(8 * c + 2) * 68], s[(8 * c + 3) * 68]); w.z = pk2(s[(8 * c + 4) * 68], s[(8 * c + 5) * 68]); w.w = pk2(s[(8 * c + 6) * 68], s[(8 * c + 7) * 68]);
            o[c] = w; }
    }
    LDS_WAIT(); asm volatile("" ::: "memory");
}
template <bool I8> __device__ __forceinline__ void cv_item64(const float* W, int ldw, int k0, int n0, void* dst, size_t dst_row0, int Kp, const unsigned* cm, float* sbout, LAS float* scr, int lane) {
    f32x4 v[16]; cv_load64(W, ldw, k0, n0, lane, v); cv_finish64<I8>(v, k0, n0, dst, dst_row0, Kp, cm, sbout, scr, lane);
}
__device__ __forceinline__ void q8_item(const float* W, int ldw, int k0, int n0, unsigned char* W8, size_t dst_row0, int K, const unsigned* cm, float* sbout, LAS float* scr, int lane) {
#pragma unroll 8
    for (int i = 0; i < 32; ++i) { const int kk = 2 * i + (lane >> 5); scr[kk * 33 + (lane & 31)] = W[(size_t)(k0 + kk) * ldw + n0 + (lane & 31)]; }
    LDS_WAIT(); asm volatile("" ::: "memory");
#pragma unroll
    for (int j = 0; j < 2; ++j) { const int id = lane + 64 * j, n = id >> 2, c = id & 3; const float mx = __uint_as_float(cm[n0 + n]); const float inv = mx > 0.f ? 127.f / mx : 0.f;
        const LAS float* s = scr + (16 * c) * 33 + n; v4u o;
        o.x = q8x4(s[0 * 33] * inv, s[1 * 33] * inv, s[2 * 33] * inv, s[3 * 33] * inv); o.y = q8x4(s[4 * 33] * inv, s[5 * 33] * inv, s[6 * 33] * inv, s[7 * 33] * inv);
        o.z = q8x4(s[8 * 33] * inv, s[9 * 33] * inv, s[10 * 33] * inv, s[11 * 33] * inv); o.w = q8x4(s[12 * 33] * inv, s[13 * 33] * inv, s[14 * 33] * inv, s[15 * 33] * inv);
        *(GAS v4u*)(W8 + (dst_row0 + n) * K + k0 + 16 * c) = o; }
    if (k0 == 0 && lane < 32) sbout[n0 + lane] = __uint_as_float(cm[n0 + lane]) * (1.f / 127.f);
    LDS_WAIT(); asm volatile("" ::: "memory");
}
__device__ __forceinline__ void phase_quant_inproj(Frame& F, int li, int vcu, int G) {
    LAS float* scr = (LAS float*)(F.lds + F.wave * 17408);
    const int NGW = G * NWAVES, gw = (vcu * NWAVES + F.wave + NGW / 2) % NGW, lane = F.lane, kind = li % 3, j = li / 3;
    const float* W = kind == 0 ? F.in[I_AWIN] + (size_t)j * 1024 * A_INW : (kind == 1 ? F.in[I_BWIN] + (size_t)j * 1024 * 3072 : F.in[I_CWIN] + (size_t)j * 1024 * 4096);
    const int N = kind == 1 ? 3072 : 4096, ldw = kind == 0 ? A_INW : N; const unsigned* cm = F.ctl + CW_CMAX + (kind == 0 ? j * 4096 : (kind == 1 ? 8192 : 12288));
    unsigned char* W8 = F.ws + WS_W; float* sbw = (float*)(F.ws + WS_SBW); const int nblk = N / 32;
    LAS float* scr64 = (LAS float*)(F.lds + F.wave * 17408); const int nblk64 = N / 64;
    for (int it = gw; it < 16 * nblk64; it += NGW) { const int kb = it / nblk64, nb = it % nblk64; cv_item64<true>(W, ldw, 64 * kb, 64 * nb, W8, (size_t)64 * nb, 1024, cm, sbw, scr64, lane); }
}
__device__ __forceinline__ void phase_colmax_all(Frame& F) {
    unsigned* cm = F.ctl + CW_CMAX;
    { const int gw = F.vcu * NWAVES + F.wave, NGW = F.G * NWAVES, lane = F.lane;
      for (int it = gw; it < DEPTH * NEXP * 2 * 16 * 2; it += NGW) { const int nb = it & 1, kb = (it >> 1) & 15, mat = (it >> 5) & 1, e = (it >> 6) & 15, li = it >> 10;
          const float* p = (mat ? F.in[I_EW3] : F.in[I_EW1]) + ((size_t)(li * NEXP + e) * 1024 + kb * 64) * 512 + nb * 256 + 4 * lane; f32x4 m = {0.f, 0.f, 0.f, 0.f};
#pragma unroll 16
          for (int kk = 0; kk < 64; ++kk) { const f32x4 v = *(const GAS f32x4*)(p + (size_t)kk * 512); m = __builtin_elementwise_max(m, __builtin_elementwise_abs(v)); }
          const int n0 = nb * 256 + 4 * lane;
#pragma unroll
          for (int q = 0; q < 4; ++q) __hip_atomic_fetch_max(cm + 16384 + li * 16384 + e * 1024 + (n0 >> 7) * 256 + (n0 & 127) + (mat ? 128 : 0) + q, __float_as_uint(m[q]), RLX_AGENT); } }
    colmax_matrix(F, F.in[I_AWIN], 1024, 4096, A_INW, cm); colmax_matrix(F, F.in[I_AWIN] + (size_t)1024 * A_INW, 1024, 4096, A_INW, cm + 4096);
    colmax_matrix(F, F.in[I_BWIN], 1024, 3072, 3072, cm + 8192); colmax_matrix(F, F.in[I_CWIN], 1024, 4096, 4096, cm + 12288);
    colmax_matrix(F, F.in[I_AWOUT], 1024, 1024, 1024, cm + 81920); colmax_matrix(F, F.in[I_AWOUT] + (size_t)1024 * 1024, 1024, 1024, 1024, cm + 81920 + 1024); colmax_matrix(F, F.in[I_BWOUT], 1024, 1024, 1024, cm + 81920 + 2048);
}
__device__ __forceinline__ void st_row_i8(unsigned char* row8, float* scale, int lane, const float (&v)[16]) {
    float m = 0.f;
#pragma unroll
    for (int k = 0; k < 16; ++k) m = fmaxf(m, fabsf(v[k]));
#pragma unroll
    for (int o = 1; o < 64; o <<= 1) m = fmaxf(m, __shfl_xor(m, o));
    const float inv = m > 0.f ? 127.f / m : 0.f;
    GAS unsigned* p = (GAS unsigned*)row8 + lane;
#pragma unroll
    for (int j = 0; j < 4; ++j) p[64 * j] = q8x4(v[4 * j] * inv, v[4 * j + 1] * inv, v[4 * j + 2] * inv, v[4 * j + 3] * inv);
    if (lane == 0) *scale = m * (1.f / 127.f);
}
__device__ __forceinline__ void phase_convert(Frame& F, int li, bool do_i8, int parts, int vcu, int G) {
    LAS float* scr = (LAS float*)(F.lds + F.wave * 17408);
    const int gw = vcu * NWAVES + F.wave, NGW = G * NWAVES, lane = F.lane;
    const int kind = li % 3, j = li / 3;
    bf16* Wm = (bf16*)(F.ws + WS_W);
    {
        const float* w1 = F.in[I_EW1] + (size_t)li * NEXP * 1024 * 512; const float* w3 = F.in[I_EW3] + (size_t)li * NEXP * 1024 * 512; const float* w2 = F.in[I_EW2] + (size_t)li * NEXP * 512 * 1024;
        bf16* W13 = (bf16*)(F.ws + WS_W13); bf16* W2t = (bf16*)(F.ws + WS_W2);
        LAS float* scr64 = (LAS float*)(F.lds + F.wave * 17408);
        const int mode = (parts & 3) == 3 ? 0 : ((parts & 1) ? 1 : 2), nitems = (parts & 3) == 0 ? 0 : NEXP * (mode == 0 ? 384 : (mode == 1 ? 256 : 128));
#define MW_ER(it_) const int e_ = mode == 0 ? (it_) / 384 : (mode == 1 ? (it_) >> 8 : (it_) >> 7), r_ = mode == 0 ? (it_) % 384 : (mode == 1 ? ((it_) & 255) : 256 + ((it_) & 127))
#define MW_LOAD(it_, v_) do { MW_ER(it_); \
            if (r_ < 256) { const int w3s = r_ >> 7, q_ = r_ & 127; cv_load64((w3s ? w3 : w1) + (size_t)e_ * 1024 * 512, 512, 64 * (q_ >> 3), 64 * (q_ & 7), lane, v_); } \
            else { const int q_ = r_ - 256; cv_load64(w2 + (size_t)e_ * 512 * 1024, 1024, 64 * (q_ >> 4), 64 * (q_ & 15), lane, v_); } } while (0)
#define MW_FIN(it_, v_) do { MW_ER(it_); \
            if (r_ < 256) { const int w3s = r_ >> 7, q_ = r_ & 127, n0_ = 64 * (q_ & 7); const size_t drow = (size_t)e_ * 1024 + (n0_ >> 7) * 256 + (n0_ & 127) + (w3s ? 128 : 0); \
                cv_finish64<true>(v_, 64 * (q_ >> 3), n0_, W13, drow, 1024, F.ctl + CW_CMAX + 16384 + li * 16384 + drow - n0_, (float*)(F.ws + WS_SB13) + drow - n0_, scr64, lane); } \
            else { const int q_ = r_ - 256; cv_finish64<false>(v_, 64 * (q_ >> 4), 64 * (q_ & 15), W2t, (size_t)e_ * 1024 + 64 * (q_ & 15), 512, nullptr, nullptr, scr64, lane); } } while (0)
        { f32x4 va[16], vb[16]; int it = gw;
          if (it < nitems) MW_LOAD(it, va);
          while (it < nitems) {
              const int it1 = it + NGW, it2 = it + 2 * NGW;
              if (it1 < nitems) MW_LOAD(it1, vb);
              MW_FIN(it, va);
              if (it1 >= nitems) break;
              if (it2 < nitems) MW_LOAD(it2, va);
              MW_FIN(it1, vb);
              it = it2; } }
#undef MW_LOAD
#undef MW_FIN
#undef MW_ER
    }
    if (!(parts & 4)) return;
    if (kind == 0) {
        const float* win = F.in[I_AWIN] + (size_t)j * 1024 * A_INW; const float* wout = F.in[I_AWOUT] + (size_t)j * 1024 * 1024;
        bf16* Win = Wm; bf16* Wout = Wm + (size_t)4128 * 1024;
        for (int it = (gw + NGW - (9 * NGW) / 32) % NGW; it < 16 * 32; it += NGW) { const int kb = it >> 5, nb = it & 31; q8_item(wout, 1024, 64 * kb, 32 * nb, (unsigned char*)Wout, (size_t)32 * nb, 1024, F.ctl + CW_CMAX + 81920 + j * 1024, (float*)(F.ws + WS_SBO), scr, lane); }
        for (int idx = gw * 64 + lane; idx < 16 * 1024; idx += NGW * 64) { const int n = idx >> 10, k = idx & 1023; Win[(size_t)(4096 + n) * 1024 + k] = f2bf(win[(size_t)k * A_INW + 4096 + n]); }
    } else if (kind == 1) {
        const float* win = F.in[I_BWIN] + (size_t)j * 1024 * 3072; const float* wout = F.in[I_BWOUT] + (size_t)j * 1024 * 1024;
        bf16* Win = Wm; bf16* Wout = Wm + (size_t)4128 * 1024;
        for (int it = (gw + NGW - (9 * NGW) / 32) % NGW; it < 16 * 32; it += NGW) { const int kb = it >> 5, nb = it & 31; q8_item(wout, 1024, 64 * kb, 32 * nb, (unsigned char*)Wout, (size_t)32 * nb, 1024, F.ctl + CW_CMAX + 81920 + 2048, (float*)(F.ws + WS_SBO), scr, lane); }
        float* lut = (float*)(F.ws + WS_LUT); const float* rb = F.in[I_REL];
        for (int idx = gw * 64 + lane; idx < 8 * 384; idx += NGW * 64) { const int h = idx / 384, n = idx % 384;
            int bk = n; if (n >= 16) { bk = 16 + (int)(logf((float)n / 16.0f) / logf(8.0f) * 16.0f); bk = bk > 31 ? 31 : bk; }
            lut[idx] = (rb[bk * 8 + h] - rb[31 * 8 + h]) * 1.4426950408889634f; }
    } else {
        const float* win = F.in[I_CWIN] + (size_t)j * 1024 * 4096; const float* wout = F.in[I_CWOUT] + (size_t)j * 2048 * 1024;
        bf16* Win = Wm; bf16* Wout = Wm + (size_t)4128 * 1024;
        for (int it = (gw + NGW - (9 * NGW) / 32) % NGW; it < 32 * 32; it += NGW) tr_matrix_item(wout, 2048, 1024, 1024, Wout, scr, it, lane);
        bf16* wsb = (bf16*)(F.ws + WS_WSB); const float* wsrc = F.in[I_CWS] + (size_t)j * 8 * 128 * 128;
        for (int idx = gw * 64 + lane; idx < 8 * 128 * 128; idx += NGW * 64) { const int t = (idx >> 7) & 127, s = idx & 127; wsb[idx] = f2bf(t >= s ? wsrc[idx] : 0.f); }
        float* wsum = (float*)(F.ws + WS_WSUM);
        for (int rid = gw; rid < 8 * 128; rid += NGW) { const int t = rid & 127; float sacc = 0.f;
            for (int s = lane; s < 128; s += 64) sacc += (t >= s) ? bf1(f2bf(wsrc[rid * 128 + s])) : 0.f;
            sacc = wave_sum(sacc); if (lane == 0) wsum[rid] = sacc; }
    }
    if (do_i8) phase_quant_inproj(F, li, vcu, G);
}
__device__ __forceinline__ void thin_gemm16(Frame& F, const bf16* A, const bf16* Wt, float* out) {
    const int gw = F.vcu * NWAVES + F.wave, NGW = F.G * NWAVES, lane = F.lane, fr = lane & 15, fq = lane >> 4;
    for (int rg = gw; rg < T / 16; rg += NGW) {
        const bf16* ap = A + (size_t)(rg * 16 + fr) * 1024 + 8 * fq; const bf16* bp = Wt + (size_t)fr * 1024 + 8 * fq;
        f32x4 acc = {0.f, 0.f, 0.f, 0.f};
#pragma unroll 8
        for (int s = 0; s < 32; ++s) { const bf16x8 a = *(const GAS bf16x8*)(ap + 32 * s), b = *(const GAS bf16x8*)(bp + 32 * s); acc = MFMA16(a, b, acc); }
#pragma unroll
        for (int r = 0; r < 4; ++r) out[(size_t)(rg * 16 + 4 * fq + r) * 16 + fr] = acc[r];
    }
}

__device__ __forceinline__ void ld_row_bf16(const bf16* row, int lane, float (&v)[16]) {
    const GAS v2u* p = (const GAS v2u*)row + lane;
#pragma unroll
    for (int j = 0; j < 4; ++j) { const v2u w = p[64 * j]; v[4 * j] = bflo(w.x); v[4 * j + 1] = bfhi(w.x); v[4 * j + 2] = bflo(w.y); v[4 * j + 3] = bfhi(w.y); }
}
__device__ __forceinline__ void ld_vec_f32(const float* p, int lane, float (&v)[16]) {
    const GAS f32x4* q = (const GAS f32x4*)p + lane;
#pragma unroll
    for (int j = 0; j < 4; ++j) { const f32x4 w = q[64 * j]; v[4 * j] = w.x; v[4 * j + 1] = w.y; v[4 * j + 2] = w.z; v[4 * j + 3] = w.w; }
}
__device__ __forceinline__ void ln16(float (&v)[16], const float (&g)[16], const float (&b)[16]) {
    float s = 0.f;
#pragma unroll
    for (int k = 0; k < 16; ++k) s += v[k];
    const float mean = wave_sum(s) * (1.f / 1024.f); float q = 0.f;
#pragma unroll
    for (int k = 0; k < 16; ++k) { v[k] -= mean; q += v[k] * v[k]; }
    const float rstd = rsqrtf_(wave_sum(q) * (1.f / 1024.f) + LN_EPS);
#pragma unroll
    for (int k = 0; k < 16; ++k) v[k] = v[k] * rstd * g[k] + b[k];
}
__device__ __forceinline__ void st_row_bf16(bf16* row, int lane, const float (&v)[16]) {
    GAS v2u* p = (GAS v2u*)row + lane;
#pragma unroll
    for (int j = 0; j < 4; ++j) { v2u o; o.x = pk2(v[4 * j], v[4 * j + 1]); o.y = pk2(v[4 * j + 2], v[4 * j + 3]); p[64 * j] = o; }
}
__device__ __forceinline__ void phase_init(Frame& F) {
    const int lane = F.lane, gw = F.vcu * NWAVES + F.wave, NGW = F.G * NWAVES;
    bf16* H = (bf16*)(F.ws + WS_H); unsigned char* H8 = F.ws + WS_H8; float* HS = (float*)(F.ws + WS_HS);
    for (int row0 = gw; row0 < T; row0 += 2 * NGW) {
        float v[2][16];
#pragma unroll
        for (int q = 0; q < 2; ++q) { const int row = (row0 + q * NGW < T) ? row0 + q * NGW : row0; ld_vec_f32(F.in[I_X] + (size_t)row * 1024, lane, v[q]); }
#pragma unroll
        for (int q = 0; q < 2; ++q) { const int row = row0 + q * NGW; if (row >= T) break;
            st_row_bf16(H + (size_t)row * 1024, lane, v[q]); st_row_i8(H8 + (size_t)row * 1024, HS + row, lane, v[q]); }
    }
}

__device__ __forceinline__ void phase_ln_mix(Frame& F, int li, const unsigned char* y, const float* ysc, bool use_y) {
    constexpr int WP = 2064;
    LAS unsigned char* wrb = F.lds;
    LAS float* lg_ = (LAS float*)(F.lds + 33792);
    LAS float* lb_ = lg_ + 1024;
    LAS float* tbuf = lb_ + 1024;
    LAS int* lcnt = (LAS int*)(tbuf + 8 * 256);
    LAS int* lbase = lcnt + 16;
    LAS int* rinfo = lcnt + 64;
    LAS float* rw = (LAS float*)(rinfo + 512);
    const int tid = F.tid, lane = F.lane, wave = F.wave, fr = lane & 15, fq = lane >> 4;
    const float* wrg = F.in[I_WR];
    for (int idx = tid; idx < 16384; idx += NTHR) { const int c = idx >> 4, e = idx & 15; *(LAS bf16*)(wrb + e * WP + c * 2) = f2bf(wrg[idx]); }
    for (int idx = tid; idx < 1024; idx += NTHR) { lg_[idx] = F.in[I_LNMG][li * 1024 + idx]; lb_[idx] = F.in[I_LNMB][li * 1024 + idx]; }
    bf16* H = (bf16*)(F.ws + WS_H);
    unsigned* gcnt = F.ctl + CW_CNT + li * 1024;
    int* toke = (int*)(F.ws + WS_TOKE); int* tokp = (int*)(F.ws + WS_TOKP); float* tokw = (float*)(F.ws + WS_TOKW);
    const float* rbg = F.in[I_RB];
    __syncthreads();
    LAS float* gbmax = (LAS float*)(rw + 256);
    if (wave == 0) { float gm = 0.f, bm = 0.f; for (int i = lane; i < 1024; i += 64) { gm = fmaxf(gm, fabsf(lg_[i])); bm = fmaxf(bm, fabsf(lb_[i])); }
#pragma unroll
        for (int o = 1; o < 64; o <<= 1) { gm = fmaxf(gm, __shfl_xor(gm, o)); bm = fmaxf(bm, __shfl_xor(bm, o)); }
        if (lane == 0) { gbmax[0] = gm; gbmax[1] = bm; } }
    __syncthreads();
    for (int rg = F.vcu; rg < T / 128; rg += F.G) {
        if (tid < 16) lcnt[tid] = 0;
        __syncthreads();
        const size_t row = (size_t)rg * 128 + wave * 16 + fr;
        const bf16* hp = H + row * 1024 + 8 * fq; const unsigned char* yp = y + row * 1024 + 8 * fq; const float* ysr = ysc + row * 16;
        float sum = 0.f, sq = 0.f, vmx = -INFINITY, vmn = INFINITY;
#pragma unroll 2
        for (int sc = 0; sc < 8; ++sc) {
            v4u hq[4]; v2u yq[4]; float ys2[2];
#pragma unroll
            for (int k = 0; k < 4; ++k) { hq[k] = *(const GAS v4u*)(hp + 32 * (4 * sc + k)); if (use_y) yq[k] = *(const GAS v2u*)(yp + 32 * (4 * sc + k)); else yq[k] = (v2u){0x80808080u, 0x80808080u}; }
#pragma unroll
            for (int k = 0; k < 2; ++k) ys2[k] = use_y ? *(const GAS float*)(ysr + 2 * sc + k) : 0.f;
#pragma unroll
            for (int k = 0; k < 4; ++k) { const unsigned hw[4] = {hq[k].x, hq[k].y, hq[k].z, hq[k].w}; const float ys = ys2[k >> 1], yc = -128.f * ys;
#pragma unroll
                for (int e = 0; e < 4; ++e) { const unsigned yw = ((e < 2) ? yq[k].x : yq[k].y) ^ 0x80808080u; const int sh = 16 * (e & 1);
                    const float a = fmaf(ys, (float)((yw >> sh) & 255u), fmaf(DN_ALPHA, bflo(hw[e]), yc)), c = fmaf(ys, (float)((yw >> (sh + 8)) & 255u), fmaf(DN_ALPHA, bfhi(hw[e]), yc));
                    sum += a + c; sq += a * a + c * c; vmx = fmaxf(vmx, fmaxf(a, c)); vmn = fminf(vmn, fminf(a, c)); } }
        }
        sum += __shfl_xor(sum, 16); sum += __shfl_xor(sum, 32); sq += __shfl_xor(sq, 16); sq += __shfl_xor(sq, 32);
        vmx = fmaxf(vmx, __shfl_xor(vmx, 16)); vmx = fmaxf(vmx, __shfl_xor(vmx, 32)); vmn = fminf(vmn, __shfl_xor(vmn, 16)); vmn = fminf(vmn, __shfl_xor(vmn, 32));
        const float mean = sum * (1.f / 1024.f); const float rstd = rsqrtf_(fmaxf(sq * (1.f / 1024.f) - mean * mean, 0.f) + LN_EPS);
        const float qmax = fmaxf(vmx - mean, mean - vmn) * rstd * gbmax[0] + gbmax[1]; const float qinv = qmax > 0.f ? 127.f / qmax : 0.f;
        if (fq == 0) ((float*)(F.ws + WS_HS))[row] = qmax * (1.f / 127.f);
        bf16* hrow = H + row * 1024 + 8 * fq; unsigned char* r8 = F.ws + WS_H8 + row * 1024 + 8 * fq;
        f32x4 acc = {0.f, 0.f, 0.f, 0.f};
        v4u hq2[2][4]; v2u yq2[2][4]; float ys22[2][2];
#define LM_LOAD(sc_) do { _Pragma("unroll") for (int k = 0; k < 4; ++k) { hq2[(sc_) & 1][k] = *(const GAS v4u*)(hp + 32 * (4 * (sc_) + k)); if (use_y) yq2[(sc_) & 1][k] = *(const GAS v2u*)(yp + 32 * (4 * (sc_) + k)); else yq2[(sc_) & 1][k] = (v2u){0x80808080u, 0x80808080u}; } \
            _Pragma("unroll") for (int k = 0; k < 2; ++k) ys22[(sc_) & 1][k] = use_y ? *(const GAS float*)(ysr + 2 * (sc_) + k) : 0.f; } while (0)
        LM_LOAD(0);
#pragma unroll
        for (int sc = 0; sc < 8; ++sc) {
            if (sc + 1 < 8) LM_LOAD(sc + 1);
            const v4u (&hq)[4] = hq2[sc & 1]; const v2u (&yq)[4] = yq2[sc & 1];
#pragma unroll
            for (int k = 0; k < 4; ++k) { const int s = 4 * sc + k; const int c0 = 32 * s + 8 * fq;
                const f32x4 g0 = *(const LAS f32x4*)(lg_ + c0), g1 = *(const LAS f32x4*)(lg_ + c0 + 4), b0 = *(const LAS f32x4*)(lb_ + c0), b1 = *(const LAS f32x4*)(lb_ + c0 + 4);
                const float gg[8] = {g0.x, g0.y, g0.z, g0.w, g1.x, g1.y, g1.z, g1.w}, bb[8] = {b0.x, b0.y, b0.z, b0.w, b1.x, b1.y, b1.z, b1.w};
                const unsigned hw[4] = {hq[k].x, hq[k].y, hq[k].z, hq[k].w}; float ov[8]; unsigned ow[4]; const float ys = ys22[sc & 1][k >> 1], yc = -128.f * ys;
#pragma unroll
                for (int e = 0; e < 4; ++e) { const unsigned yw = ((e < 2) ? yq[k].x : yq[k].y) ^ 0x80808080u; const int sh = 16 * (e & 1);
                    const float a = fmaf(ys, (float)((yw >> sh) & 255u), fmaf(DN_ALPHA, bflo(hw[e]), yc)), c = fmaf(ys, (float)((yw >> (sh + 8)) & 255u), fmaf(DN_ALPHA, bfhi(hw[e]), yc));
                    ov[2 * e] = (a - mean) * rstd * gg[2 * e] + bb[2 * e]; ov[2 * e + 1] = (c - mean) * rstd * gg[2 * e + 1] + bb[2 * e + 1]; ow[e] = pk2(ov[2 * e], ov[2 * e + 1]); }
                const v4u o = {ow[0], ow[1], ow[2], ow[3]};
                *(GAS v4u*)(hrow + 32 * s) = o;
                v2u q; q.x = q8x4(ov[0] * qinv, ov[1] * qinv, ov[2] * qinv, ov[3] * qinv); q.y = q8x4(ov[4] * qinv, ov[5] * qinv, ov[6] * qinv, ov[7] * qinv);
                *(GAS v2u*)(r8 + 32 * s) = q;
                const bf16x8 bfrag = *(const LAS bf16x8*)(wrb + fr * WP + c0 * 2);
                acc = MFMA16(__builtin_bit_cast(bf16x8, o), bfrag, acc); }
            __builtin_amdgcn_sched_barrier(0);
        }
#undef LM_LOAD
        LAS float* tb = tbuf + wave * 256;
#pragma unroll
        for (int r = 0; r < 4; ++r) tb[(4 * fq + r) * 16 + fr] = acc[r];
        asm volatile("s_waitcnt lgkmcnt(0)" ::: "memory");
        float lg[16];
        { const LAS f32x4* tp = (const LAS f32x4*)(tb + fr * 16);
#pragma unroll
          for (int q = 0; q < 4; ++q) { const f32x4 t4 = tp[q]; lg[4 * q] = t4.x; lg[4 * q + 1] = t4.y; lg[4 * q + 2] = t4.z; lg[4 * q + 3] = t4.w; } }
        float sc[16], sel[16];
#pragma unroll
        for (int e = 0; e < 16; ++e) { sc[e] = sigmoidf_(lg[e]); sel[e] = sc[e] + rbg[e]; }
        int best = 0; float bestv = -INFINITY;
#pragma unroll
        for (int gq = 0; gq < 4; ++gq) { const float a0 = sel[4 * gq], a1 = sel[4 * gq + 1], a2 = sel[4 * gq + 2], a3 = sel[4 * gq + 3];
            const float mx = fmaxf(fmaxf(a0, a1), fmaxf(a2, a3));
            const float second = fmaxf(fmaxf(fminf(a0, a1), fminf(a2, a3)), fminf(fmaxf(a0, a1), fmaxf(a2, a3)));
            const float gs = mx + second;
            if (gs > bestv) { bestv = gs; best = gq; } }
        float c0v = -INFINITY, c1v = -INFINITY; int e0 = 0, e1 = 0; float s0 = 0.f, s1 = 0.f;
#pragma unroll
        for (int e = 0; e < 16; ++e) { const bool ing = (e >> 2) == best; const float x = sel[e];
            if (ing) { if (x > c0v) { c1v = c0v; e1 = e0; s1 = s0; c0v = x; e0 = e; s0 = sc[e]; } else if (x > c1v) { c1v = x; e1 = e; s1 = sc[e]; } } }
        const float inv = 1.f / (s0 + s1);
        if (lane < 16) { const int lr = wave * 16 + lane;
            const int p0 = __hip_atomic_fetch_add(&lcnt[e0], 1, __ATOMIC_RELAXED, __HIP_MEMORY_SCOPE_WORKGROUP), p1 = __hip_atomic_fetch_add(&lcnt[e1], 1, __ATOMIC_RELAXED, __HIP_MEMORY_SCOPE_WORKGROUP);
            rinfo[lr * 4] = e0; rinfo[lr * 4 + 1] = e1; rinfo[lr * 4 + 2] = p0; rinfo[lr * 4 + 3] = p1; rw[lr * 2] = s0 * inv; rw[lr * 2 + 1] = s1 * inv; }
        __syncthreads();
        if (tid < 16) lbase[tid] = (int)__hip_atomic_fetch_add(gcnt + tid * 64, (unsigned)lcnt[tid], RLX_AGENT);
        __syncthreads();
        if (tid < 128) { const size_t r2 = (size_t)rg * 128 + tid; const int q0 = rinfo[tid * 4], q1 = rinfo[tid * 4 + 1];
            toke[r2 * 2] = q0; toke[r2 * 2 + 1] = q1; tokp[r2 * 2] = lbase[q0] + rinfo[tid * 4 + 2]; tokp[r2 * 2 + 1] = lbase[q1] + rinfo[tid * 4 + 3];
            tokw[r2 * 2] = rw[tid * 2]; tokw[r2 * 2 + 1] = rw[tid * 2 + 1]; }
        __syncthreads();
    }
}
__device__ __forceinline__ void moe_tables(Frame& F, int li) {
    LAS int* seg = (LAS int*)(F.lds + MOE_TAB_OFF); LAS int* cnt = seg + 32;
    unsigned* gcnt = F.ctl + CW_CNT + li * 1024;
    if (F.tid < 16) cnt[F.tid] = (int)__hip_atomic_load(gcnt + F.tid * 64, RLX_AGENT);
    __syncthreads();
    if (F.tid == 0) { int o = 0; for (int e = 0; e < 16; ++e) { seg[e] = o; o += (cnt[e] + 255) & ~255; } seg[16] = o; }
    __syncthreads();
}
__device__ __forceinline__ void phase_gather(Frame& F, int li, unsigned char* Xs8) {
    moe_tables(F, li);
    const LAS int* seg = (const LAS int*)(F.lds + MOE_TAB_OFF); const LAS int* cnt = seg + 32;
    const int lane = F.lane, gw = F.vcu * NWAVES + F.wave, NGW = F.G * NWAVES;
    const int* toke = (const int*)(F.ws + WS_TOKE); const int* tokp = (const int*)(F.ws + WS_TOKP);
    const unsigned char* H8 = F.ws + WS_H8; const float* HS = (const float*)(F.ws + WS_HS); float* XSC = (float*)(F.ws + WS_XSC);
    for (int base = gw; base < 2 * T; base += 64 * NGW) {
        const int myslot = base + lane * NGW; int my_r = 0;
        if (myslot < 2 * T) my_r = seg[toke[myslot]] + tokp[myslot];
        int nk = (2 * T - base + NGW - 1) / NGW; nk = nk > 64 ? 64 : nk;
        for (int k0 = 0; k0 < nk; k0 += 4) {
            v4u d[4]; float ds[4]; int rr[4];
#pragma unroll
            for (int q = 0; q < 4; ++q) { const int k = k0 + q; rr[q] = __shfl(my_r, k < nk ? k : 0); const int slot = base + (k < nk ? k : 0) * NGW;
                const GAS v4u* src = (const GAS v4u*)(H8 + (size_t)(slot >> 1) * 1024); d[q] = src[lane]; ds[q] = HS[slot >> 1]; }
#pragma unroll
            for (int q = 0; q < 4; ++q) if (k0 + q < nk) { GAS v4u* dst = (GAS v4u*)(Xs8 + (size_t)rr[q] * 1024); dst[lane] = d[q]; if (lane == 0) XSC[rr[q]] = ds[q]; }
        }
    }
    for (int pr = gw; pr < 16 * 256; pr += NGW) { const int e = pr >> 8, i = pr & 255; const int r = seg[e] + cnt[e] + i;
        if (r < seg[e + 1]) { GAS v4u* dst = (GAS v4u*)(Xs8 + (size_t)r * 1024); const v4u z = {0u, 0u, 0u, 0u}; dst[lane] = z; if (lane == 0) XSC[r] = 0.f; } }
}
__device__ __forceinline__ void phase_ln_ffn(Frame& F, int li, const unsigned char* Y2, const float* Y2S, bool use_m, bool last) {
    const int lane = F.lane, gw = F.vcu * NWAVES + F.wave, NGW = F.G * NWAVES;
    float g[16], b[16];
    ld_vec_f32(F.in[I_LNFG] + li * 1024, lane, g); ld_vec_f32(F.in[I_LNFB] + li * 1024, lane, b);
    bf16* H = (bf16*)(F.ws + WS_H);
    const int* toke = (const int*)(F.ws + WS_TOKE); const int* tokp = (const int*)(F.ws + WS_TOKP); const float* tokw = (const float*)(F.ws + WS_TOKW);
    if (use_m) moe_tables(F, li);
    const LAS int* seg = (const LAS int*)(F.lds + MOE_TAB_OFF);
    for (int base = gw; base < T; base += 64 * NGW) {
        const int myrow = base + lane * NGW; int my_r0 = 0, my_r1 = 0; float my_w0 = 0.f, my_w1 = 0.f;
        if (use_m && myrow < T) { my_r0 = seg[toke[2 * myrow]] + tokp[2 * myrow]; my_r1 = seg[toke[2 * myrow + 1]] + tokp[2 * myrow + 1]; my_w0 = tokw[2 * myrow]; my_w1 = tokw[2 * myrow + 1]; }
        int nk = (T - base + NGW - 1) / NGW; nk = nk > 64 ? 64 : nk;
        for (int k0 = 0; k0 < nk; k0 += 2) {
            float v[2][16]; unsigned qa[2][4], qc[2][4]; float sa[2][4], sc[2][4]; float w0[2], w1[2]; int rows[2];
#pragma unroll
            for (int q = 0; q < 2; ++q) { const int k = (k0 + q < nk) ? k0 + q : k0; rows[q] = base + k * NGW;
                ld_row_bf16(H + (size_t)rows[q] * 1024, lane, v[q]);
                if (use_m) { const int r0 = __shfl(my_r0, k), r1 = __shfl(my_r1, k); w0[q] = __shfl(my_w0, k); w1[q] = __shfl(my_w1, k);
                    const GAS unsigned* pa = (const GAS unsigned*)(Y2 + (size_t)r0 * 1024) + lane; const GAS unsigned* pc = (const GAS unsigned*)(Y2 + (size_t)r1 * 1024) + lane;
                    const GAS float* sap = (const GAS float*)(Y2S + (size_t)r0 * 16) + (lane >> 4); const GAS float* scp = (const GAS float*)(Y2S + (size_t)r1 * 16) + (lane >> 4);
#pragma unroll
                    for (int j = 0; j < 4; ++j) { qa[q][j] = pa[64 * j]; qc[q][j] = pc[64 * j]; sa[q][j] = sap[4 * j]; sc[q][j] = scp[4 * j]; } } }
#pragma unroll
            for (int q = 0; q < 2; ++q) {
                if (q == 1 && k0 + 1 >= nk) break;
                if (use_m) {
#pragma unroll
                    for (int j = 0; j < 4; ++j) { const float A = w0[q] * sa[q][j], C = w1[q] * sc[q][j], cj = -128.f * (A + C);
                        const unsigned xa = qa[q][j] ^ 0x80808080u, xc = qc[q][j] ^ 0x80808080u;
#pragma unroll
                        for (int i = 0; i < 4; ++i) v[q][4 * j + i] = fmaf(DN_ALPHA, v[q][4 * j + i], cj) + A * (float)((xa >> (8 * i)) & 255u) + C * (float)((xc >> (8 * i)) & 255u); } }
                else {
#pragma unroll
                    for (int k = 0; k < 16; ++k) v[q][k] = DN_ALPHA * v[q][k]; }
                ln16(v[q], g, b);
                if (last) { GAS f32x4* o = (GAS f32x4*)(F.out + (size_t)rows[q] * 1024) + lane;
#pragma unroll
                    for (int jq = 0; jq < 4; ++jq) o[64 * jq] = (f32x4){v[q][4 * jq], v[q][4 * jq + 1], v[q][4 * jq + 2], v[q][4 * jq + 3]}; }
                else { st_row_bf16(H + (size_t)rows[q] * 1024, lane, v[q]); st_row_i8(F.ws + WS_H8 + (size_t)rows[q] * 1024, (float*)(F.ws + WS_HS) + rows[q], lane, v[q]); }
            }
        }
    }
}
namespace pg8 {
struct MoeOrder : StaticOrder {
    const PG8_LAS int* seg; const PG8_LAS int* cnt; size_t estride; const int* rowtok; unsigned rowbytes;
    __device__ __forceinline__ int expert(int pm) const { int e = 0;
#pragma unroll
        for (int q = 1; q < 16; ++q) if (seg[q] <= pm * 256) e = q;
        return e; }
    __device__ __forceinline__ size_t boff(const Unit& u, size_t tstepB) const { return (size_t)expert(u.pm) * estride + (size_t)u.pn * tstepB; }
    __device__ __forceinline__ int token(const Unit& u, int r) const { const int e = expert(u.pm), p = u.pm * 256 - seg[e] + r; return p < cnt[e] ? rowtok[(size_t)e * 32768 + p] : 0; }
    __device__ __forceinline__ unsigned arow_off(const Unit& u, int r) const { return (unsigned)token(u, r) * rowbytes; }
};
struct EpiSwiGLU {
    static constexpr int PERM = 1, AFTER_DRAIN = false; static constexpr int NSTORE = 8;
    bf16_t* O; const float* sa; const float* sb13; MoeOrder S;
    __device__ __forceinline__ void stage_scales(PG8_LAS unsigned char* ldsc, const Unit& u, int lane) const { stage_scales_dma(ldsc, sa + u.pm * BM, sb13 + (size_t)S.expert(u.pm) * 1024 + u.pn * BM, lane); }
    __device__ __forceinline__ void operator()(const f32x4 (&acc)[2][2][4][2], const Unit& u, int wr, int wc, int fr, int fq, const PG8_LAS unsigned char* ldsc) const {
        const int row0 = u.pm * BM + wr * 64 + fr, col0 = u.pn * 128 + wc * 32 + 8 * fq;
        f32x4 s1[2], s3[2]; float srw[2][4];
        { const PG8_LAS float* lr = (const PG8_LAS float*)ldsc + wr * 64 + fr; const PG8_LAS float* lc = (const PG8_LAS float*)(ldsc + 1024) + wc * 32 + 8 * fq;
#pragma unroll
          for (int n = 0; n < 2; ++n) { s1[n] = *(const PG8_LAS f32x4*)(lc + 4 * n); s3[n] = *(const PG8_LAS f32x4*)(lc + HALF + 4 * n); }
#pragma unroll
          for (int ai = 0; ai < 2; ++ai)
#pragma unroll
              for (int m = 0; m < 4; ++m) srw[ai][m] = lr[ai * HALF + m * 16]; }
#pragma unroll
        for (int ai = 0; ai < 2; ++ai)
#pragma unroll
            for (int m = 0; m < 4; ++m) { bf16_t* rowp = O + (size_t)(row0 + ai * HALF + m * 16) * 512 + col0;
                float h[8];
                const float sr = srw[ai][m];
#pragma unroll
                for (int n = 0; n < 2; ++n) { const f32x4 av = dq4(acc[ai][0][m][n], sr, s1[n]), bvv = dq4(acc[ai][1][m][n], sr, s3[n]);
#pragma unroll
                    for (int q = 0; q < 4; ++q) { const float a = av[q], b = bvv[q]; h[4 * n + q] = a * __builtin_amdgcn_rcpf(1.f + __builtin_amdgcn_exp2f(-1.4426950408889634f * a)) * b; } }
                u32x4 w; w.x = cvt_pk_bf16(h[0], h[1]); w.y = cvt_pk_bf16(h[2], h[3]); w.z = cvt_pk_bf16(h[4], h[5]); w.w = cvt_pk_bf16(h[6], h[7]);
                st16_wt(rowp, w); }
    }
};
typedef short s16x2 __attribute__((ext_vector_type(2)));
__device__ __forceinline__ unsigned q8n4(const f32x4& x) {
    s16x2 lo = __builtin_amdgcn_cvt_pknorm_i16(x[0], x[1]), hi = __builtin_amdgcn_cvt_pknorm_i16(x[2], x[3]);
    lo = lo + (s16x2){128, 128}; hi = hi + (s16x2){128, 128};
    return __builtin_amdgcn_perm(__builtin_bit_cast(unsigned, hi), __builtin_bit_cast(unsigned, lo), 0x07050301u);
}
struct EpiI8Blk {
    static constexpr int PERM = 2; static constexpr bool AFTER_DRAIN = false; static constexpr int NSTORE = 16;
    unsigned char* O8; float* SC; int ldc; const float* bias; const float* sa = nullptr; const float* sb = nullptr;
    __device__ __forceinline__ void stage_scales(PG8_LAS unsigned char* ldsc, const Unit& u, int lane) const { if (sa) stage_scales_dma(ldsc, sa + u.pm * BM, sb + u.pn * BM, lane); }
    __device__ __forceinline__ void operator()(const f32x4 (&acc)[2][2][4][2], const Unit& u, int wr, int wc, int fr, int fq, const PG8_LAS unsigned char* ldsc) const {
        const int row0 = u.pm * BM + wr * 64 + fr, col0 = u.pn * BM + wc * 64 + 16 * fq, nblk = ldc >> 6, blk = u.pn * 4 + wc;
        f32x4 bv[2][2], scl[2][2]; float srw[2][4];
#pragma unroll
        for (int bj = 0; bj < 2; ++bj)
#pragma unroll
            for (int n = 0; n < 2; ++n) { bv[bj][n] = bias ? *(const f32x4*)(bias + col0 + 8 * bj + 4 * n) : (f32x4){0.f, 0.f, 0.f, 0.f};
                scl[bj][n] = sa ? *(const PG8_LAS f32x4*)((const PG8_LAS float*)(ldsc + 1024) + wc * 64 + 16 * fq + 8 * bj + 4 * n) : (f32x4){1.f, 1.f, 1.f, 1.f}; }
#pragma unroll
        for (int ai = 0; ai < 2; ++ai)
#pragma unroll
            for (int m = 0; m < 4; ++m) srw[ai][m] = sa ? ((const PG8_LAS float*)ldsc)[wr * 64 + fr + ai * HALF + m * 16] : 1.f;
#pragma unroll
        for (int ai = 0; ai < 2; ++ai)
#pragma unroll
            for (int m = 0; m < 4; ++m) { const size_t row = (size_t)(row0 + ai * HALF + m * 16);
                f32x4 v[4]; float mx = 0.f;
#pragma unroll
                for (int bj = 0; bj < 2; ++bj)
#pragma unroll
                    for (int n = 0; n < 2; ++n) { f32x4 t = sa ? dq4(acc[ai][bj][m][n], srw[ai][m], scl[bj][n]) + bv[bj][n] : acc[ai][bj][m][n] + bv[bj][n]; v[2 * bj + n] = t;
                        mx = fmaxf(fmaxf(mx, fmaxf(fabsf(t[0]), fabsf(t[1]))), fmaxf(fabsf(t[2]), fabsf(t[3]))); }
                mx = fmaxf(mx, __shfl_xor(mx, 16)); mx = fmaxf(mx, __shfl_xor(mx, 32)); mx = fmaxf(mx, 1e-30f);
                const float inv = 0.996f * __builtin_amdgcn_rcpf(mx);
                u32x4 w; w.x = q8n4(v[0] * inv); w.y = q8n4(v[1] * inv); w.z = q8n4(v[2] * inv); w.w = q8n4(v[3] * inv);
                st16_wt(O8 + row * ldc + col0, w);
                if (fq == 0) SC[row * nblk + blk] = mx * (256.f / (0.996f * 32767.f)); }
    }
};
struct EpiSplitHalo {
    static constexpr int PERM = 1, AFTER_DRAIN = false; static constexpr int NSTORE = 16;
    bf16_t* O; size_t split_stride; bf16_t* halo; size_t halo_stride; float scale0; const float* sa; const float* sb;
    __device__ __forceinline__ void stage_scales(PG8_LAS unsigned char* ldsc, const Unit& u, int lane) const { if (sa) stage_scales_dma(ldsc, sa + u.pm * BM, sb + u.pn * BM, lane); }
    __device__ __forceinline__ void operator()(const f32x4 (&acc)[2][2][4][2], const Unit& u, int wr, int wc, int fr, int fq, const PG8_LAS unsigned char* ldsc) const {
        const int row0 = u.pm * BM + wr * 64 + fr; const int t = (u.pn * BM) >> 10; const int colt = (u.pn * BM) & 1023;
        bf16_t* base = O + (size_t)t * split_stride; const int col0 = colt + wc * 32 + 8 * fq; const float sc = (t == 0) ? scale0 : 1.f;
        float srw[2][4]; f32x4 scl[2][2];
        { const PG8_LAS float* lr = (const PG8_LAS float*)ldsc + wr * 64 + fr; const PG8_LAS float* lc = (const PG8_LAS float*)(ldsc + 1024) + wc * 32 + 8 * fq;
#pragma unroll
          for (int ai = 0; ai < 2; ++ai)
#pragma unroll
              for (int m = 0; m < 4; ++m) srw[ai][m] = sa ? lr[ai * HALF + m * 16] * sc : 1.f;
#pragma unroll
          for (int bj = 0; bj < 2; ++bj)
#pragma unroll
              for (int n = 0; n < 2; ++n) scl[bj][n] = sa ? *(const PG8_LAS f32x4*)(lc + bj * HALF + 4 * n) : (f32x4){1.f, 1.f, 1.f, 1.f}; }
#pragma unroll
        for (int ai = 0; ai < 2; ++ai)
#pragma unroll
            for (int m = 0; m < 4; ++m) { const int row = row0 + ai * HALF + m * 16; bf16_t* rowp = base + (size_t)row * 1024 + col0;
#pragma unroll
                for (int bj = 0; bj < 2; ++bj) { f32x4 v0, v1; if (sa) { const float sr = srw[ai][m]; v0 = dq4(acc[ai][bj][m][0], sr, scl[bj][0]); v1 = dq4(acc[ai][bj][m][1], sr, scl[bj][1]); } else { v0 = acc[ai][bj][m][0] * sc; v1 = acc[ai][bj][m][1] * sc; }
                    u32x4 w; w.x = cvt_pk_bf16(v0[0], v0[1]); w.y = cvt_pk_bf16(v0[2], v0[3]); w.z = cvt_pk_bf16(v1[0], v1[1]); w.w = cvt_pk_bf16(v1[2], v1[3]);
                    st16_wt(rowp + bj * HALF, w);
                    if (halo != nullptr && m == 3 && fr >= 13 && t < 3) st16_wt(halo + (size_t)t * halo_stride + ((size_t)(row >> 6) * 3 + ((row & 63) - 61)) * 1024 + col0 + bj * HALF, w); } }
    }
};
}

namespace dn {
constexpr int QS = 272, TS = 144;
constexpr int L_QS = 0, L_KS = 17408, L_VS = 34816, L_AT = 52224, L_AN = 61440, L_AD = 70656, L_TB = 74752, L_TAB = 76800, L_CW = 78336, L_RAW = 84480;
}
__device__ __forceinline__ void ld_frag8(const LAS unsigned char* rowp, int c1, float (&x)[8]) {
    const v2u lo = *(const LAS v2u*)(rowp + 2 * c1), hi = *(const LAS v2u*)(rowp + 2 * c1 + 32);
    x[0] = bflo(lo.x); x[1] = bfhi(lo.x); x[2] = bflo(lo.y); x[3] = bfhi(lo.y); x[4] = bflo(hi.x); x[5] = bfhi(hi.x); x[6] = bflo(hi.y); x[7] = bfhi(hi.y);
}
__device__ __forceinline__ v4u pack8(const float (&x)[8]) { v4u o; o.x = pk2(x[0], x[1]); o.y = pk2(x[2], x[3]); o.z = pk2(x[4], x[5]); o.w = pk2(x[6], x[7]); return o; }
__device__ __forceinline__ bf16x8 frag_lohi(v2u lo, v2u hi) { v4u p; p.x = lo.x; p.y = lo.y; p.z = hi.x; p.w = hi.y; return __builtin_bit_cast(bf16x8, p); }
__device__ __forceinline__ v2u pack4(const f32x4& v) { v2u o; o.x = pk2(v[0], v[1]); o.y = pk2(v[2], v[3]); return o; }

__device__ __forceinline__ void phase_delta_local(Frame& F, int j) {
    using namespace dn;
    LAS unsigned char* L = F.lds;
    LAS float* gcs = (LAS float*)(L + L_TAB); LAS float* betas = gcs + 64; LAS float* egs = gcs + 128; LAS float* eks = gcs + 192; LAS float* bscs = gcs + 256;
    LAS float* Ad = (LAS float*)(L + L_AD); LAS float* cwl = (LAS float*)(L + L_CW);
    const int tid = F.tid, lane = F.lane, wave = F.wave, fr = lane & 15, fq = lane >> 4;
    bf16* Qp = (bf16*)(F.ws + WS_R); bf16* Kp = (bf16*)(F.ws + WS_R + TD2); bf16* Vp = (bf16*)(F.ws + WS_R + 2 * TD2);
    bf16* Ub = (bf16*)(F.ws + WS_R + 4 * TD2); bf16* ATb = (bf16*)(F.ws + WS_R + 5 * TD2);
    const bf16* halo = (const bf16*)(F.ws + WS_HALO); const float* AB = (const float*)(F.ws + WS_AB);
    const float* convw = F.in[I_ACONV] + (size_t)j * 4 * 3072; float* EGL = (float*)(F.ws + WS_EGL);
    const int bh = F.vcu >> 3, h = bh & 7, b = bh >> 3;
    if (bh >= 32) return;
    for (int idx = tid; idx < 3 * 4 * 128; idx += NTHR) { const int c = idx & 127, xj = idx >> 7, x = xj >> 2, jj = xj & 3; cwl[idx] = convw[(size_t)jj * 3072 + x * 1024 + h * 128 + c]; }
    const float alog = -__expf(F.in[I_AALOG][j * 8 + h]), dtb = F.in[I_ADT][j * 8 + h];
#define DL_DMA(n_) do { const int ch_ = b * 128 + (n_); const size_t c0_ = (size_t)ch_ * 64; \
        for (int idx = wave; idx < 51; idx += 8) { const int x_ = idx / 17, i_ = idx % 17, ri = 4 * i_ + (lane >> 4); \
            const bf16* X_ = x_ == 0 ? Qp : (x_ == 1 ? Kp : Vp); \
            const bf16* src = (ri >= 3) ? X_ + (c0_ + ri - 3) * 1024 + h * 128 + (lane & 15) * 8 : halo + (size_t)x_ * HALO_T + ((size_t)((n_) > 0 ? ch_ - 1 : ch_) * 3 + ri) * 1024 + h * 128 + (lane & 15) * 8; \
            __builtin_amdgcn_global_load_lds((const unsigned*)src, (LAS unsigned*)(L + L_RAW + x_ * 17408 + i_ * 1024), 16, 0, 0); } } while (0)
#define DL_BAR() do { asm volatile("s_waitcnt lgkmcnt(0)" ::: "memory"); __builtin_amdgcn_s_barrier(); asm volatile("" ::: "memory"); } while (0)
    __syncthreads();
    DL_DMA((F.vcu & 7) * 16);
    for (int k = 0; k < 16; ++k) {
        const int n = (F.vcu & 7) * 16 + k, unit = bh * 128 + n, ch = b * 128 + n; const size_t c0 = (size_t)ch * 64;
        asm volatile("s_waitcnt vmcnt(0)" ::: "memory"); DL_BAR();
#define DL_COMP(XX) do { \
        _Pragma("unroll") for (int ii = 0; ii < 2; ++ii) { const int it = tid + NTHR * ii, r = it >> 4, gq = it & 15; \
            float acc[8] = {0.f, 0.f, 0.f, 0.f, 0.f, 0.f, 0.f, 0.f}; \
            _Pragma("unroll") for (int jj = 0; jj < 4; ++jj) { v4u w = *(const LAS v4u*)(L + L_RAW + (XX) * 17408 + (r + jj) * 256 + gq * 16); if (n == 0 && r + jj < 3) w = (v4u){0u, 0u, 0u, 0u}; \
                const LAS f32x4* cw = (const LAS f32x4*)(cwl + ((XX) * 4 + jj) * 128 + gq * 8); const f32x4 w0 = cw[0], w1 = cw[1]; \
                acc[0] += bflo(w.x) * w0.x; acc[1] += bfhi(w.x) * w0.y; acc[2] += bflo(w.y) * w0.z; acc[3] += bfhi(w.y) * w0.w; \
                acc[4] += bflo(w.z) * w1.x; acc[5] += bfhi(w.z) * w1.y; acc[6] += bflo(w.w) * w1.z; acc[7] += bfhi(w.w) * w1.w; } \
            float ss = 0.f; \
            _Pragma("unroll") for (int e = 0; e < 8; ++e) { acc[e] = siluf_(acc[e]); ss += acc[e] * acc[e]; } \
            if ((XX) < 2) { ss += __shfl_xor(ss, 1); ss += __shfl_xor(ss, 2); ss += __shfl_xor(ss, 4); ss += __shfl_xor(ss, 8); \
                float rs = rsqrtf_(ss + 1e-6f); if ((XX) == 0) rs *= 0.08838834764831845f; \
                _Pragma("unroll") for (int e = 0; e < 8; ++e) acc[e] *= rs; } \
            *(LAS v4u*)(L + ((XX) == 0 ? L_QS : ((XX) == 1 ? L_KS : L_VS)) + r * QS + gq * 16) = pack8(acc); } } while (0)
        float ga = 0.f, gb = 0.f;
        if (wave == 0) { ga = AB[(c0 + lane) * 16 + h]; gb = AB[(c0 + lane) * 16 + 8 + h]; }
        DL_COMP(0); DL_COMP(1); DL_COMP(2);
#undef DL_COMP
        if (wave == 0) {
            const float xs = ga + dtb; const float sp = xs > 20.f ? xs : log1pf(__expf(xs));
            float gi = alog * sp;
#pragma unroll
            for (int o = 1; o < 64; o <<= 1) { const float t = __shfl_up(gi, o); if (lane >= o) gi += t; }
            const float gl = __shfl(gi, 63); const float be = sigmoidf_(gb), eg = __expf(gi);
            gcs[lane] = gi; betas[lane] = be; egs[lane] = eg; eks[lane] = __expf(gl - gi); bscs[lane] = be * eg;
            if (lane == 0) EGL[bh * 128 + n] = __expf(gl);
        }
        DL_BAR();
        if (k + 1 < 16) DL_DMA(n + 1);
#pragma unroll
        for (int tt = 0; tt < 2; ++tt) {
            const int id = 2 * wave + tt, it = id >> 2, jt = id & 3;
            f32x4 kk = {0.f, 0.f, 0.f, 0.f}, qk = {0.f, 0.f, 0.f, 0.f};
            if (jt <= it) {
#pragma unroll
                for (int s = 0; s < 4; ++s) {
                    const bf16x8 bk = *(const LAS bf16x8*)(L + L_KS + (16 * jt + fr) * QS + (32 * s + 8 * fq) * 2);
                    const bf16x8 ak = *(const LAS bf16x8*)(L + L_KS + (16 * it + fr) * QS + (32 * s + 8 * fq) * 2);
                    const bf16x8 aq = *(const LAS bf16x8*)(L + L_QS + (16 * it + fr) * QS + (32 * s + 8 * fq) * 2);
                    kk = MFMA16(ak, bk, kk); qk = MFMA16(aq, bk, qk); } }
            const int jc = 16 * jt + fr; const float gj = gcs[jc];
#pragma unroll
            for (int r = 0; r < 4; ++r) { const int i = 16 * it + 4 * fq + r; const float dec = __expf(fminf(gcs[i] - gj, 0.f));
                const float av = (i > jc) ? betas[i] * kk[r] * dec : 0.f;
                if (it == jt) Ad[it * 256 + (4 * fq + r) * 16 + fr] = av;
                else if (jt < it) *(LAS bf16*)(L + L_AN + i * TS + jc * 2) = f2bf(-av);
                *(LAS bf16*)(L + L_AT + i * TS + jc * 2) = f2bf((i >= jc) ? qk[r] * dec : 0.f); }
        }
        DL_BAR();
        if (wave < 4) {
            const LAS float* A = Ad + wave * 256; float Tr[16];
#pragma unroll
            for (int r = 0; r < 16; ++r) {
                float t0 = (fr == r) ? 1.f : 0.f, t1 = 0.f;
#pragma unroll
                for (int q4 = 0; q4 < (r + 3) / 4; ++q4) { const f32x4 a = *(const LAS f32x4*)(A + r * 16 + 4 * q4);
                    if (4 * q4 + 0 < r) t0 -= a.x * Tr[4 * q4 + 0];
                    if (4 * q4 + 1 < r) t1 -= a.y * Tr[4 * q4 + 1];
                    if (4 * q4 + 2 < r) t0 -= a.z * Tr[4 * q4 + 2];
                    if (4 * q4 + 3 < r) t1 -= a.w * Tr[4 * q4 + 3]; }
                Tr[r] = t0 + t1;
            }
            if (lane < 16) {
#pragma unroll
                for (int r = 0; r < 16; ++r) *(LAS bf16*)(L + L_TB + wave * 512 + r * 32 + lane * 2) = f2bf(Tr[r]); }
        }
        for (int f = (wave + 4) & 7; f < 40; f += 8) {
            float x[8]; GAS v4u* dst;
            if (f < 16) { const int mt = f >> 2, s = f & 3, row = 16 * mt + fr; ld_frag8(L + L_QS + row * QS, 32 * s + 4 * fq, x); const float e = egs[row];
#pragma unroll
                for (int q = 0; q < 8; ++q) x[q] *= e;
                dst = (GAS v4u*)(Qp + (c0 + 4 * f + fq) * 1024 + h * 128 + fr * 8); }
            else if (f < 32) { const int g = f - 16, mt = g >> 1, s = g & 1, d = 16 * mt + fr, c1 = 32 * s + 4 * fq;
#pragma unroll
                for (int q = 0; q < 8; ++q) { const int c = c1 + (q & 3) + 16 * (q >> 2); x[q] = bf1(*(const LAS bf16*)(L + L_KS + c * QS + d * 2)) * eks[c]; }
                dst = (GAS v4u*)(Kp + (c0 + 4 * g + fq) * 1024 + h * 128 + fr * 8); }
            else { const int g = f - 32, mt = g >> 1, s = g & 1, row = 16 * mt + fr; ld_frag8(L + L_AT + row * TS, 32 * s + 4 * fq, x);
                dst = (GAS v4u*)(ATb + ((size_t)unit * 8 + g) * 512 + lane * 8); }
            *dst = pack8(x);
        }
        DL_BAR();
#pragma unroll
        for (int t2 = 0; t2 < 2; ++t2) {
            const int ct = 2 * wave + t2, isw = ct >> 3, nt = ct & 7; const LAS unsigned char* src = L + (isw ? L_KS : L_VS) + (16 * nt + fr) * 2; const LAS float* sc = isw ? bscs : betas;
            v2u X[4];
#pragma unroll
            for (int bb = 0; bb < 4; ++bb) {
                f32x4 acc;
#pragma unroll
                for (int r = 0; r < 4; ++r) { const int row = 16 * bb + 4 * fq + r; acc[r] = bf1(*(const LAS bf16*)(src + row * QS)) * sc[row]; }
#pragma unroll
                for (int s = 0; s < (bb + 1) / 2; ++s) {
                    const LAS unsigned char* ap = L + L_AN + (16 * bb + fr) * TS + (32 * s + 4 * fq) * 2;
                    const v2u alo = *(const LAS v2u*)ap; v2u ahi = {0u, 0u}, xhi = {0u, 0u};
                    if (2 * s + 1 < bb) { ahi = *(const LAS v2u*)(ap + 32); xhi = X[2 * s + 1]; }
                    acc = MFMA16(frag_lohi(alo, ahi), frag_lohi(X[2 * s], xhi), acc); }
                const v2u tlo = *(const LAS v2u*)(L + L_TB + bb * 512 + fr * 32 + fq * 8); const v2u z2 = {0u, 0u};
                const f32x4 zero = {0.f, 0.f, 0.f, 0.f};
                const f32x4 xb = MFMA16(frag_lohi(tlo, z2), frag_lohi(pack4(acc), z2), zero);
                X[bb] = pack4(xb);
                if (!isw) *(GAS v2u*)(Ub + (((size_t)unit * 8 + nt) * 4 + bb) * 256 + lane * 4) = X[bb];
                else {
#pragma unroll
                    for (int r = 0; r < 4; ++r) *(LAS bf16*)(L + L_QS + (16 * bb + 4 * fq + r) * QS + (16 * nt + fr) * 2) = f2bf(xb[r]); }
            }
        }
        DL_BAR();
#pragma unroll
        for (int kf = 0; kf < 2; ++kf) { const int f = wave * 2 + kf, mt = f >> 2, s = f & 3, row = 16 * mt + fr; float x[8]; ld_frag8(L + L_QS + row * QS, 32 * s + 4 * fq, x);
            *(GAS v4u*)(Vp + (c0 + 4 * f + fq) * 1024 + h * 128 + fr * 8) = pack8(x); }
    }
    asm volatile("s_waitcnt vmcnt(0)" ::: "memory"); DL_BAR();
#undef DL_DMA
#undef DL_BAR
}
__device__ __forceinline__ void phase_delta_scan(Frame& F, unsigned long long& pollt) {
    const int lane = F.lane, wave = F.wave, fr = lane & 15, fq = lane >> 4;
    const int bh = F.vcu >> 3, sl = F.vcu & 7, h = bh & 7; const size_t cb = (size_t)(bh >> 3) * SEQ;
    LAS unsigned char* L = F.lds;
    constexpr int SLOT = 59392;
    constexpr int HRING = 2 * SLOT + 256, HENT = 6144, HDEPTH = 4;
    volatile LAS unsigned* flags = (volatile LAS unsigned*)(L + 2 * SLOT);
    if (F.tid < 64) flags[F.tid] = 0u;
    __syncthreads();
    if (bh >= 32) return;
    const bf16* Qp = (const bf16*)(F.ws + WS_R); const bf16* Kp = (const bf16*)(F.ws + WS_R + TD2); const bf16* Vp = (const bf16*)(F.ws + WS_R + 2 * TD2);
    const bf16* Ub = (const bf16*)(F.ws + WS_R + 4 * TD2); const bf16* ATb = (const bf16*)(F.ws + WS_R + 5 * TD2); bf16* Ob = (bf16*)(F.ws + WS_R + 5 * TD2 + 32 * MiB);
#define DS_SPIN(cond) do { unsigned sp_ = 0; while (cond) { __builtin_amdgcn_s_sleep(1); if (++sp_ > (1u << 24)) break; } asm volatile("" ::: "memory"); } while (0)
    if (wave >= 2) {
        const size_t lrow = (size_t)fq * 1024 + h * 128 + fr * 8;
        for (int c = wave - 2; c < 128; c += 6) {
            const size_t r0 = cb + (size_t)c * 64;
            v4u R[56]; v2u U[4];
#pragma unroll
            for (int f = 0; f < 16; ++f) R[f] = *(const GAS v4u*)(Vp + (r0 + 4 * f) * 1024 + lrow);
#pragma unroll
            for (int f = 0; f < 16; ++f) R[16 + f] = *(const GAS v4u*)(Qp + (r0 + 4 * f) * 1024 + lrow);
#pragma unroll
            for (int f = 0; f < 16; ++f) R[32 + f] = *(const GAS v4u*)(Kp + (r0 + 4 * f) * 1024 + lrow);
            const bf16* at = ATb + ((size_t)(bh * 128 + c) * 8) * 512 + lane * 8;
#pragma unroll
            for (int f = 0; f < 8; ++f) R[48 + f] = *(const GAS v4u*)(at + f * 512);
            const bf16* up = Ub + (((size_t)(bh * 128 + c) * 8 + sl) * 4) * 256 + lane * 4;
#pragma unroll
            for (int t = 0; t < 4; ++t) U[t] = *(const GAS v2u*)(up + t * 256);
            LAS unsigned char* d = L + (c & 1) * SLOT + lane * 16;
            if (c >= 2) DS_SPIN(flags[16] < (unsigned)(c - 1));
#pragma unroll
            for (int f = 0; f < 16; ++f) *(LAS v4u*)(d + f * 1024) = R[f];
#pragma unroll
            for (int f = 32; f < 48; ++f) *(LAS v4u*)(d + f * 1024) = R[f];
#pragma unroll
            for (int t = 0; t < 4; ++t) *(LAS v2u*)(L + (c & 1) * SLOT + 57344 + t * 512 + lane * 8) = U[t];
            asm volatile("s_waitcnt lgkmcnt(0)" ::: "memory");
            if (lane == 0) flags[(c & 1) * 8] = (unsigned)(c + 1);
            if (c >= 2) DS_SPIN(flags[24] < (unsigned)(c - 1));
#pragma unroll
            for (int f = 16; f < 32; ++f) *(LAS v4u*)(d + f * 1024) = R[f];
#pragma unroll
            for (int f = 48; f < 56; ++f) *(LAS v4u*)(d + f * 1024) = R[f];
            asm volatile("s_waitcnt lgkmcnt(0)" ::: "memory");
            if (lane == 0) flags[48 + (c & 1) * 8] = (unsigned)(c + 1);
        }
        return;
    }
    if (wave == 1) {
        for (int n = 0; n < 128; ++n) {
            const int slot = n & 1;
            DS_SPIN(flags[32] < (unsigned)(n + 1) || flags[48 + slot * 8] != (unsigned)(n + 1));
            const LAS unsigned char* P = L + slot * SLOT + lane * 16; const LAS unsigned char* Hh = L + HRING + (n & (HDEPTH - 1)) * HENT + lane * 16;
            bf16x8 Sb[4], vb[2], qf[16], af[8];
#pragma unroll
            for (int s = 0; s < 4; ++s) Sb[s] = *(const LAS bf16x8*)(Hh + s * 1024);
#pragma unroll
            for (int s = 0; s < 4; ++s)
#pragma unroll
                for (int t = 0; t < 4; ++t) qf[t * 4 + s] = *(const LAS bf16x8*)(P + 16384 + (t * 4 + s) * 1024);
#pragma unroll
            for (int s = 0; s < 2; ++s) vb[s] = *(const LAS bf16x8*)(Hh + 4096 + s * 1024);
#pragma unroll
            for (int s = 0; s < 2; ++s)
#pragma unroll
                for (int t = 0; t < 4; ++t) af[t * 2 + s] = *(const LAS bf16x8*)(P + 49152 + (t * 2 + s) * 1024);
            __builtin_amdgcn_sched_barrier(0);
            f32x4 qs_[4];
#pragma unroll
            for (int t = 0; t < 4; ++t) qs_[t] = (f32x4){0.f, 0.f, 0.f, 0.f};
#pragma unroll
            for (int s = 0; s < 4; ++s)
#pragma unroll
                for (int t = 0; t < 4; ++t) qs_[t] = MFMA16(qf[t * 4 + s], Sb[s], qs_[t]);
#pragma unroll
            for (int s = 0; s < 2; ++s)
#pragma unroll
                for (int t = 0; t < 4; ++t) qs_[t] = MFMA16(af[t * 2 + s], vb[s], qs_[t]);
            asm volatile("s_waitcnt lgkmcnt(0)" ::: "memory");
            if (lane == 0) { flags[24] = (unsigned)(n + 1); flags[40] = (unsigned)(n + 1); }
#pragma unroll
            for (int t = 0; t < 4; ++t)
#pragma unroll
                for (int r = 0; r < 4; ++r) Ob[(cb + (size_t)n * 64 + 16 * t + 4 * fq + r) * 1024 + h * 128 + sl * 16 + fr] = f2bf(qs_[t][r]);
        }
        return;
    }
    const float* EGL = (const float*)(F.ws + WS_EGL) + bh * 128;
    const float egl_lo = EGL[lane], egl_hi = EGL[64 + lane];
    f32x4 Sa[8];
#pragma unroll
    for (int m = 0; m < 8; ++m) Sa[m] = (f32x4){0.f, 0.f, 0.f, 0.f};
    bf16x8 Sb[4];
#pragma unroll
    for (int s = 0; s < 4; ++s) Sb[s] = (bf16x8){0, 0, 0, 0, 0, 0, 0, 0};
    for (int n = 0; n < 128; ++n) {
        const int slot = n & 1;
        const unsigned long long tp0 = PROBE_MASK ? __builtin_amdgcn_s_memrealtime() : 0ull;
        DS_SPIN(flags[slot * 8] != (unsigned)(n + 1));
        if (n >= HDEPTH) DS_SPIN(flags[40] < (unsigned)(n - HDEPTH + 1));
        if (PROBE_MASK) pollt += __builtin_amdgcn_s_memrealtime() - tp0;
        const LAS unsigned char* P = L + slot * SLOT + lane * 16; LAS unsigned char* Hh = L + HRING + (n & (HDEPTH - 1)) * HENT + lane * 16;
        const float egl = __builtin_bit_cast(float, __builtin_amdgcn_readlane(__builtin_bit_cast(int, n < 64 ? egl_lo : egl_hi), n & 63));
        bf16x8 wf[16], kf[16]; v2u ucur[4];
#pragma unroll
        for (int s = 0; s < 4; ++s)
#pragma unroll
            for (int t = 0; t < 4; ++t) wf[t * 4 + s] = *(const LAS bf16x8*)(P + (t * 4 + s) * 1024);
#pragma unroll
        for (int t = 0; t < 4; ++t) ucur[t] = *(const LAS v2u*)(L + slot * SLOT + 57344 + t * 512 + lane * 8);
#pragma unroll
        for (int s = 0; s < 2; ++s)
#pragma unroll
            for (int m = 0; m < 8; ++m) kf[m * 2 + s] = *(const LAS bf16x8*)(P + 32768 + (m * 2 + s) * 1024);
#pragma unroll
        for (int s = 0; s < 4; ++s) *(LAS bf16x8*)(Hh + s * 1024) = Sb[s];
        __builtin_amdgcn_sched_barrier(0);
        f32x4 ws_[4];
#pragma unroll
        for (int t = 0; t < 4; ++t) ws_[t] = (f32x4){0.f, 0.f, 0.f, 0.f};
#pragma unroll
        for (int s = 0; s < 4; ++s)
#pragma unroll
            for (int t = 0; t < 4; ++t) ws_[t] = MFMA16(wf[t * 4 + s], Sb[s], ws_[t]);
        f32x4 vn[4];
#pragma unroll
        for (int t = 0; t < 4; ++t) { vn[t][0] = bflo(ucur[t].x) - ws_[t][0]; vn[t][1] = bfhi(ucur[t].x) - ws_[t][1]; vn[t][2] = bflo(ucur[t].y) - ws_[t][2]; vn[t][3] = bfhi(ucur[t].y) - ws_[t][3]; }
        bf16x8 vb[2];
#pragma unroll
        for (int s = 0; s < 2; ++s) { vb[s] = frag_lohi(pack4(vn[2 * s]), pack4(vn[2 * s + 1])); *(LAS bf16x8*)(Hh + 4096 + s * 1024) = vb[s]; }
        asm volatile("s_waitcnt lgkmcnt(0)" ::: "memory");
        if (lane == 0) { flags[32] = (unsigned)(n + 1); flags[16] = (unsigned)(n + 1); }
#pragma unroll
        for (int m = 0; m < 8; ++m) Sa[m] = Sa[m] * egl;
#pragma unroll
        for (int s = 0; s < 2; ++s)
#pragma unroll
            for (int m = 0; m < 8; ++m) Sa[m] = MFMA16(kf[m * 2 + s], vb[s], Sa[m]);
#pragma unroll
        for (int s = 0; s < 4; ++s) Sb[s] = frag_lohi(pack4(Sa[2 * s]), pack4(Sa[2 * s + 1]));
    }
#undef DS_SPIN
}
__device__ __forceinline__ void phase_delta_normgate(Frame& F, int j, const bf16* O, const bf16* G, bf16* ON) {
    const int lane = F.lane, gw = F.vcu * NWAVES + F.wave, NGW = F.G * NWAVES;
    float ng[16];
#pragma unroll
    for (int k = 0; k < 16; ++k) ng[k] = F.in[I_ANG][j * 128 + (lane & 7) * 16 + k];
    for (int row0 = gw; row0 < T; row0 += 4 * NGW) {
      v4u po0[4], po1[4], pg0[4], pg1[4];
#pragma unroll
      for (int q = 0; q < 4; ++q) { const int row = (row0 + q * NGW < T) ? row0 + q * NGW : row0; const GAS v4u* op = (const GAS v4u*)(O + (size_t)row * 1024 + lane * 16); const GAS v4u* gp = (const GAS v4u*)(G + (size_t)row * 1024 + lane * 16);
          po0[q] = op[0]; po1[q] = op[1]; pg0[q] = gp[0]; pg1[q] = gp[1]; }
#pragma unroll
      for (int q = 0; q < 4; ++q) { const int row = row0 + q * NGW; if (row >= T) break;
        const v4u o0 = po0[q], o1 = po1[q], g0 = pg0[q], g1 = pg1[q];
        const unsigned ow[8] = {o0.x, o0.y, o0.z, o0.w, o1.x, o1.y, o1.z, o1.w}, gwv[8] = {g0.x, g0.y, g0.z, g0.w, g1.x, g1.y, g1.z, g1.w};
        float v[16], gt[16]; float ss = 0.f;
#pragma unroll
        for (int k = 0; k < 8; ++k) { v[2 * k] = bflo(ow[k]); v[2 * k + 1] = bfhi(ow[k]); gt[2 * k] = bflo(gwv[k]); gt[2 * k + 1] = bfhi(gwv[k]); ss += v[2 * k] * v[2 * k] + v[2 * k + 1] * v[2 * k + 1]; }
        ss += __shfl_xor(ss, 1); ss += __shfl_xor(ss, 2); ss += __shfl_xor(ss, 4);
        const float rs = rsqrtf_(ss * (1.f / 128.f) + LN_EPS);
        float ov[16]; float m = 0.f;
#pragma unroll
        for (int k = 0; k < 16; ++k) { ov[k] = v[k] * rs * ng[k] * siluf_(gt[k]); m = fmaxf(m, fabsf(ov[k])); }
#pragma unroll
        for (int o = 1; o < 64; o <<= 1) m = fmaxf(m, __shfl_xor(m, o));
        const float inv = m > 0.f ? 127.f / m : 0.f;
        *(GAS v4u*)((unsigned char*)ON + (size_t)row * 1024 + lane * 16) = (v4u){q8x4(ov[0] * inv, ov[1] * inv, ov[2] * inv, ov[3] * inv), q8x4(ov[4] * inv, ov[5] * inv, ov[6] * inv, ov[7] * inv), q8x4(ov[8] * inv, ov[9] * inv, ov[10] * inv, ov[11] * inv), q8x4(ov[12] * inv, ov[13] * inv, ov[14] * inv, ov[15] * inv)};
        if (lane == 0) ((float*)(F.ws + WS_ONS))[row] = m * (1.f / 127.f);
      }
    }
}
__device__ __forceinline__ void phase_diff_combine(Frame& F, int j, int li, const bf16* O0, const bf16* O1, bf16* ON) {
    const int lane = F.lane, gw = F.vcu * NWAVES + F.wave, NGW = F.G * NWAVES;
    const float* lam = F.in[I_BLAM] + j * 256;
    float p01 = lam[lane] * lam[64 + lane], p23 = lam[128 + lane] * lam[192 + lane];
    p01 = wave_sum(p01); p23 = wave_sum(p23);
    const float lambda_init = 0.8f - 0.6f * expf(-0.3f * (float)li);
    const float lamf = expf(p01) - expf(p23) + lambda_init, osc = 1.f - lambda_init;
    float ng[16];
#pragma unroll
    for (int k = 0; k < 16; ++k) ng[k] = F.in[I_BNG][j * 128 + (lane & 7) * 16 + k] * osc;
    for (int row0 = gw; row0 < T; row0 += 4 * NGW) {
      v4u pa0[4], pa1[4], pb0[4], pb1[4];
#pragma unroll
      for (int q = 0; q < 4; ++q) { const int row = (row0 + q * NGW < T) ? row0 + q * NGW : row0; const GAS v4u* ap = (const GAS v4u*)(O0 + (size_t)row * 1024 + lane * 16); const GAS v4u* bp = (const GAS v4u*)(O1 + (size_t)row * 1024 + lane * 16);
          pa0[q] = ap[0]; pa1[q] = ap[1]; pb0[q] = bp[0]; pb1[q] = bp[1]; }
#pragma unroll
      for (int q = 0; q < 4; ++q) { const int row = row0 + q * NGW; if (row >= T) break;
        const v4u a0 = pa0[q], a1 = pa1[q], b0 = pb0[q], b1 = pb1[q];
        const unsigned aw[8] = {a0.x, a0.y, a0.z, a0.w, a1.x, a1.y, a1.z, a1.w}, bw[8] = {b0.x, b0.y, b0.z, b0.w, b1.x, b1.y, b1.z, b1.w};
        float v[16]; float ss = 0.f;
#pragma unroll
        for (int k = 0; k < 8; ++k) { v[2 * k] = bflo(aw[k]) - lamf * bflo(bw[k]); v[2 * k + 1] = bfhi(aw[k]) - lamf * bfhi(bw[k]); ss += v[2 * k] * v[2 * k] + v[2 * k + 1] * v[2 * k + 1]; }
        ss += __shfl_xor(ss, 1); ss += __shfl_xor(ss, 2); ss += __shfl_xor(ss, 4);
        const float rs = rsqrtf_(ss * (1.f / 128.f) + LN_EPS);
        float ov[16]; float m = 0.f;
#pragma unroll
        for (int k = 0; k < 16; ++k) { ov[k] = v[k] * rs * ng[k]; m = fmaxf(m, fabsf(ov[k])); }
#pragma unroll
        for (int o = 1; o < 64; o <<= 1) m = fmaxf(m, __shfl_xor(m, o));
        const float inv = m > 0.f ? 127.f / m : 0.f;
        *(GAS v4u*)((unsigned char*)ON + (size_t)row * 1024 + lane * 16) = (v4u){q8x4(ov[0] * inv, ov[1] * inv, ov[2] * inv, ov[3] * inv), q8x4(ov[4] * inv, ov[5] * inv, ov[6] * inv, ov[7] * inv), q8x4(ov[8] * inv, ov[9] * inv, ov[10] * inv, ov[11] * inv), q8x4(ov[12] * inv, ov[13] * inv, ov[14] * inv, ov[15] * inv)};
        if (lane == 0) ((float*)(F.ws + WS_ONS))[row] = m * (1.f / 127.f);
      }
    }
}
__device__ __forceinline__ void phase_gmlp_spatial(Frame& F, int j, const bf16* U, const bf16* V, bf16* UG) {
    LAS unsigned char* L = F.lds;
    constexpr int VT = 272;
    constexpr int L_ST = 69632, L_VN = 70656;
    LAS float* st = (LAS float*)(L + L_ST);
    const int tid = F.tid, lane = F.lane, wave = F.wave, fr = lane & 15, fq = lane >> 4;
    const float* lng = F.in[I_CLNG] + j * 2048; const float* lnb = F.in[I_CLNB] + j * 2048; const float* bs = F.in[I_CBS] + j * 8 * 128;
    const bf16* wsb = (const bf16*)(F.ws + WS_WSB); const float* wsum = (const float*)(F.ws + WS_WSUM);
    for (int unit = F.vcu; unit < T / 128; unit += F.G) {
        const size_t R0 = (size_t)unit * 128;
#define GM_DMA(g_) do { _Pragma("unroll") for (int q = 0; q < 8; ++q) { const int s_ = 16 * wave + 2 * q + (lane >> 5); \
            __builtin_amdgcn_global_load_lds((const unsigned*)(V + (R0 + s_) * 2048 + (g_) * 256 + (((lane & 31) ^ (s_ & 31)) * 8)), (LAS unsigned*)(L + L_VN + (16 * wave + 2 * q) * 512), 16, 0, 0); } } while (0)
        GM_DMA(0);
        for (int i0 = 0; i0 < 16; i0 += 4) {
            v4u raw[4][4];
#pragma unroll
            for (int i = 0; i < 4; ++i) { const GAS v4u* p = (const GAS v4u*)(V + (R0 + wave * 16 + i0 + i) * 2048) + lane;
#pragma unroll
                for (int q = 0; q < 4; ++q) raw[i][q] = p[64 * q]; }
#pragma unroll
            for (int i = 0; i < 4; ++i) { float s = 0.f, s2 = 0.f;
#pragma unroll
                for (int q = 0; q < 4; ++q) { const unsigned ww[4] = {raw[i][q].x, raw[i][q].y, raw[i][q].z, raw[i][q].w};
#pragma unroll
                    for (int e = 0; e < 4; ++e) { const float a = bflo(ww[e]), c2 = bfhi(ww[e]); s += a + c2; s2 += a * a + c2 * c2; } }
                s = wave_sum(s); s2 = wave_sum(s2);
                const float mean = s * (1.f / 2048.f); const float rstd = rsqrtf_(fmaxf(s2 * (1.f / 2048.f) - mean * mean, 0.f) + LN_EPS);
                if (lane == 0) { st[2 * (wave * 16 + i0 + i)] = mean; st[2 * (wave * 16 + i0 + i) + 1] = rstd; } }
        }
        for (int g = 0; g < 8; ++g) {
            bf16x8 af[4];
#pragma unroll
            for (int s = 0; s < 4; ++s) af[s] = *(const GAS bf16x8*)(wsb + ((size_t)g * 128 + 16 * wave + fr) * 128 + 32 * s + 8 * fq);
            float bt[4], wsr[4], gc[16], bc[16];
#pragma unroll
            for (int r = 0; r < 4; ++r) { bt[r] = bs[g * 128 + 16 * wave + 4 * fq + r]; wsr[r] = wsum[g * 128 + 16 * wave + 4 * fq + r]; }
#pragma unroll
            for (int nt = 0; nt < 16; ++nt) { gc[nt] = lng[g * 256 + 16 * nt + fr]; bc[nt] = lnb[g * 256 + 16 * nt + fr]; }
            asm volatile("s_waitcnt vmcnt(0)" ::: "memory");
            __syncthreads();
#pragma unroll 2
            for (int k = 0; k < 8; ++k) { const int it = tid + NTHR * k, s = it & 127, cg = it >> 7;
                const v4u w = *(const LAS v4u*)(L + L_VN + s * 512 + ((cg ^ (s & 31)) * 16)); const unsigned ww[4] = {w.x, w.y, w.z, w.w};
                const float mean = st[2 * s], rstd = st[2 * s + 1];
                LAS unsigned char* tb = L + (cg * 8) * VT + s * 2;
#pragma unroll
                for (int e = 0; e < 4; ++e) { *(LAS bf16*)(tb + (2 * e) * VT) = f2bf((bflo(ww[e]) - mean) * rstd); *(LAS bf16*)(tb + (2 * e + 1) * VT) = f2bf((bfhi(ww[e]) - mean) * rstd); } }
            __syncthreads();
            if (g + 1 < 8) GM_DMA(g + 1);
            f32x4 acc[16];
#pragma unroll
            for (int nt = 0; nt < 16; ++nt) { acc[nt] = (f32x4){0.f, 0.f, 0.f, 0.f};
#pragma unroll
                for (int s = 0; s < 4; ++s) { const bf16x8 bfr = *(const LAS bf16x8*)(L + (16 * nt + fr) * VT + (32 * s + 8 * fq) * 2); acc[nt] = MFMA16(af[s], bfr, acc[nt]); } }
            asm volatile("s_waitcnt lgkmcnt(0)" ::: "memory");
            __builtin_amdgcn_s_barrier();
            asm volatile("" ::: "memory");
#pragma unroll
            for (int nt = 0; nt < 16; ++nt)
#pragma unroll
                for (int r = 0; r < 4; ++r) *(LAS bf16*)(L + (16 * wave + 4 * fq + r) * 528 + (16 * nt + fr) * 2) = f2bf(gc[nt] * acc[nt][r] + bc[nt] * wsr[r] + bt[r]);
            asm volatile("s_waitcnt lgkmcnt(0)" ::: "memory");
            __builtin_amdgcn_s_barrier();
            asm volatile("" ::: "memory");
            v4u uu[8];
#pragma unroll
            for (int k = 0; k < 8; ++k) { const int it = tid + NTHR * k, t = it >> 5, cg = it & 31; uu[k] = *(const GAS v4u*)(U + (R0 + t) * 2048 + g * 256 + cg * 8); }
#pragma unroll
            for (int k = 0; k < 8; ++k) { const int it = tid + NTHR * k, t = it >> 5, cg = it & 31; const size_t go = (R0 + t) * 2048 + g * 256 + cg * 8;
                const v4u m = *(const LAS v4u*)(L + t * 528 + cg * 16); const v4u u = uu[k];
                v4u o; o.x = pk2(bflo(m.x) * bflo(u.x), bfhi(m.x) * bfhi(u.x)); o.y = pk2(bflo(m.y) * bflo(u.y), bfhi(m.y) * bfhi(u.y));
                o.z = pk2(bflo(m.z) * bflo(u.z), bfhi(m.z) * bfhi(u.z)); o.w = pk2(bflo(m.w) * bflo(u.w), bfhi(m.w) * bfhi(u.w));
                *(GAS v4u*)(UG + go) = o; }
        }
        asm volatile("s_waitcnt vmcnt(0) lgkmcnt(0)" ::: "memory");
        __syncthreads();
#undef GM_DMA
    }
}
#ifndef MK_FUSED
#define MK_FUSED 1
#endif
#ifndef MK_ENABLE
#define MK_ENABLE 15
#endif
#ifndef PROBE_MASK
#define PROBE_MASK 0
#endif
#ifndef PROBE_MULT
#define PROBE_MULT 1
#endif
enum { PT_INIT = 0, PT_CONV, PT_GIN, PT_DLOC, PT_DSCAN, PT_DNG, PT_ATTN, PT_COMB, PT_GGELU, PT_GMLP, PT_GOUT, PT_LNMIX, PT_GATH, PT_G1, PT_G2, PT_LNFFN };
#define PB() asm volatile("v_mbcnt_lo_u32_b32 %0, -1, 0\n\tv_mbcnt_hi_u32_b32 %0, -1, %0" : "=v"(F.lane)); F.tid = F.wave * 64 + F.lane; const unsigned long long _t0 = PROBE_MASK ? __builtin_amdgcn_s_memrealtime() : 0ull
#define PE(type) do { if ((PROBE_MASK >> (type)) & 1) pacc += __builtin_amdgcn_s_memrealtime() - _t0; } while (0)
constexpr int PH_PER_LAYER = 16, NPH = 1 + DEPTH * PH_PER_LAYER;
struct Args { const float* in[27]; float* out; unsigned char* ws; int ph_lo, ph_hi; };
__host__ __device__ inline bool phase_valid(int p) {
    if (p == 0) return true;
    const int li = (p - 1) / PH_PER_LAYER, lp = (p - 1) % PH_PER_LAYER, kind = li % 3;
    if (lp == 0) return false;
    if (lp >= 1 && lp <= 5) { if (!((MK_ENABLE >> kind) & 1)) return false; return kind == 0 ? true : (kind == 1 ? lp <= 4 : lp <= 3); }
    if (lp == 8 || lp == 12) return true;
    if (lp >= 9 && lp <= 11) return (MK_ENABLE & 8) != 0;
    return false;
}
#define IN(p) (lo <= (p) && (p) < hi && phase_valid(p))
#define SEAM() do { if (fused) xcd_barrier(bar); } while (0)
#define TAIL_CONVERT(ncol_, li_, i8_, parts_) do { const int nun_ = (__builtin_amdgcn_readfirstlane(((const LAS int*)(F.lds + MOE_TAB_OFF))[16]) >> 8) * (ncol_)  , rem_ = nun_ % F.G, c_ = (int)blockIdx.x; \
        if (c_ >= rem_) { asm volatile("v_mbcnt_lo_u32_b32 %0, -1, 0\n\tv_mbcnt_hi_u32_b32 %0, -1, %0" : "=v"(F.lane)); F.tid = F.wave * 64 + F.lane; phase_convert(F, (li_), (i8_), (parts_), c_ - rem_, F.G - rem_); } } while (0)
template <int LI> __device__ __forceinline__ void layer_body(Frame& F, const XcdBarrier& bar, unsigned char* ldsg, const int lo, const int hi, const bool fused, unsigned long long& pacc) {
    bf16* H = (bf16*)(F.ws + WS_H); bf16* Wm = (bf16*)(F.ws + WS_W); bf16* Wout = Wm + (size_t)4128 * 1024;
    unsigned char* R = F.ws + WS_R;
        constexpr int li = LI, kind = LI % 3, j = LI / 3, pb = 1 + LI * PH_PER_LAYER;
        const bool mix_on = ((MK_ENABLE >> kind) & 1) != 0, moe_on = (MK_ENABLE & 8) != 0;
        unsigned char* Y = R + (kind == 1 ? 0 : 2 * TD2); float* YS = (float*)(Y + 32 * MiB);
        if (kind != 2 && IN(pb + 1)) { PB();
            const int N = (kind == 0) ? 4096 : 3072;
            pg8::Gemm g{(const bf16*)(F.ws + WS_H8), Wm, T, N, D / 2}; pg8::StaticOrder S; S.init(T, N, F.G, (int)blockIdx.x);
            pg8::EpiSplitHalo E{(bf16*)R, (size_t)T * D, kind == 0 ? (bf16*)(F.ws + WS_HALO) : nullptr, HALO_T, kind == 0 ? 1.f : attn_body::C2, (const float*)(F.ws + WS_HS), (const float*)(F.ws + WS_SBW)};
            pg8::gemm_phase<pg8::EpiSplitHalo, pg8::StaticOrder, true, true, true>(F.lds, g, S, E, F.tid);
            if (kind == 0) thin_gemm16(F, H, Wm + (size_t)4096 * 1024, (float*)(F.ws + WS_AB));
            SEAM(); PE(PT_GIN);
        }
        if (kind == 0) {
            if (IN(pb + 2)) { PB(); phase_delta_local(F, j); SEAM(); PE(PT_DLOC); }
            if (IN(pb + 3)) { PB(); unsigned long long pollt = 0ull; phase_delta_scan(F, pollt); SEAM(); PE(PT_DSCAN); if ((PROBE_MASK >> 16) & 1) pacc += pollt; }
            if (IN(pb + 4)) { PB(); phase_delta_normgate(F, j, (const bf16*)(R + 5 * TD2 + 32 * MiB), (const bf16*)(R + 3 * TD2), (bf16*)(R + TD2)); SEAM(); PE(PT_DNG); }
        } else if (kind == 1) {
            if (IN(pb + 2)) { PB();
                const attn_body::AttnTensors AT{(const attn_body::bf16*)R, (const attn_body::bf16*)(R + TD2), (const attn_body::bf16*)(R + 2 * TD2), (attn_body::bf16*)(R + 3 * TD2), (attn_body::bf16*)(R + 4 * TD2), (const float*)(F.ws + WS_LUT)};
                const attn_body::StaticOrder S((int)F.G, (int)blockIdx.x);
                attn_body::attn_phase<attn_body::StaticOrder>((char*)ldsg, AT, S, F.tid);
                SEAM(); PE(PT_ATTN);
            }
            if (IN(pb + 3)) { PB(); phase_diff_combine(F, j, li, (const bf16*)(R + 3 * TD2), (const bf16*)(R + 4 * TD2), (bf16*)(R + 5 * TD2)); SEAM(); PE(PT_COMB); }
        } else {
            if (IN(pb + 1)) { PB();
                pg8::Gemm g{(const bf16*)(F.ws + WS_H8), Wm, T, 4096, D / 2}; pg8::StaticOrder S; S.init(T, 4096, F.G, (int)blockIdx.x);
                pg8::EpiBf16<1> E{(bf16*)R, 2048, nullptr, 2048, (size_t)T * 2048, 1.f, (const float*)(F.ws + WS_HS), (const float*)(F.ws + WS_SBW)};
                pg8::gemm_phase<pg8::EpiBf16<1>, pg8::StaticOrder, true, true, true>(F.lds, g, S, E, F.tid);
                SEAM(); PE(PT_GGELU);
            }
            if (IN(pb + 2)) { PB(); phase_gmlp_spatial(F, j, (const bf16*)R, (const bf16*)(R + 2 * TD2), (bf16*)(R + 4 * TD2)); SEAM(); PE(PT_GMLP); }
        }
        { const int po = pb + (kind == 0 ? 5 : (kind == 1 ? 4 : 3));
          if (IN(po)) { PB();
            const bf16* A = (const bf16*)(R + (kind == 0 ? TD2 : (kind == 1 ? 5 * TD2 : 4 * TD2))); const int K = (kind == 2) ? 2048 : 1024;
            pg8::StaticOrder S; S.init(T, D, F.G, (int)blockIdx.x);
            if constexpr (kind == 2) { pg8::Gemm g{A, Wout, T, D, K}; pg8::EpiI8Blk E{Y, YS, D, nullptr};
                pg8::gemm_phase<pg8::EpiI8Blk, pg8::StaticOrder, true, true>(F.lds, g, S, E, F.tid); }
            else { pg8::Gemm g{A, Wout, T, D, 512}; pg8::EpiI8Blk E{Y, YS, D, nullptr, (const float*)(F.ws + WS_ONS), (const float*)(F.ws + WS_SBO)};
                pg8::gemm_phase<pg8::EpiI8Blk, pg8::StaticOrder, true, true, true>(F.lds, g, S, E, F.tid); }
            SEAM(); PE(PT_GOUT);
          } }
        if (IN(pb + 8)) { PB(); phase_ln_mix(F, li, Y, YS, mix_on); SEAM(); PE(PT_LNMIX); }
        bf16* H1 = (bf16*)(R + 136 * MiB); unsigned char* Y2 = R + 204 * MiB; float* Y2S = (float*)(R + 276 * MiB);
        if (IN(pb + 9)) { PB(); phase_gather(F, li, (unsigned char*)R); SEAM(); PE(PT_GATH); }
        if (IN(pb + 10)) { PB();
            moe_tables(F, li);
            pg8::MoeOrder S; S.seg = (const LAS int*)(F.lds + MOE_TAB_OFF); S.cnt = S.seg + 32; const int nt = __builtin_amdgcn_readfirstlane(S.seg[16]) >> 8;
            S.init(nt * 256, 1024, F.G, (int)blockIdx.x); S.estride = (size_t)1024 * 1024; S.rowtok = nullptr; S.rowbytes = 0u;
            pg8::Gemm g{(const bf16*)R, (const bf16*)(F.ws + WS_W13), nt * 256, 1024, 512};
            pg8::EpiSwiGLU E{H1, (const float*)(F.ws + WS_XSC), (const float*)(F.ws + WS_SB13), S};
            pg8::gemm_phase<pg8::EpiSwiGLU, pg8::MoeOrder, true, true, true>(F.lds, g, S, E, F.tid);
            TAIL_CONVERT(4, li, false, 2); if (li != DEPTH - 1) TAIL_CONVERT(4, li + 1, true, 4);
            SEAM(); PE(PT_G1);
        }
        if (IN(pb + 11)) { PB();
            moe_tables(F, li);
            pg8::MoeOrder S; S.seg = (const LAS int*)(F.lds + MOE_TAB_OFF); S.cnt = S.seg + 32; const int nt = __builtin_amdgcn_readfirstlane(S.seg[16]) >> 8;
            S.init(nt * 256, 1024, F.G, (int)blockIdx.x); S.estride = (size_t)1024 * 512 * 2; S.rowtok = nullptr; S.rowbytes = 0u;
            pg8::Gemm g{H1, (const bf16*)(F.ws + WS_W2), nt * 256, 1024, 512};
            pg8::EpiI8Blk E{Y2, Y2S, D, nullptr};
            pg8::gemm_phase<pg8::EpiI8Blk, pg8::MoeOrder, true, true>(F.lds, g, S, E, F.tid);
            if (li != DEPTH - 1) TAIL_CONVERT(4, li + 1, true, 1);
            SEAM(); PE(PT_G2);
        }
        if (IN(pb + 12)) { PB(); phase_ln_ffn(F, li, Y2, Y2S, moe_on, li == DEPTH - 1); if (li != DEPTH - 1) { SEAM(); } PE(PT_LNFFN); }
}
__global__ void __launch_bounds__(NTHR, 2) mk_fwd(Args args) {
    extern __shared__ __attribute__((aligned(16))) unsigned char lds[];
    Frame F;
    F.lds = (LAS unsigned char*)lds;
    F.wave = __builtin_amdgcn_readfirstlane((int)threadIdx.x >> 6); asm volatile("v_mbcnt_lo_u32_b32 %0, -1, 0\n\tv_mbcnt_hi_u32_b32 %0, -1, %0" : "=v"(F.lane)); F.tid = F.wave * 64 + F.lane;
    F.G = gridDim.x; { const int bx = blockIdx.x; F.vcu = (F.G % 8 == 0) ? (bx % 8) * (F.G / 8) + bx / 8 : bx; }
    F.ws = args.ws; F.ctl = (unsigned*)(args.ws + WS_CTL); F.out = args.out;
#pragma unroll
    for (int i = 0; i < 27; ++i) F.in[i] = args.in[i];
    volatile LAS unsigned* MISC = (volatile LAS unsigned*)(F.lds + MISC_OFF);
    for (int u = F.tid; u < (LDS_BYTES - RING_BYTES) / 4; u += NTHR) ((LAS unsigned*)(F.lds + RING_BYTES))[u] = 0u;
    __syncthreads();
    const int lo = args.ph_lo, hi = args.ph_hi; const bool fused = (hi - lo) > 1;
    XcdBarrier bar; bar.bar = F.ctl + CW_BAR; bar.x = 0; bar.st = nullptr; bar.wave = F.wave;
    if (fused) bar = xcd_barrier_post(F.ctl + CW_BAR, MISC + 8, F.wave);
    bf16* H = (bf16*)(F.ws + WS_H); bf16* Wm = (bf16*)(F.ws + WS_W); bf16* Wout = Wm + (size_t)4128 * 1024;
    unsigned char* R = F.ws + WS_R;

    unsigned long long pacc = 0ull;
    if (IN(0)) { PB(); phase_init(F); phase_colmax_all(F); SEAM(); phase_convert(F, 0, true, 5, F.vcu, F.G); SEAM(); PE(PT_INIT); }
    layer_body<0>(F, bar, lds, lo, hi, fused, pacc);
    layer_body<1>(F, bar, lds, lo, hi, fused, pacc);
    layer_body<2>(F, bar, lds, lo, hi, fused, pacc);
    layer_body<3>(F, bar, lds, lo, hi, fused, pacc);
    if (PROBE_MASK != 0 && blockIdx.x == 0 && F.tid == 0) { const unsigned long long te = __builtin_amdgcn_s_memrealtime(); while (__builtin_amdgcn_s_memrealtime() - te < (unsigned long long)PROBE_MULT * pacc) __builtin_amdgcn_s_sleep(8); }
#undef IN
#undef SEAM
}

extern "C" void kernel_launch(void* const* d_in, const int* in_sizes, int n_in, void* d_out, int out_size, void* d_ws, size_t ws_size, hipStream_t stream) {
    static int grid = 0;
    if (grid == 0) {
        if (n_in != 27 || in_sizes[0] != T * D || out_size != T * D || ws_size < WS_END) { fprintf(stderr, "kernel_launch: unexpected shapes (n_in %d, in0 %d, out %d, ws %zu < %zu); nothing launched\n", n_in, n_in > 0 ? in_sizes[0] : -1, out_size, ws_size, (size_t)WS_END); grid = -1; return; }
        int dev = 0, cus = 0;
        if (hipGetDevice(&dev) != hipSuccess || hipDeviceGetAttribute(&cus, hipDeviceAttributeMultiprocessorCount, dev) != hipSuccess) { grid = -1; return; }
        if (hipFuncSetAttribute((const void*)mk_fwd, hipFuncAttributeMaxDynamicSharedMemorySize, LDS_BYTES) != hipSuccess) { fprintf(stderr, "kernel_launch: hipFuncSetAttribute failed\n"); grid = -1; return; }
        int per_cu = 0;
        if (hipOccupancyMaxActiveBlocksPerMultiprocessor(&per_cu, (const void*)mk_fwd, NTHR, LDS_BYTES) != hipSuccess || per_cu < 1) fprintf(stderr, "kernel_launch: occupancy query reports %d\n", per_cu);
        (void)hipGetLastError();
        grid = cus;
        if (grid != 256) fprintf(stderr, "kernel_launch: %d CUs (built for 256)\n", grid);
    }
    if (grid < 0) return;
    if (hipMemsetAsync((char*)d_ws + WS_CTL, 0, CTL_ZERO_BYTES, stream) != hipSuccess) return;
    Args a{};
    for (int i = 0; i < 27; ++i) a.in[i] = (const float*)d_in[i];
    a.out = (float*)d_out; a.ws = (unsigned char*)d_ws;
#if MK_FUSED
    a.ph_lo = 0; a.ph_hi = NPH;
    hipLaunchKernelGGL(mk_fwd, dim3(grid), dim3(NTHR), LDS_BYTES, stream, a);
#else
    for (int p = 0; p < NPH; ++p) { if (!phase_valid(p)) continue; a.ph_lo = p; a.ph_hi = p + 1; hipLaunchKernelGGL(mk_fwd, dim3(grid), dim3(NTHR), LDS_BYTES, stream, a); }
#endif
}
```

```cpp
#include <hip/hip_runtime.h>
#include <hip/hip_bf16.h>
#include <cstdio>
#include <cstdint>
#include <cmath>
namespace pg8 {
#define PG8_LAS __attribute__((address_space(3)))
typedef unsigned short bf16_t;
typedef short bf16x8 __attribute__((ext_vector_type(8)));
typedef float f32x4 __attribute__((ext_vector_type(4)));
typedef unsigned u32x4 __attribute__((ext_vector_type(4)));
constexpr int BM = 256, BK = 64, HALF = 128, HTB = HALF * BK * 2  , STAGE_BYTES = 8 * HTB, NXCD = 8, WGM = 8;

__host__ __device__ __forceinline__ int lds_byte(int r, int c) { const int st = (r >> 4) * 2 + (c >> 5), rr = r & 15, cc = c & 31, ob = rr * 64 + cc * 2; return st * 1024 + (ob ^ (((ob >> 9) & 1) << 5)); }
__host__ __device__ __forceinline__ void stage_rc(int b, int& R, int& C) { const int st = b / 1024, sb = b % 1024, swz = sb ^ (((sb >> 9) & 1) << 5); R = (st >> 1) * 16 + swz / 64; C = (st & 1) * 32 + (swz % 64) / 2; }
__host__ __device__ __forceinline__ int perm32(int rho) { const int n = rho >> 4, i = rho & 15; return 8 * (i >> 2) + 4 * n + (i & 3); }

struct Unit { int pm, pn; };
struct Gemm { const bf16_t* A; const bf16_t* Bt; int M, N, K; };

struct StaticOrder {
    int nM, nN, nwg, G, c;
    __host__ __device__ void init(int M, int N, int G_, int c_) { nM = M / BM; nN = N / BM; nwg = nM * nN; G = G_; c = c_; }
    __host__ __device__ bool next(int i, Unit& u) const {
        const long L = (long)i * G + c; if (L >= nwg) return false;
        int wgid = (int)L; { const int q = nwg / NXCD, r = nwg % NXCD, xcd = wgid % NXCD, off = wgid / NXCD; wgid = (xcd < r ? xcd * (q + 1) : r * (q + 1) + (xcd - r) * q) + off; }
        const int nig = WGM * nN, gid = wgid / nig, fm = gid * WGM, gsz = (nM - fm) < WGM ? (nM - fm) : WGM;
        u.pm = fm + ((wgid % nig) % gsz); u.pn = (wgid % nig) / gsz; return true;
    }
    __device__ __forceinline__ void a_ready(const Unit&) const {}
    __device__ __forceinline__ void done(const Unit&) const {}
    __device__ __forceinline__ size_t aoff(const Unit& u, size_t tstepA) const { return (size_t)u.pm * tstepA; }
    __device__ __forceinline__ size_t boff(const Unit& u, size_t tstepB) const { return (size_t)u.pn * tstepB; }
    __device__ __forceinline__ unsigned arow_off(const Unit&, int) const { return 0u; }
};

__device__ __forceinline__ unsigned cvt_pk_bf16(float lo, float hi) { unsigned r; asm volatile("v_cvt_pk_bf16_f32 %0, %1, %2" : "=v"(r) : "v"(lo), "v"(hi)); return r; }
typedef float f32x2 __attribute__((ext_vector_type(2)));
__device__ __forceinline__ f32x2 gelu_pk(f32x2 v) {
    const f32x2 av = __builtin_elementwise_abs(v), d = av * 0.2316418882f + 1.0f;
    f32x2 t; t.x = __builtin_amdgcn_rcpf(d.x); t.y = __builtin_amdgcn_rcpf(d.y);
    f32x2 q = t * 0.5307027145f + (-0.7265760135f); q = q * t + 0.7107068705f; q = q * t + (-0.142248368f); q = q * t + 0.127414796f; q = q * t;
    const f32x2 s = (v * v) * (-0.72134752044f);
    f32x2 e; e.x = __builtin_amdgcn_exp2f(s.x); e.y = __builtin_amdgcn_exp2f(s.y);
    const f32x2 m = v * (q * e), r = v - m;
    f32x2 o; o.x = v.x < 0.f ? m.x : r.x; o.y = v.y < 0.f ? m.y : r.y; return o;
}

typedef int i32x4 __attribute__((ext_vector_type(4)));
__device__ __forceinline__ f32x4 dq4(const f32x4& a, float srow, const f32x4& scol) { const i32x4 v = __builtin_bit_cast(i32x4, a); return (f32x4){(float)v[0], (float)v[1], (float)v[2], (float)v[3]} * srow * scol; }
__device__ __forceinline__ void stage_scales_dma(PG8_LAS unsigned char* ldsc, const float* rs, const float* cs, int lane) {
    __builtin_amdgcn_global_load_lds((const unsigned*)(rs + 4 * lane), (PG8_LAS unsigned*)ldsc, 16, 0, 0);
    __builtin_amdgcn_global_load_lds((const unsigned*)(cs + 4 * lane), (PG8_LAS unsigned*)(ldsc + 1024), 16, 0, 0);
}
template <int ACT  > struct EpiBf16 {
    static constexpr int PERM = 1, AFTER_DRAIN = false; static constexpr int NSTORE = 16;     static_assert(ACT == 0 || ACT == 1, "EpiBf16: ACT is 0 (none) or 1 (gelu_pk)");
    bf16_t* O; int ldc; const float* bias; int split_cols; size_t split_stride; float scale0; const float* sa = nullptr; const float* sb = nullptr;
    __device__ __forceinline__ void stage_scales(PG8_LAS unsigned char* ldsc, const Unit& u, int lane) const { if (sa) stage_scales_dma(ldsc, sa + u.pm * BM, sb + u.pn * BM, lane); }
    __device__ __forceinline__ void operator()(const f32x4 (&acc)[2][2][4][2], const Unit& u, int wr, int wc, int fr, int fq, const PG8_LAS unsigned char* ldsc) const {
        const int row0 = u.pm * BM + wr * 64 + fr; int colt = u.pn * BM; bf16_t* base = O;
        float sc = 1.f; if (split_cols) { const int t = colt / split_cols; base += (size_t)t * split_stride; colt -= t * split_cols; if (t == 0) sc = scale0; }
        const int col0 = colt + wc * 32 + 8 * fq, bcol0 = u.pn * BM + wc * 32 + 8 * fq;
        f32x4 bv[2][2];
#pragma unroll
        for (int bj = 0; bj < 2; ++bj)
#pragma unroll
            for (int n = 0; n < 2; ++n) bv[bj][n] = bias ? *(const f32x4*)(bias + bcol0 + bj * HALF + 4 * n) : (f32x4){0.f, 0.f, 0.f, 0.f};
        float srw[2][4]; f32x4 scl[2][2];
        { const PG8_LAS float* lr = (const PG8_LAS float*)ldsc + wr * 64 + fr; const PG8_LAS float* lc = (const PG8_LAS float*)(ldsc + 1024) + wc * 32 + 8 * fq;
#pragma unroll
          for (int ai = 0; ai < 2; ++ai)
#pragma unroll
              for (int m = 0; m < 4; ++m) srw[ai][m] = sa ? lr[ai * HALF + m * 16] : 1.f;
#pragma unroll
          for (int bj = 0; bj < 2; ++bj)
#pragma unroll
              for (int n = 0; n < 2; ++n) scl[bj][n] = sa ? *(const PG8_LAS f32x4*)(lc + bj * HALF + 4 * n) : (f32x4){1.f, 1.f, 1.f, 1.f}; }
#pragma unroll
        for (int ai = 0; ai < 2; ++ai)
#pragma unroll
            for (int m = 0; m < 4; ++m) { bf16_t* rowp = base + (size_t)(row0 + ai * HALF + m * 16) * ldc + col0;
#pragma unroll
                for (int bj = 0; bj < 2; ++bj) { f32x4 v0, v1; if (sa) { const float sr = srw[ai][m]; v0 = dq4(acc[ai][bj][m][0], sr, scl[bj][0]) + bv[bj][0]; v1 = dq4(acc[ai][bj][m][1], sr, scl[bj][1]) + bv[bj][1]; } else { v0 = acc[ai][bj][m][0] + bv[bj][0]; v1 = acc[ai][bj][m][1] + bv[bj][1]; }
                    if (ACT == 1) { f32x2 a = gelu_pk((f32x2){v0[0], v0[1]}), b = gelu_pk((f32x2){v0[2], v0[3]}), c = gelu_pk((f32x2){v1[0], v1[1]}), d = gelu_pk((f32x2){v1[2], v1[3]});
                        v0 = (f32x4){a.x, a.y, b.x, b.y}; v1 = (f32x4){c.x, c.y, d.x, d.y}; }
                    v0 = v0 * sc; v1 = v1 * sc; u32x4 w; w.x = cvt_pk_bf16(v0[0], v0[1]); w.y = cvt_pk_bf16(v0[2], v0[3]); w.z = cvt_pk_bf16(v1[0], v1[1]); w.w = cvt_pk_bf16(v1[2], v1[3]);
                    *(u32x4*)(rowp + bj * HALF) = w; } }
    }
};

template <bool I8> __device__ __forceinline__ f32x4 mma_step(const bf16x8& a, const bf16x8& b, const f32x4& c) {
    if constexpr (I8) return __builtin_bit_cast(f32x4, __builtin_amdgcn_mfma_i32_16x16x64_i8(__builtin_bit_cast(i32x4, a), __builtin_bit_cast(i32x4, b), __builtin_bit_cast(i32x4, c), 0, 0, 0));
    else return __builtin_amdgcn_mfma_f32_16x16x32_bf16(a, b, c, 0, 0, 0);
}
template <class Epi, class Sched, bool ALIGN_EPI = false, bool SP2 = false, bool I8 = false, bool GATHER = false>
__device__ __forceinline__ void gemm_phase(PG8_LAS unsigned char* lds, const Gemm g, const Sched& S, const Epi& E, const int tid_in) {
    const int tid = tid_in, wid = __builtin_amdgcn_readfirstlane(tid >> 6), lane = tid & 63, wr = wid >> 2, wc = wid & 3, fr = lane & 15, fq = lane >> 4;
    const int K = g.K, nt = K / BK;
    unsigned voffA[2], voffB[2], voffB1[2];
#pragma unroll
    for (int i = 0; i < 2; ++i) { int R, C; stage_rc(tid * 16 + i * 8192, R, C); const int Rb = Epi::PERM == 1 ? ((R & ~31) + perm32(R & 31)) : R;
        voffA[i] = (unsigned)(R * K + C) * 2u;
        if constexpr (Epi::PERM == 2) { const int cb = (R >> 5) * 64 + 16 * ((R & 15) >> 2) + 4 * ((R >> 4) & 1) + (R & 3); voffB[i] = (unsigned)(cb * K + C) * 2u; voffB1[i] = (unsigned)((cb + 8) * K + C) * 2u; }
        else { voffB[i] = (unsigned)(Rb * K + C) * 2u; voffB1[i] = voffB[i] + (unsigned)(HALF * K * 2); } }
    const size_t kstep = (size_t)(BK * 2);
    const size_t hstep = (size_t)HALF * K * 2;
    const size_t tstep = 2 * hstep;
    const unsigned ldsw = (unsigned)wid * 1024u;
    const int aoff = lds_byte(wr * 64 + fr, fq * 8), boff = lds_byte(wc * 32 + fr, fq * 8);
#define PG8_SA(b, h) (((b) * 2 + (h)) * HTB)
#define PG8_SB(b, h) ((4 + (b) * 2 + (h)) * HTB)
#define PG8_STAGE(bufoff, gbase, voff) do { _Pragma("unroll") for (int _i = 0; _i < 2; ++_i) \
        __builtin_amdgcn_global_load_lds((const unsigned*)((const char*)(gbase) + (voff)[_i]), (PG8_LAS unsigned*)(lds + (bufoff) + ldsw + _i * 8192), 16, 0, 0); } while (0)
#define PG8_STAGE_A(bufoff, gptr, kb, vo) do { if constexpr (GATHER) { _Pragma("unroll") for (int _i = 0; _i < 2; ++_i) \
        __builtin_amdgcn_global_load_lds((const unsigned*)((const char*)g.A + (kb) + (vo)[_i]), (PG8_LAS unsigned*)(lds + (bufoff) + ldsw + _i * 8192), 16, 0, 0); } else PG8_STAGE(bufoff, gptr, voffA); } while (0)
#define PG8_LDA(dst, b, h) do { _Pragma("unroll") for (int m = 0; m < 4; ++m) _Pragma("unroll") for (int k = 0; k < 2; ++k) dst[m][k] = *(const PG8_LAS bf16x8*)(lds + PG8_SA(b, h) + aoff + m * 2048 + k * 1024); } while (0)
#define PG8_LDB(dst, b, h) do { _Pragma("unroll") for (int n = 0; n < 2; ++n) _Pragma("unroll") for (int k = 0; k < 2; ++k) dst[n][k] = *(const PG8_LAS bf16x8*)(lds + PG8_SB(b, h) + boff + n * 2048 + k * 1024); } while (0)
#define PG8_MMA(ai, bj, At, Bt) do { __builtin_amdgcn_s_setprio(1); _Pragma("unroll") for (int m = 0; m < 4; ++m) _Pragma("unroll") for (int n = 0; n < 2; ++n) _Pragma("unroll") for (int k = 0; k < 2; ++k) \
        acc[ai][bj][m][n] = mma_step<I8>(Bt[n][k], At[m][k], acc[ai][bj][m][n]); __builtin_amdgcn_s_setprio(0); } while (0)
#define PG8_WAIT_V(n) asm volatile("s_waitcnt vmcnt(" #n ")" ::: "memory")
#define PG8_WAIT_VS() do { if constexpr (Epi::NSTORE == 16) asm volatile("s_cmp_eq_u32 %0, 0\n\ts_cbranch_scc1 1f\n\ts_waitcnt vmcnt(24)\n\ts_branch 2f\n1:\n\ts_waitcnt vmcnt(8)\n2:" :: "s"(__builtin_amdgcn_readfirstlane(stores_pending)) : "memory", "scc"); \
        else if constexpr (Epi::NSTORE == 8) asm volatile("s_cmp_eq_u32 %0, 0\n\ts_cbranch_scc1 1f\n\ts_waitcnt vmcnt(16)\n\ts_branch 2f\n1:\n\ts_waitcnt vmcnt(8)\n2:" :: "s"(__builtin_amdgcn_readfirstlane(stores_pending)) : "memory", "scc"); \
        else asm volatile("s_waitcnt vmcnt(8)" ::: "memory"); } while (0)
#define PG8_WAIT_L(n) asm volatile("s_waitcnt lgkmcnt(" #n ")" ::: "memory")
#define PG8_BAR __builtin_amdgcn_s_barrier()
#define PG8_SCHED __builtin_amdgcn_sched_barrier(0)
    Unit cur, nxt; int ui = 0;
    if (!S.next(0, cur)) return;
    f32x4 acc[2][2][4][2];
#pragma unroll
    for (int a = 0; a < 2; ++a)
#pragma unroll
        for (int b = 0; b < 2; ++b)
#pragma unroll
            for (int m = 0; m < 4; ++m)
#pragma unroll
                for (int n = 0; n < 2; ++n) acc[a][b][m][n] = (f32x4){0.f, 0.f, 0.f, 0.f};
    bf16x8 At[4][2], B0[2][2], B1[2][2];
    const char* cA = (const char*)g.A + S.aoff(cur, tstep); const char* cB = (const char*)g.Bt + S.boff(cur, tstep);
    unsigned ca[2][2] = {{0u, 0u}, {0u, 0u}}, na[2][2] = {{0u, 0u}, {0u, 0u}};
    if constexpr (GATHER) {
#pragma unroll
        for (int h2 = 0; h2 < 2; ++h2)
#pragma unroll
            for (int i = 0; i < 2; ++i) { int R, C; stage_rc(tid * 16 + i * 8192, R, C); ca[h2][i] = S.arow_off(cur, 128 * h2 + R) + (unsigned)C * 2u; } }
    S.a_ready(cur);
    if constexpr (SP2) {
        PG8_STAGE(PG8_SB(0, 0), cB, voffB); PG8_STAGE(PG8_SB(0, 1), cB, voffB1); PG8_STAGE_A(PG8_SA(0, 0), cA, 0, ca[0]); PG8_STAGE_A(PG8_SA(0, 1), cA + hstep, 0, ca[1]);
        if (wr == 1) PG8_BAR;
        PG8_WAIT_V(2); PG8_BAR;
        PG8_STAGE(PG8_SB(1, 0), cB + kstep, voffB); PG8_STAGE_A(PG8_SA(1, 0), cA + kstep, kstep, ca[0]); PG8_STAGE(PG8_SB(1, 1), cB + kstep, voffB1);
        PG8_WAIT_V(6); PG8_BAR;
    } else {
        PG8_STAGE(PG8_SB(0, 0), cB, voffB); PG8_STAGE(PG8_SA(0, 0), cA, voffA); PG8_STAGE(PG8_SB(0, 1), cB, voffB1); PG8_STAGE(PG8_SA(0, 1), cA + hstep, voffA);
        if (wr == 1) PG8_BAR;
        PG8_WAIT_V(4); PG8_BAR;
        PG8_STAGE(PG8_SB(1, 0), cB + kstep, voffB); PG8_STAGE(PG8_SA(1, 0), cA + kstep, voffA); PG8_STAGE(PG8_SB(1, 1), cB + kstep, voffB1);
        PG8_WAIT_V(6); PG8_BAR;
    }
    for (;;) {
        const bool has_next = S.next(ui + 1, nxt);
        const char* nA = has_next ? (const char*)g.A + S.aoff(nxt, tstep) : cA; const char* nB = has_next ? (const char*)g.Bt + S.boff(nxt, tstep) : cB;
        if constexpr (GATHER) {
#pragma unroll
            for (int h2 = 0; h2 < 2; ++h2)
#pragma unroll
                for (int i = 0; i < 2; ++i) { int R, C; stage_rc(tid * 16 + i * 8192, R, C); na[h2][i] = has_next ? S.arow_off(nxt, 128 * h2 + R) + (unsigned)C * 2u : ca[h2][i]; } }
        for (int t = 0; t < nt; t += 2) {
            const bool last = (t == nt - 2); const int stores_pending = __builtin_amdgcn_readfirstlane((SP2 && (t == 0) && (ui > 0) && !Epi::AFTER_DRAIN) ? 1 : 0);
            const char* a1 = cA + (size_t)(t + 1) * kstep;
            const char* a2 = last ? nA : cA + (size_t)(t + 2) * kstep; const char* b2 = last ? nB : cB + (size_t)(t + 2) * kstep;
            const char* a3 = a2 + kstep; const char* b3 = b2 + kstep;
            if (last && has_next) S.a_ready(nxt);
            if (last && wid == 0) E.stage_scales(lds + STAGE_BYTES, cur, lane);
            const size_t k2 = last ? (size_t)0 : (size_t)(t + 2) * kstep; unsigned sa0[2], sa1[2];
#pragma unroll
            for (int i = 0; i < 2; ++i) { sa0[i] = last ? na[0][i] : ca[0][i]; sa1[i] = last ? na[1][i] : ca[1][i]; }
            if constexpr (SP2) {
            PG8_LDB(B0, 0, 0); PG8_LDB(B1, 0, 1); PG8_SCHED; PG8_LDA(At, 0, 0); if (!stores_pending) PG8_STAGE_A(PG8_SA(1, 1), a1 + hstep, (size_t)(t + 1) * kstep, ca[1]);
            PG8_WAIT_VS(); PG8_WAIT_L(0); PG8_BAR; PG8_MMA(0, 0, At, B0); PG8_MMA(0, 1, At, B1); PG8_BAR; PG8_SCHED;
            PG8_LDA(At, 0, 1); PG8_STAGE(PG8_SB(0, 0), b2, voffB); PG8_STAGE(PG8_SB(0, 1), b2, voffB1); PG8_STAGE_A(PG8_SA(0, 0), a2, k2, sa0);
            PG8_WAIT_VS(); PG8_WAIT_L(0); PG8_BAR; PG8_MMA(1, 0, At, B0); PG8_MMA(1, 1, At, B1); PG8_BAR; PG8_SCHED;
            PG8_LDB(B0, 1, 0); PG8_LDB(B1, 1, 1); PG8_SCHED; PG8_LDA(At, 1, 0); PG8_STAGE_A(PG8_SA(0, 1), a2 + hstep, k2, sa1);
            PG8_WAIT_VS(); PG8_WAIT_L(0); PG8_BAR; PG8_MMA(0, 0, At, B0); PG8_MMA(0, 1, At, B1); PG8_BAR; PG8_SCHED;
            PG8_LDA(At, 1, 1); PG8_STAGE(PG8_SB(1, 0), b3, voffB); PG8_STAGE(PG8_SB(1, 1), b3, voffB1); PG8_STAGE_A(PG8_SA(1, 0), a3, k2 + kstep, sa0);
            PG8_WAIT_V(8); PG8_WAIT_L(0); PG8_BAR; PG8_MMA(1, 0, At, B0); PG8_MMA(1, 1, At, B1); PG8_BAR; PG8_SCHED;
            } else {
            PG8_LDB(B0, 0, 0); PG8_SCHED; PG8_LDA(At, 0, 0); PG8_STAGE(PG8_SA(1, 1), a1 + hstep, voffA);
            PG8_WAIT_L(8); PG8_BAR; PG8_WAIT_L(0); PG8_MMA(0, 0, At, B0); PG8_BAR; PG8_SCHED;
            PG8_LDB(B1, 0, 1); PG8_STAGE(PG8_SB(0, 0), b2, voffB);
            PG8_BAR; PG8_WAIT_L(0); PG8_MMA(0, 1, At, B1); PG8_BAR;
            PG8_LDA(At, 0, 1); PG8_STAGE(PG8_SA(0, 0), a2, voffA);
            PG8_BAR; PG8_WAIT_L(0); PG8_MMA(1, 0, At, B0); PG8_BAR; PG8_SCHED;
            PG8_STAGE(PG8_SB(0, 1), b2, voffB1);
            PG8_WAIT_V(6); PG8_BAR; PG8_MMA(1, 1, At, B1); PG8_BAR;
            PG8_LDB(B0, 1, 0); PG8_SCHED; PG8_LDA(At, 1, 0); PG8_STAGE(PG8_SA(0, 1), a2 + hstep, voffA);
            PG8_WAIT_L(8); PG8_BAR; PG8_WAIT_L(0); PG8_MMA(0, 0, At, B0); PG8_BAR; PG8_SCHED;
            PG8_LDB(B1, 1, 1); PG8_STAGE(PG8_SB(1, 0), b3, voffB);
            PG8_BAR; PG8_WAIT_L(0); PG8_MMA(0, 1, At, B1); PG8_BAR;
            PG8_LDA(At, 1, 1); PG8_STAGE(PG8_SA(1, 0), a3, voffA);
            PG8_BAR; PG8_WAIT_L(0); PG8_MMA(1, 0, At, B0); PG8_BAR; PG8_SCHED;
            PG8_STAGE(PG8_SB(1, 1), b3, voffB1);
            PG8_WAIT_V(6); PG8_BAR; PG8_MMA(1, 1, At, B1); PG8_BAR;
            }
        }
        if constexpr (SP2 && !Epi::AFTER_DRAIN) { if (has_next) PG8_STAGE_A(PG8_SA(1, 1), nA + kstep + hstep, kstep, na[1]); }
        if constexpr (ALIGN_EPI) { if (wr == 0) PG8_BAR; }
        if constexpr (!Epi::AFTER_DRAIN) { E(acc, cur, wr, wc, fr, fq, lds + STAGE_BYTES); S.done(cur); }
        if (!has_next) break;
#pragma unroll
        for (int a = 0; a < 2; ++a)
#pragma unroll
            for (int b = 0; b < 2; ++b)
#pragma unroll
                for (int m = 0; m < 4; ++m)
#pragma unroll
                    for (int n = 0; n < 2; ++n) acc[a][b][m][n] = (f32x4){0.f, 0.f, 0.f, 0.f};
        cur = nxt; cA = nA; cB = nB; ++ui;
        if constexpr (GATHER) {
#pragma unroll
            for (int h2 = 0; h2 < 2; ++h2)
#pragma unroll
                for (int i = 0; i < 2; ++i) ca[h2][i] = na[h2][i]; }
        if constexpr (ALIGN_EPI) { if (wr == 1) PG8_BAR; }
    }
    PG8_WAIT_V(0);
    if constexpr (!ALIGN_EPI) { if (wr == 0) PG8_BAR; }
    PG8_BAR;
    if constexpr (Epi::AFTER_DRAIN) { E.fused(acc, cur, wr, wc, fr, fq, lds, wid, lane); S.done(cur); }
#undef PG8_SA
#undef PG8_SB
#undef PG8_STAGE
#undef PG8_STAGE_A
#undef PG8_LDA
#undef PG8_LDB
#undef PG8_MMA
#undef PG8_WAIT_V
#undef PG8_WAIT_VS
#undef PG8_WAIT_L
#undef PG8_BAR
#undef PG8_SCHED
}
}
namespace attn_body {
using bf16=__hip_bfloat16;
using bf16x8=__attribute__((ext_vector_type(8)))short;
using s16x4=__attribute__((ext_vector_type(4)))short;
using f32x16=__attribute__((ext_vector_type(16)))float;
using u32x4=__attribute__((ext_vector_type(4)))unsigned;
constexpr int BATCH=4,NHEAD=16,SEQ=8192,D=64,DM=NHEAD*D;
constexpr int NW=8,QBLK=32,QB=QBLK*NW,KVBLK=64,NQB=SEQ/QB;
constexpr int ATTN_PITCH=DM, ATTN_UNIT_ROWS=QB;
__device__ __forceinline__ int crow(int r,int hi){return (r&3)+8*(r>>2)+4*hi;}
#define SBAR() __builtin_amdgcn_sched_barrier(0)
__device__ __forceinline__ void cmask(f32x16&p0,f32x16&p1,int jb,int qrel,int hi){
  const float NEG=-INFINITY; int kb=64*jb+4*hi;
  #pragma unroll
  for(int r=0;r<16;++r){int kv=kb+(r&3)+8*(r>>2); if(kv>qrel)p0[r]=NEG; if(kv+32>qrel)p1[r]=NEG;}
}

typedef __attribute__((address_space(3))) const float* lds_cfptr;
__device__ __forceinline__ void bmask(f32x16&p0,f32x16&p1,int jb6,int qrel,int hi,lds_cfptr lut){
  const float NEG=-INFINITY; const int kb=64*jb6-128+4*hi;
  #pragma unroll
  for(int r=0;r<16;++r){const int n0=qrel-(kb+(r&3)+8*(r>>2)), n1=n0-32;
    const float b0=lut[n0<0?0:n0], b1=lut[n1<0?0:n1];
    p0[r]=(n0>=0)?p0[r]+b0:NEG; p1[r]=(n1>=0)?p1[r]+b1:NEG;}
}

constexpr int NSLOT=3, SLOTB=8192;
constexpr int LDS_K=0, LDS_V=NSLOT*SLOTB, LDS_WS=3*NSLOT*SLOTB, LDS_OST=LDS_WS+NW*64*4, LDS_BYTES=LDS_OST+NW*4096;
constexpr float C2=0.125f*1.4426950408889634f;
__device__ __forceinline__ void glds16(const void*gsrc,unsigned lds_dst){unsigned keep;
  asm volatile("s_mov_b32 %0, m0\n\ts_mov_b32 m0, %2\n\ts_nop 0\n\tglobal_load_lds_dwordx4 %1, off\n\ts_mov_b32 m0, %0":"=&s"(keep):"v"(gsrc),"s"(lds_dst):"memory");}
__device__ __forceinline__ float max3f(float a,float b,float c){float r;asm("v_max3_f32 %0, %1, %2, %3":"=v"(r):"v"(a),"v"(b),"v"(c));return r;}
__device__ __forceinline__ float max2f(float a,float b){float r;asm("v_max_f32_e32 %0, %1, %2":"=v"(r):"v"(a),"v"(b));return r;}
__device__ __forceinline__ float fadd_s(float a,float b){float r;asm("v_add_f32_e32 %0, %1, %2":"=v"(r):"v"(a),"v"(b));return r;}
__device__ __forceinline__ float fsub_s(float a,float b){float r;asm("v_sub_f32_e32 %0, %1, %2":"=v"(r):"v"(a),"v"(b));return r;}
typedef float f32x2_t __attribute__((ext_vector_type(2))); typedef __bf16 bf16x2_t __attribute__((ext_vector_type(2)));
__device__ __forceinline__ unsigned cvtpk_s(float lo,float hi){f32x2_t v={lo,hi};bf16x2_t b=__builtin_convertvector(v,bf16x2_t);return __builtin_bit_cast(unsigned,b);}
#define WAIT_BAR(N) asm volatile("s_waitcnt vmcnt(" #N ") lgkmcnt(0)\n\ts_barrier":::"memory")

__device__ __forceinline__ void qkt(f32x16&p0,f32x16&p1,const char*Kslot,const bf16x8*qr,int r32,int hi){ const f32x16 negm=f32x16{};
  const char*kb=Kslot+hi*1024+r32*16;
  #pragma unroll
  for(int d0=0;d0<4;++d0){
    const bf16x8 b0=*reinterpret_cast<const bf16x8*>(kb+d0*2048);
    const bf16x8 b1=*reinterpret_cast<const bf16x8*>(kb+d0*2048+512);
    if(d0==0){p0=__builtin_amdgcn_mfma_f32_32x32x16_bf16(b0,qr[0],negm,0,0,0);p1=__builtin_amdgcn_mfma_f32_32x32x16_bf16(b1,qr[0],negm,0,0,0);}
    else{p0=__builtin_amdgcn_mfma_f32_32x32x16_bf16(b0,qr[d0],p0,0,0,0);p1=__builtin_amdgcn_mfma_f32_32x32x16_bf16(b1,qr[d0],p1,0,0,0);}}
}
typedef __attribute__((address_space(3))) const char* lds_cptr;
typedef short v4i16_t __attribute__((ext_vector_type(4)));
__device__ __forceinline__ void kload8(bf16x8*kf,lds_cptr kp){
  kf[0]=*(const __attribute__((address_space(3))) bf16x8*)(kp);      kf[1]=*(const __attribute__((address_space(3))) bf16x8*)(kp+512);
  kf[2]=*(const __attribute__((address_space(3))) bf16x8*)(kp+2048); kf[3]=*(const __attribute__((address_space(3))) bf16x8*)(kp+2560);
  kf[4]=*(const __attribute__((address_space(3))) bf16x8*)(kp+4096); kf[5]=*(const __attribute__((address_space(3))) bf16x8*)(kp+4608);
  kf[6]=*(const __attribute__((address_space(3))) bf16x8*)(kp+6144); kf[7]=*(const __attribute__((address_space(3))) bf16x8*)(kp+6656);
}
__device__ __forceinline__ void kload2(bf16x8*kf,lds_cptr kp,int j){ kf[2*j]=*(const __attribute__((address_space(3))) bf16x8*)(kp+j*2048); kf[2*j+1]=*(const __attribute__((address_space(3))) bf16x8*)(kp+j*2048+512); }
__device__ __forceinline__ s16x4 vtr(lds_cptr p){ return __builtin_bit_cast(s16x4,__builtin_amdgcn_ds_read_tr16_b64_v4i16((__attribute__((address_space(3))) v4i16_t*)p)); }
__device__ __forceinline__ float rowmax(const f32x16&p0,const f32x16&p1){
  float a=max3f(p0[0],p0[1],p1[0]),b=max3f(p0[2],p0[3],p1[1]);a=max3f(a,p1[2],p1[3]);
  #pragma unroll
  for(int r=4;r<16;r+=4){a=max3f(a,p0[r],p0[r+1]);b=max3f(b,p0[r+2],p0[r+3]);a=max3f(a,p1[r],p1[r+1]);b=max3f(b,p1[r+2],p1[r+3]);}
  const float m=max2f(a,b);
  auto rr=__builtin_amdgcn_permlane32_swap(__float_as_uint(m),__float_as_uint(m),false,false);
  return max2f(__uint_as_float(rr[0]),__uint_as_float(rr[1]));
}
__device__ __forceinline__ void pv(f32x16*o,int vb,bf16x8 pa0,bf16x8 pa1,bf16x8 pa2,bf16x8 pa3){
  #pragma unroll
  for(int d0=0;d0<2;++d0){s16x4 lo[4],hi[4];
    #pragma unroll
    for(int ks=0;ks<4;++ks){
      asm volatile("ds_read_b64_tr_b16 %0,%1 offset:%c2":"=&v"(lo[ks]):"v"(vb),"i"(d0*4096+ks*1024):"memory");
      asm volatile("ds_read_b64_tr_b16 %0,%1 offset:%c2":"=&v"(hi[ks]):"v"(vb),"i"(d0*4096+ks*1024+512):"memory");}
    asm volatile("s_waitcnt lgkmcnt(0)":::"memory");SBAR();
    #define PK(k) (bf16x8){lo[k][0],lo[k][1],lo[k][2],lo[k][3],hi[k][0],hi[k][1],hi[k][2],hi[k][3]}
    o[d0]=__builtin_amdgcn_mfma_f32_32x32x16_bf16(pa0,PK(0),o[d0],0,0,0);
    o[d0]=__builtin_amdgcn_mfma_f32_32x32x16_bf16(pa1,PK(1),o[d0],0,0,0);
    o[d0]=__builtin_amdgcn_mfma_f32_32x32x16_bf16(pa2,PK(2),o[d0],0,0,0);
    o[d0]=__builtin_amdgcn_mfma_f32_32x32x16_bf16(pa3,PK(3),o[d0],0,0,0);
    #undef PK
  }
}

#ifndef ATTN_STORE16
#define ATTN_STORE16(p,v) (*(u32x4*)(p)=(v))
#endif
template<int THRL> __device__ __forceinline__ void attn_unit(int b,int h,int hv,int qb,const bf16*Q,const bf16*__restrict__ K,const bf16*__restrict__ V,bf16*O,char*shm,lds_cfptr lut,const int tid_in){
  const int tid=tid_in,lane=tid&63,r32=lane&31,hi=lane>>5; const int wid=__builtin_amdgcn_readfirstlane(tid>>6);
  const long rowbase=(long)b*SEQ; const int q0=qb*QB;
  const bf16*Qw=Q+(rowbase+q0+wid*QBLK)*DM+h*D;
  const bf16*Kh=K+rowbase*DM+h*D,*Vh=V+rowbase*DM+hv*2*D;
  const unsigned lds0=(unsigned)(uintptr_t)shm;
  float*wsf=(float*)(shm+LDS_WS)+wid*64;
  const bf16*ksrc=Kh+(long)lane*DM+wid*8;
  const bf16*vsrc=Vh+(long)(16*(wid&3)+(lane>>2))*DM+(wid>>2)*32+(lane&3)*8;
  const unsigned kdst=lds0+LDS_K+wid*1024, vdst=lds0+LDS_V+wid*1024;
  #define DMA_K(t,slot) glds16(ksrc+(long)(t)*KVBLK*DM,(unsigned)__builtin_amdgcn_readfirstlane(kdst+(slot)))
  #define DMA_V(t,slot) do{ glds16(vsrc+(long)(t)*KVBLK*DM,(unsigned)__builtin_amdgcn_readfirstlane(vdst+2*(slot))); glds16(vsrc+(long)(t)*KVBLK*DM+64,(unsigned)__builtin_amdgcn_readfirstlane(vdst+2*(slot)+SLOTB)); }while(0)
  const int vb0=(int)(lds0+LDS_V)+((lane>>4)&1)*32+(lane&3)*8+(4*hi+((lane&15)>>2))*64;
  const char*Kbase=shm+LDS_K; bf16x8 kf[8];
  const lds_cptr shm3=(lds_cptr)shm; const lds_cptr kp0=shm3+LDS_K+hi*1024+r32*16; const lds_cptr vp0=shm3+LDS_V+((lane>>4)&1)*32+(lane&3)*8+(4*hi+((lane&15)>>2))*64;
  const int NT=(q0+QB)/KVBLK;
  DMA_K(0,0);DMA_V(0,0);DMA_K(1,SLOTB);
  bf16x8 qr[4];
  #pragma unroll
  for(int d0=0;d0<4;++d0)qr[d0]=*reinterpret_cast<const bf16x8*>(&Qw[(long)r32*DM+d0*16+hi*8]);
  { bf16x8*qst=(bf16x8*)(shm+LDS_OST+wid*4096)+lane; qst[0]=qr[0]; qst[64]=qr[1]; qst[128]=qr[2]; qst[192]=qr[3]; }
  const lds_cptr qp0=(lds_cptr)shm+LDS_OST+wid*4096+lane*16;
  #define QLD(d) (*(const __attribute__((address_space(3))) bf16x8*)(qp0+(d)*1024))
  float mhat=0.f,l_reg=0.f;f32x16 o[4];o[0]=f32x16{};o[1]=f32x16{};o[2]=f32x16{};o[3]=f32x16{};const f32x16 zero16=f32x16{};
  const int qrel=wid*QBLK+r32;
  #define CMASK(P0,P1,t) do{int jb_=(t)-(NT-6); if(jb_>=0)bmask(P0,P1,jb_,qrel,hi,lut);}while(0)
  bool resc=false;
  #define START(P0,P1) do{ resc=false; \
    _Pragma("unroll") for(int r=0;r<16;++r)P0[r]=__builtin_amdgcn_exp2f(P0[r]); }while(0)
  #define RESC() do{ if(resc){ asm volatile("s_waitcnt lgkmcnt(0)":::"memory"); \
      _Pragma("unroll") for(int d_=0;d_<4;++d_) _Pragma("unroll") for(int r=0;r<16;++r)o[d_][r]*=wsf[crow(r,hi)]; } }while(0)
  f32x16 pA0,pA1,pB0,pB1;
  int sl_prev=0,sl_cur=0,sl_next=SLOTB;
  #define ROT() do{sl_prev=sl_cur;sl_cur=sl_next;sl_next=(sl_next==(NSLOT-1)*SLOTB)?0:sl_next+SLOTB;}while(0)
  DMA_K(2,2*SLOTB);
  WAIT_BAR(4);
  qkt(pA0,pA1,Kbase,qr,r32,hi);asm volatile("s_nop 15\n\ts_nop 7":"+v"(pA0),"+v"(pA1));CMASK(pA0,pA1,0);
  START(pA0,pA1);
  _Pragma("unroll") for(int r=0;r<16;++r)pA1[r]=__builtin_amdgcn_exp2f(pA1[r]);
  WAIT_BAR(0);
  DMA_K(3,0);DMA_V(1,SLOTB);
  ROT();
  kload8(kf,kp0+sl_cur);
  WAIT_BAR(3);
  s16x4 vlo[8],vhi[8]; u32x4 pw0,pw1,pw2,pw3;
  #define PKW(P,B) cvtpk_s(P[B],P[B+1])
  #define PAF(k) __builtin_bit_cast(bf16x8,pw##k)
  #define VFR(i) (bf16x8){vlo[i][0],vlo[i][1],vlo[i][2],vlo[i][3],vhi[i][0],vhi[i][1],vhi[i][2],vhi[i][3]}
  #define PIN(x) asm volatile("":"+v"(x))
  #define MX3(a,b,c) __builtin_fmaxf(__builtin_fmaxf((a),(b)),(c))
  #define GAPA(MF,A0,A1,A2,A3,W0,W1,PW) do{ MF; sacc+=A0; sacc+=A1; sacc+=A2; sacc+=A3; PIN(sacc); W0; W1; PIN(PW); SBAR(); }while(0)
  #define EX(v) __builtin_amdgcn_exp2f(v)
  #define GAPB(MF,X,B) do{ MF; X[B]=EX(X[B]); X[B+1]=EX(X[B+1]); X[B+2]=EX(X[B+2]); X[B+3]=EX(X[B+3]); PIN(X); SBAR(); }while(0)
  #define VRD(i) do{ vlo[i]=vtr(vp_+(((i)>>2)*4096+((i)&3)*1024)); vhi[i]=vtr(vp_+(((i)>>2)*4096+((i)&3)*1024+512)); }while(0)
  #define VRDB(i) do{ vlo[i]=vtr(vp_+(SLOTB+((i)>>2)*4096+((i)&3)*1024)); vhi[i]=vtr(vp_+(SLOTB+((i)>>2)*4096+((i)&3)*1024+512)); }while(0)
  #define KRD(G,j) do{ if(G){ kload2(kf,kp0+sl_next,j); SBAR(); } }while(0)
  #define STEP(C0,C1,P0,P1,t,GK,GV,GL) do{ SBAR(); \
    const lds_cptr vp_=vp0+2*sl_prev; \
    bf16x8 qa_=QLD(0), qb_=QLD(1); VRD(0); SBAR(); float sacc=(P0[0]+P0[1]); \
    GAPA(C0=__builtin_amdgcn_mfma_f32_32x32x16_bf16(kf[0],qa_,zero16,0,0,0), P0[2],P0[3],P0[4],P0[5],     pw0[0]=PKW(P0,0), pw0[1]=PKW(P0,2), pw0); \
    VRD(4); SBAR(); GAPA(C1=__builtin_amdgcn_mfma_f32_32x32x16_bf16(kf[1],qa_,zero16,0,0,0), P0[6],P0[7],P0[8],P0[9],     pw0[2]=PKW(P0,4), pw0[3]=PKW(P0,6), pw0); \
    qa_=QLD(2); VRD(1); SBAR(); GAPA(C0=__builtin_amdgcn_mfma_f32_32x32x16_bf16(kf[2],qb_,C0,0,0,0),   P0[10],P0[11],P0[12],P0[13], pw1[0]=PKW(P0,8), pw1[1]=PKW(P0,10), pw1); \
    VRD(5); SBAR(); GAPA(C1=__builtin_amdgcn_mfma_f32_32x32x16_bf16(kf[3],qb_,C1,0,0,0),   P0[14],P0[15],P1[0],P1[1],   pw1[2]=PKW(P0,12),pw1[3]=PKW(P0,14), pw1); \
    qb_=QLD(3); VRD(2); SBAR(); GAPA(C0=__builtin_amdgcn_mfma_f32_32x32x16_bf16(kf[4],qa_,C0,0,0,0),   P1[2],P1[3],P1[4],P1[5],     pw2[0]=PKW(P1,0), pw2[1]=PKW(P1,2), pw2); \
    VRD(6); SBAR(); GAPA(C1=__builtin_amdgcn_mfma_f32_32x32x16_bf16(kf[5],qa_,C1,0,0,0),   P1[6],P1[7],P1[8],P1[9],     pw2[2]=PKW(P1,4), pw2[3]=PKW(P1,6), pw2); \
    VRD(3); SBAR(); GAPA(C0=__builtin_amdgcn_mfma_f32_32x32x16_bf16(kf[6],qb_,C0,0,0,0),   P1[10],P1[11],P1[12],P1[13], pw3[0]=PKW(P1,8), pw3[1]=PKW(P1,10), pw3); \
    VRD(7); SBAR(); GAPA(C1=__builtin_amdgcn_mfma_f32_32x32x16_bf16(kf[7],qb_,C1,0,0,0),   P1[14],P1[15],0.f,0.f,       pw3[2]=PKW(P1,12),pw3[3]=PKW(P1,14), pw3); \
    l_reg+=sacc; \
    if(GK){DMA_K((t)+3,sl_cur);} if(GV){DMA_V((t)+1,sl_next);} \
    CMASK(C0,C1,t); \
    resc=false; \
    SBAR(); \
    GAPB(o[0]=__builtin_amdgcn_mfma_f32_32x32x16_bf16(PAF(0),VFR(0),o[0],0,0,0), C0,0); VRDB(0); SBAR(); \
    GAPB(o[1]=__builtin_amdgcn_mfma_f32_32x32x16_bf16(PAF(0),VFR(4),o[1],0,0,0), C0,4); VRDB(4); SBAR(); \
    KRD(GL,0); GAPB(o[0]=__builtin_amdgcn_mfma_f32_32x32x16_bf16(PAF(1),VFR(1),o[0],0,0,0), C0,8); VRDB(1); SBAR(); \
    KRD(GL,1); GAPB(o[1]=__builtin_amdgcn_mfma_f32_32x32x16_bf16(PAF(1),VFR(5),o[1],0,0,0), C0,12); VRDB(5); SBAR(); \
    KRD(GL,2); GAPB(o[0]=__builtin_amdgcn_mfma_f32_32x32x16_bf16(PAF(2),VFR(2),o[0],0,0,0), C1,0); VRDB(2); SBAR(); \
    KRD(GL,3); GAPB(o[1]=__builtin_amdgcn_mfma_f32_32x32x16_bf16(PAF(2),VFR(6),o[1],0,0,0), C1,4); VRDB(6); SBAR(); \
    GAPB(o[0]=__builtin_amdgcn_mfma_f32_32x32x16_bf16(PAF(3),VFR(3),o[0],0,0,0), C1,8); VRDB(3); SBAR(); \
    GAPB(o[1]=__builtin_amdgcn_mfma_f32_32x32x16_bf16(PAF(3),VFR(7),o[1],0,0,0), C1,12); VRDB(7); SBAR(); \
      \
    o[2]=__builtin_amdgcn_mfma_f32_32x32x16_bf16(PAF(0),VFR(0),o[2],0,0,0); \
    o[3]=__builtin_amdgcn_mfma_f32_32x32x16_bf16(PAF(0),VFR(4),o[3],0,0,0); \
    o[2]=__builtin_amdgcn_mfma_f32_32x32x16_bf16(PAF(1),VFR(1),o[2],0,0,0); \
    o[3]=__builtin_amdgcn_mfma_f32_32x32x16_bf16(PAF(1),VFR(5),o[3],0,0,0); \
    o[2]=__builtin_amdgcn_mfma_f32_32x32x16_bf16(PAF(2),VFR(2),o[2],0,0,0); \
    o[3]=__builtin_amdgcn_mfma_f32_32x32x16_bf16(PAF(2),VFR(6),o[3],0,0,0); \
    o[2]=__builtin_amdgcn_mfma_f32_32x32x16_bf16(PAF(3),VFR(3),o[2],0,0,0); \
    o[3]=__builtin_amdgcn_mfma_f32_32x32x16_bf16(PAF(3),VFR(7),o[3],0,0,0); \
    }while(0)
  int t=1;
  #undef CMASK
  #define CMASK(P0,P1,t) do{}while(0)
  for(;t+7<NT;t+=2){
    STEP(pB0,pB1,pA0,pA1,t,true,true,true);     WAIT_BAR(3); RESC(); ROT();
    STEP(pA0,pA1,pB0,pB1,t+1,true,true,true);   WAIT_BAR(3); RESC(); ROT();
  }
  #undef CMASK
  #define CMASK(P0,P1,t) do{int jb_=(t)-(NT-6); if(jb_>=0)bmask(P0,P1,jb_,qrel,hi,lut);}while(0)
  #define ENDW(tt) do{ if((tt)+3<NT){WAIT_BAR(3);} else if((tt)+2<NT){WAIT_BAR(2);} else {WAIT_BAR(0);} }while(0)
  for(;t+1<NT;t+=2){
    STEP(pB0,pB1,pA0,pA1,t,(t+3<NT),(t+1<NT),(t+1<NT));       ENDW(t);   RESC(); ROT();
    STEP(pA0,pA1,pB0,pB1,t+1,(t+4<NT),(t+2<NT),(t+2<NT));     ENDW(t+1); RESC(); ROT();
  }
  STEP(pB0,pB1,pA0,pA1,NT-1,false,false,false); RESC();
  { float sacc=pB0[0]+pB0[1]; _Pragma("unroll") for(int r=2;r<16;++r)sacc+=pB0[r]; _Pragma("unroll") for(int r=0;r<16;++r)sacc+=pB1[r]; l_reg+=sacc;
    pw0=(u32x4){PKW(pB0,0),PKW(pB0,2),PKW(pB0,4),PKW(pB0,6)};pw1=(u32x4){PKW(pB0,8),PKW(pB0,10),PKW(pB0,12),PKW(pB0,14)};pw2=(u32x4){PKW(pB1,0),PKW(pB1,2),PKW(pB1,4),PKW(pB1,6)};pw3=(u32x4){PKW(pB1,8),PKW(pB1,10),PKW(pB1,12),PKW(pB1,14)};
    SBAR(); pv(o,vb0+2*sl_cur,PAF(0),PAF(1),PAF(2),PAF(3)); pv(o+2,vb0+2*sl_cur+SLOTB,PAF(0),PAF(1),PAF(2),PAF(3)); }
  #undef PKW
  #undef PAF
  #undef VFR
  #undef PIN
  #undef MX3
  #undef GAPA
  #undef GAPB
  #undef EX
  #undef VRD
  #undef VRDB
  #undef QLD
  #undef KRD
  #undef STEP
  #undef ENDW
  {auto rr=__builtin_amdgcn_permlane32_swap(__float_as_uint(l_reg),__float_as_uint(l_reg),false,false);l_reg=__uint_as_float(rr[0])+__uint_as_float(rr[1]);}
  if(hi==0)wsf[32+r32]=l_reg;asm volatile("s_waitcnt lgkmcnt(0)":::"memory");
  float rli[16];
  #pragma unroll
  for(int r=0;r<16;++r)rli[r]=__builtin_amdgcn_rcpf(wsf[32+crow(r,hi)]);
  bf16*Ow=O+(rowbase+q0+wid*QBLK)*DM+hv*2*D;
  { bf16*stg=(bf16*)(shm+LDS_OST)+wid*2048;
    #pragma unroll
    for(int hf=0;hf<2;++hf){
    #pragma unroll
    for(int r=0;r<16;++r){const int orow=crow(r,hi);
      #pragma unroll
      for(int d0=0;d0<2;++d0)stg[orow*64+d0*32+r32]=__float2bfloat16(o[2*hf+d0][r]*rli[r]);}
    asm volatile("s_waitcnt lgkmcnt(0)":::"memory");
    #pragma unroll
    for(int i=0;i<4;++i){const int row=i*8+(lane>>3),ch=lane&7; const u32x4 v=*(const u32x4*)(stg+row*64+ch*8); ATTN_STORE16(Ow+(long)row*DM+hf*64+ch*8,v);}
    asm volatile("s_waitcnt lgkmcnt(0)":::"memory"); } }
  asm volatile("s_waitcnt lgkmcnt(0)\n\ts_barrier":::"memory");
  #undef DMA_K
  #undef DMA_V
  #undef CMASK
  #undef START
  #undef RESC
  #undef ROT
}
constexpr int ATTN_LDS_BYTES=LDS_BYTES;
constexpr int LUT_OFF=110592, LUT_N=384;
struct AttnTensors { const bf16* Q; const bf16* K; const bf16* V; bf16* O0; bf16* O1; const float* lut_g; };
struct AttnUnit { int b, hq, hv, m, qb; };
struct StaticOrder {
  int vcu;
  __device__ __forceinline__ explicit StaticOrder(int grid,int block):vcu((block%8)*(grid/8)+block/8){}
  __device__ __forceinline__ bool next(int i,AttnUnit&u)const{ if(i>=8)return false; const int s=vcu&7, combo=(vcu>>3)*2+(i>>2), rem=combo&15, h=rem>>1, m=rem&1, k=i&3;
    u.b=combo>>4; u.hq=2*h+m; u.hv=h; u.m=m; u.qb=(k==0)?s:(k==1)?15-s:(k==2)?16+s:31-s; return true; }
  __device__ __forceinline__ void a_ready(const AttnUnit&)const{}
  __device__ __forceinline__ void done(const AttnUnit&)const{}
};
template<class Sched,int THRL=8> __device__ __forceinline__ void attn_phase(char*lds,const AttnTensors&T,const Sched&S,const int tid_in){
  { float* l=(float*)(lds+LUT_OFF); for(int i=tid_in;i<8*LUT_N;i+=512) l[i]=T.lut_g[i]; }
  asm volatile("s_waitcnt vmcnt(0) lgkmcnt(0)\n\ts_barrier":::"memory");
  AttnUnit u;
  for(int i=0;S.next(i,u);++i){ S.a_ready(u); attn_unit<THRL>(u.b,u.hq,u.hv,u.qb,T.Q,T.K,T.V,u.m?T.O1:T.O0,lds,(lds_cfptr)(lds+LUT_OFF)+(u.hq>>1)*LUT_N,tid_in); S.done(u); }
}
#undef SBAR
#undef WAIT_BAR
}
#ifndef PROBE_MASK
#define PROBE_MASK 0
#endif
constexpr int NWAVES = 8, NTHR = 512;
constexpr int NB = 4, SEQ = 8192, T = NB * SEQ, D = 1024, DEPTH = 4, NEXP = 16;
constexpr int A_INW = 4112;
constexpr float DN_ALPHA = 1.6817928305074290f;
constexpr float LN_EPS = 1e-5f;
constexpr int MAXTILES = 272, MAXROWS = MAXTILES * 256;

constexpr size_t MiB = 1u << 20;
constexpr size_t WS_CTL = 0, CTL_ZERO_BYTES = 1 * MiB;
constexpr size_t WS_AB = 1 * MiB;
constexpr size_t WS_TOKE = 3 * MiB;
constexpr size_t WS_TOKP = WS_TOKE + 256 * 1024;
constexpr size_t WS_TOKW = WS_TOKP + 256 * 1024;
constexpr size_t WS_TOKR = WS_TOKW + 256 * 1024;
constexpr size_t WS_MISC = 4 * MiB;
constexpr size_t WS_LUT = WS_MISC + 4096;
constexpr size_t WS_WSUM = WS_MISC + 16384;
constexpr size_t WS_EGL = WS_MISC + 32768;
constexpr size_t WS_HS = WS_MISC + 512 * 1024;
constexpr size_t WS_SBW = WS_MISC + 704 * 1024;
constexpr size_t WS_XSC = 14 * MiB;
constexpr size_t WS_SB13 = 14 * MiB + 512 * 1024;
constexpr size_t WS_ONS = 14 * MiB + 768 * 1024;
constexpr size_t WS_SBO = 14 * MiB + 1024 * 1024;
constexpr size_t WS_H8 = 144 * MiB + 384 * MiB;
constexpr size_t WS_WSB = WS_MISC + 65536;
constexpr size_t WS_RTOK = 20 * MiB;
constexpr size_t WS_RSC = 22 * MiB;
constexpr size_t WS_HALO = 5 * MiB;
constexpr size_t HALO_T = (size_t)512 * 3 * 1024;
constexpr size_t WS_W = 16 * MiB;
constexpr size_t WS_W13 = 29 * MiB;
constexpr size_t WS_W2 = 61 * MiB;
constexpr size_t WS_H = 80 * MiB;
constexpr size_t WS_R = 144 * MiB;
constexpr size_t TD2 = (size_t)T * D * 2;
constexpr size_t WS_END = WS_R + 416 * MiB;
constexpr int CW_TMO = 0, CW_BAR = 4096, CW_CNT = 8192, CW_CMAX = 65536;

constexpr int LDS_BYTES = 147456;
constexpr int RING_BYTES = 131072;
constexpr int MOE_TAB_OFF = 143360;
constexpr int MISC_OFF = LDS_BYTES - 256;

#define GAS __attribute__((address_space(1)))
#define LAS __attribute__((address_space(3)))
typedef unsigned short bf16;
typedef unsigned v4u __attribute__((ext_vector_type(4)));
typedef unsigned v2u __attribute__((ext_vector_type(2)));
typedef float f32x4 __attribute__((ext_vector_type(4)));
typedef float f32x2 __attribute__((ext_vector_type(2)));
typedef short bf16x8 __attribute__((ext_vector_type(8)));
typedef __bf16 bf16x2_t __attribute__((ext_vector_type(2)));
#define RLX_AGENT __ATOMIC_RELAXED, __HIP_MEMORY_SCOPE_AGENT
#define LDS_WAIT() asm volatile("s_waitcnt lgkmcnt(0)" ::: "memory")
#define VM_WAIT() asm volatile("s_waitcnt vmcnt(0)" ::: "memory")
#define MFMA16(a, b, c) __builtin_amdgcn_mfma_f32_16x16x32_bf16((a), (b), (c), 0, 0, 0)
__device__ __forceinline__ unsigned pk2(float lo, float hi) { f32x2 v = {lo, hi}; bf16x2_t b = __builtin_convertvector(v, bf16x2_t); return __builtin_bit_cast(unsigned, b); }
__device__ __forceinline__ float bflo(unsigned w) { return __uint_as_float(w << 16); }
__device__ __forceinline__ float bfhi(unsigned w) { return __uint_as_float(w & 0xffff0000u); }
__device__ __forceinline__ float bf1(bf16 b) { return __uint_as_float(((unsigned)b) << 16); }
__device__ __forceinline__ bf16 f2bf(float f) { return (bf16)(pk2(f, 0.f) & 0xffffu); }
__device__ __forceinline__ float wave_sum(float v) {
#pragma unroll
    for (int o = 1; o < 64; o <<= 1) v += __shfl_xor(v, o);
    return v;
}
__device__ __forceinline__ float sigmoidf_(float x) { return __builtin_amdgcn_rcpf(1.f + __builtin_amdgcn_exp2f(-1.4426950408889634f * x)); }
__device__ __forceinline__ float siluf_(float x) { return x * __builtin_amdgcn_rcpf(1.f + __builtin_amdgcn_exp2f(-1.4426950408889634f * x)); }
__device__ __forceinline__ float rsqrtf_(float x) { return __builtin_amdgcn_rsqf(x); }
#define XB_TMO      128
#define XB_XCNT(j)  (256  + 64 * (j))
#define XB_XSUB(j)  (1280 + 64 * (j))
#define XB_XGEN(j)  (2304 + 64 * (j))
#define XB_TOP      3328
#define XB_TOPGEN   3392
#define XCD_BAR_WORDS 3456
#define XB_SPIN_CAP (1u << 18)

__device__ __forceinline__ unsigned xb_ld(unsigned* p)              { return __hip_atomic_load(p, __ATOMIC_RELAXED, __HIP_MEMORY_SCOPE_AGENT); }
__device__ __forceinline__ unsigned xb_add(unsigned* p, unsigned v) { return __hip_atomic_fetch_add(p, v, __ATOMIC_RELAXED, __HIP_MEMORY_SCOPE_AGENT); }
__device__ __forceinline__ unsigned xb_xcc_id() { return (unsigned)__builtin_amdgcn_s_getreg((3 << 11) | 20) & 0xFu; }
#define XB_SPIN(cond, bar) do { unsigned _sp = 0; while (cond) { __builtin_amdgcn_s_sleep(1); \
    if ((++_sp & 255u) == 0u) { if (xb_ld(&(bar)[XB_TMO])) break; if (_sp > XB_SPIN_CAP) { atomicAdd(&(bar)[XB_TMO], 1u); break; } } } } while (0)

struct XcdBarrier {
    unsigned* bar; unsigned x; int wave;
    volatile LAS unsigned* st;
};

__device__ __forceinline__ bool xb_thread0(int wave) { return wave == 0 && __builtin_amdgcn_mbcnt_hi(~0u, __builtin_amdgcn_mbcnt_lo(~0u, 0u)) == 0u; }
__device__ __forceinline__ XcdBarrier xcd_barrier_post(unsigned* bar, volatile LAS unsigned* st, int wave) {
    XcdBarrier b; b.bar = bar; b.x = xb_xcc_id(); b.st = st; b.wave = wave;
    if (xb_thread0(wave)) (void)xb_add(&bar[XB_XCNT(b.x)], 1u);
    return b;
}
__device__ __forceinline__ void xcd_barrier_complete(unsigned* bar, unsigned x, unsigned& nloc, unsigned& nx) {
    const unsigned G = gridDim.x * gridDim.y * gridDim.z;
    unsigned sum, cnt, mine, sp = 0u;
    for (;;) {
        sum = 0u; cnt = 0u; mine = 0u;
#pragma unroll
        for (unsigned j = 0; j < 16; ++j) { const unsigned c = xb_ld(&bar[XB_XCNT(j)]); sum += c; cnt += (c > 0u) ? 1u : 0u; mine = (j == x) ? c : mine; }
        if (sum == G) break;
        __builtin_amdgcn_s_sleep(1);
        if ((++sp & 255u) == 0u) { if (xb_ld(&bar[XB_TMO])) break; if (sp > XB_SPIN_CAP) { atomicAdd(&bar[XB_TMO], 1u); break; } }
    }
    nloc = mine > 0u ? mine : 1u; nx = cnt > 0u ? cnt : 1u;
}

__device__ __forceinline__ void xcd_barrier(const XcdBarrier& b) {
    asm volatile("s_waitcnt vmcnt(0)" ::: "memory");
    __syncthreads();
    if (xb_thread0(b.wave)) {
        unsigned* bar = b.bar;
        __builtin_amdgcn_s_waitcnt(0);
        unsigned nloc = b.st[0], nx = b.st[1];
        if (nloc == 0u) { xcd_barrier_complete(bar, b.x, nloc, nx); b.st[0] = nloc; b.st[1] = nx; }
        const unsigned old = xb_add(&bar[XB_XSUB(b.x)], 1u);
        const unsigned gen = old / nloc;
        if (old + 1u == (gen + 1u) * nloc) {
            __builtin_amdgcn_fence(__ATOMIC_RELEASE, "agent");
            asm volatile("s_waitcnt vmcnt(0)" ::: "memory");
            const unsigned og = xb_add(&bar[XB_TOP], 1u);
            const unsigned tg = og / nx;
            if (og + 1u == (tg + 1u) * nx) xb_add(&bar[XB_TOPGEN], 1u);
            else XB_SPIN(xb_ld(&bar[XB_TOPGEN]) == tg, bar);
            __builtin_amdgcn_fence(__ATOMIC_ACQUIRE, "agent");
            xb_add(&bar[XB_XGEN(b.x)], 1u);
            asm volatile("s_waitcnt vmcnt(0)" ::: "memory");
        } else {
            XB_SPIN(xb_ld(&bar[XB_XGEN(b.x)]) == gen, bar);
            __builtin_amdgcn_fence(__ATOMIC_ACQUIRE, "agent");
            asm volatile("s_waitcnt vmcnt(0)" ::: "memory");
        }
    }
    __syncthreads();
}
struct Frame {
    LAS unsigned char* lds;
    unsigned* ctl;
    unsigned char* ws;
    const float* in[27];
    float* out;
    int tid, lane, wave, vcu, G;
};
enum { I_X = 0, I_LNMG, I_LNMB, I_LNFG, I_LNFB, I_AWIN, I_ACONV, I_AALOG, I_ADT, I_ANG, I_AWOUT, I_BWIN, I_BLAM, I_BNG, I_BWOUT, I_REL, I_CWIN, I_CLNG, I_CLNB, I_CWS, I_CBS, I_CWOUT, I_WR, I_RB, I_EW1, I_EW3, I_EW2 };

__device__ __forceinline__ void tr_item(const float* W, int ldw, int k0, int n0, bf16* WT, size_t dst_row0, int K, LAS float* scr, int lane) {
#pragma unroll 8
    for (int i = 0; i < 32; ++i) { const int kk = 2 * i + (lane >> 5); scr[kk * 33 + (lane & 31)] = W[(size_t)(k0 + kk) * ldw + n0 + (lane & 31)]; }
    LDS_WAIT(); asm volatile("" ::: "memory");
    const int c = lane & 7;
#pragma unroll
    for (int j = 0; j < 4; ++j) { const int n = (lane >> 3) + 8 * j; const LAS float* s = scr + (8 * c) * 33 + n;
        v4u o; o.x = pk2(s[0 * 33], s[1 * 33]); o.y = pk2(s[2 * 33], s[3 * 33]); o.z = pk2(s[4 * 33], s[5 * 33]); o.w = pk2(s[6 * 33], s[7 * 33]);
        *(GAS v4u*)(WT + (dst_row0 + n) * K + k0 + 8 * c) = o; }
    LDS_WAIT(); asm volatile("" ::: "memory");
}
__device__ __forceinline__ void tr_matrix_item(const float* W, int K, int N, int ldw, bf16* WT, LAS float* scr, int item, int lane) {
    const int nblk = N / 32, kb = item / nblk, nb = item % nblk;
    tr_item(W, ldw, 64 * kb, 32 * nb, WT, (size_t)32 * nb, K, scr, lane);
}
__device__ __forceinline__ void colmax_matrix(Frame& F, const float* W, int K, int N, int ldw, unsigned* cm) {
    const int gw = F.vcu * NWAVES + F.wave, NGW = F.G * NWAVES, lane = F.lane, nb_n = N / 256;
    for (int it = gw; it < (K / 64) * nb_n; it += NGW) { const int kb = it / nb_n, nb = it % nb_n; const float* p = W + (size_t)(kb * 64) * ldw + nb * 256 + 4 * lane; f32x4 m = {0.f, 0.f, 0.f, 0.f};
#pragma unroll 16
        for (int kk = 0; kk < 64; ++kk) { const f32x4 v = *(const GAS f32x4*)(p + (size_t)kk * ldw); m = __builtin_elementwise_max(m, __builtin_elementwise_abs(v)); }
#pragma unroll
        for (int e = 0; e < 4; ++e) __hip_atomic_fetch_max(cm + nb * 256 + 4 * lane + e, __float_as_uint(m[e]), RLX_AGENT); }
}
__device__ __forceinline__ unsigned q8x4(float a, float b, float c, float d) {
    const int qa = (int)rintf(fminf(fmaxf(a, -127.f), 127.f)), qb = (int)rintf(fminf(fmaxf(b, -127.f), 127.f)), qc = (int)rintf(fminf(fmaxf(c, -127.f), 127.f)), qd = (int)rintf(fminf(fmaxf(d, -127.f), 127.f));
    return (unsigned)(qa & 0xff) | ((unsigned)(qb & 0xff) << 8) | ((unsigned)(qc & 0xff) << 16) | ((unsigned)(qd & 0xff) << 24);
}
__device__ __forceinline__ void cv_load64(const float* W, int ldw, int k0, int n0, int lane, f32x4 (&v)[16]) {
#pragma unroll
    for (int i = 0; i < 16; ++i) v[i] = *(const GAS f32x4*)(W + (size_t)(k0 + 4 * i + (lane >> 4)) * ldw + n0 + 4 * (lane & 15));
}
template <bool I8> __device__ __forceinline__ void cv_finish64(const f32x4 (&v)[16], int k0, int n0, void* dst, size_t dst_row0, int Kp, const unsigned* cm, float* sbout, LAS float* scr, int lane) {
#pragma unroll
    for (int i = 0; i < 16; ++i) *(LAS f32x4*)(scr + (4 * i + (lane >> 4)) * 68 + 4 * (lane & 15)) = v[i];
    LDS_WAIT(); asm volatile("" ::: "memory");
    const LAS float* s = scr + lane;
    if constexpr (I8) {
        const float mx = __uint_as_float(cm[n0 + lane]); const float inv = mx > 0.f ? 127.f / mx : 0.f;
        GAS v4u* o = (GAS v4u*)((unsigned char*)dst + (dst_row0 + lane) * Kp + k0);
#pragma unroll
        for (int c = 0; c < 4; ++c) { v4u w;
            w.x = q8x4(s[(16 * c + 0) * 68] * inv, s[(16 * c + 1) * 68] * inv, s[(16 * c + 2) * 68] * inv, s[(16 * c + 3) * 68] * inv); w.y = q8x4(s[(16 * c + 4) * 68] * inv, s[(16 * c + 5) * 68] * inv, s[(16 * c + 6) * 68] * inv, s[(16 * c + 7) * 68] * inv);
            w.z = q8x4(s[(16 * c + 8) * 68] * inv, s[(16 * c + 9) * 68] * inv, s[(16 * c + 10) * 68] * inv, s[(16 * c + 11) * 68] * inv); w.w = q8x4(s[(16 * c + 12) * 68] * inv, s[(16 * c + 13) * 68] * inv, s[(16 * c + 14) * 68] * inv, s[(16 * c + 15) * 68] * inv);
            o[c] = w; }
        if (k0 == 0) sbout[n0 + lane] = mx * (1.f / 127.f);
    } else {
        GAS v4u* o = (GAS v4u*)((bf16*)dst + (dst_row0 + lane) * Kp + k0);
#pragma unroll
        for (int c = 0; c < 8; ++c) { v4u w;
            w.x = pk2(s[(8 * c + 0) * 68], s[(8 * c + 1) * 68]); w.y = pk2(s[(8 * c + 2) * 68], s[(8 * c + 3) * 68]); w.z = pk2(s[(8 * c + 4) * 68], s[(8 * c + 5) * 68]); w.w = pk2(s[(8 * c + 6) * 68], s[(8 * c + 7) * 68]);
            o[c] = w; }
    }
    LDS_WAIT(); asm volatile("" ::: "memory");
}
template <bool I8> __device__ __forceinline__ void cv_item64(const float* W, int ldw, int k0, int n0, void* dst, size_t dst_row0, int Kp, const unsigned* cm, float* sbout, LAS float* scr, int lane) {
    f32x4 v[16]; cv_load64(W, ldw, k0, n0, lane, v); cv_finish64<I8>(v, k0, n0, dst, dst_row0, Kp, cm, sbout, scr, lane);
}
__device__ __forceinline__ void q8_item(const float* W, int ldw, int k0, int n0, unsigned char* W8, size_t dst_row0, int K, const unsigned* cm, float* sbout, LAS float* scr, int lane) {
#pragma unroll 8
    for (int i = 0; i < 32; ++i) { const int kk = 2 * i + (lane >> 5); scr[kk * 33 + (lane & 31)] = W[(size_t)(k0 + kk) * ldw + n0 + (lane & 31)]; }
    LDS_WAIT(); asm volatile("" ::: "memory");
#pragma unroll
    for (int j = 0; j < 2; ++j) { const int id = lane + 64 * j, n = id >> 2, c = id & 3; const float mx = __uint_as_float(cm[n0 + n]); const float inv = mx > 0.f ? 127.f / mx : 0.f;
        const LAS float* s = scr + (16 * c) * 33 + n; v4u o;
        o.x = q8x4(s[0 * 33] * inv, s[1 * 33] * inv, s[2 * 33] * inv, s[3 * 33] * inv); o.y = q8x4(s[4 * 33] * inv, s[5 * 33] * inv, s[6 * 33] * inv, s[7 * 33] * inv);
        o.z = q8x4(s[8 * 33] * inv, s[9 * 33] * inv, s[10 * 33] * inv, s[11 * 33] * inv); o.w = q8x4(s[12 * 33] * inv, s[13 * 33] * inv, s[14 * 33] * inv, s[15 * 33] * inv);
        *(GAS v4u*)(W8 + (dst_row0 + n) * K + k0 + 16 * c) = o; }
    if (k0 == 0 && lane < 32) sbout[n0 + lane] = __uint_as_float(cm[n0 + lane]) * (1.f / 127.f);
    LDS_WAIT(); asm volatile("" ::: "memory");
}
__device__ __forceinline__ void phase_quant_inproj(Frame& F, int li, int vcu, int G) {
    LAS float* scr = (LAS float*)(F.lds + F.wave * 17408);
    const int NGW = G * NWAVES, gw = (vcu * NWAVES + F.wave + NGW / 2) % NGW, lane = F.lane, kind = li % 3, j = li / 3;
    const float* W = kind == 0 ? F.in[I_AWIN] + (size_t)j * 1024 * A_INW : (kind == 1 ? F.in[I_BWIN] + (size_t)j * 1024 * 3072 : F.in[I_CWIN] + (size_t)j * 1024 * 4096);
    const int N = kind == 1 ? 3072 : 4096, ldw = kind == 0 ? A_INW : N; const unsigned* cm = F.ctl + CW_CMAX + (kind == 0 ? j * 4096 : (kind == 1 ? 8192 : 12288));
    unsigned char* W8 = F.ws + WS_W; float* sbw = (float*)(F.ws + WS_SBW); const int nblk = N / 32;
    LAS float* scr64 = (LAS float*)(F.lds + F.wave * 17408); const int nblk64 = N / 64;
    for (int it = gw; it < 16 * nblk64; it += NGW) { const int kb = it / nblk64, nb = it % nblk64; cv_item64<true>(W, ldw, 64 * kb, 64 * nb, W8, (size_t)64 * nb, 1024, cm, sbw, scr64, lane); }
}
__device__ __forceinline__ void phase_colmax_all(Frame& F) {
    unsigned* cm = F.ctl + CW_CMAX;
    { const int gw = F.vcu * NWAVES + F.wave, NGW = F.G * NWAVES, lane = F.lane;
      for (int it = gw; it < DEPTH * NEXP * 2 * 16 * 2; it += NGW) { const int nb = it & 1, kb = (it >> 1) & 15, mat = (it >> 5) & 1, e = (it >> 6) & 15, li = it >> 10;
          const float* p = (mat ? F.in[I_EW3] : F.in[I_EW1]) + ((size_t)(li * NEXP + e) * 1024 + kb * 64) * 512 + nb * 256 + 4 * lane; f32x4 m = {0.f, 0.f, 0.f, 0.f};
#pragma unroll 16
          for (int kk = 0; kk < 64; ++kk) { const f32x4 v = *(const GAS f32x4*)(p + (size_t)kk * 512); m = __builtin_elementwise_max(m, __builtin_elementwise_abs(v)); }
          const int n0 = nb * 256 + 4 * lane;
#pragma unroll
          for (int q = 0; q < 4; ++q) __hip_atomic_fetch_max(cm + 16384 + li * 16384 + e * 1024 + (n0 >> 7) * 256 + (n0 & 127) + (mat ? 128 : 0) + q, __float_as_uint(m[q]), RLX_AGENT); } }
    colmax_matrix(F, F.in[I_AWIN], 1024, 4096, A_INW, cm); colmax_matrix(F, F.in[I_AWIN] + (size_t)1024 * A_INW, 1024, 4096, A_INW, cm + 4096);
    colmax_matrix(F, F.in[I_BWIN], 1024, 3072, 3072, cm + 8192); colmax_matrix(F, F.in[I_CWIN], 1024, 4096, 4096, cm + 12288);
    colmax_matrix(F, F.in[I_AWOUT], 1024, 1024, 1024, cm + 81920); colmax_matrix(F, F.in[I_AWOUT] + (size_t)1024 * 1024, 1024, 1024, 1024, cm + 81920 + 1024); colmax_matrix(F, F.in[I_BWOUT], 1024, 1024, 1024, cm + 81920 + 2048);
}
__device__ __forceinline__ void st_row_i8(unsigned char* row8, float* scale, int lane, const float (&v)[16]) {
    float m = 0.f;
#pragma unroll
    for (int k = 0; k < 16; ++k) m = fmaxf(m, fabsf(v[k]));
#pragma unroll
    for (int o = 1; o < 64; o <<= 1) m = fmaxf(m, __shfl_xor(m, o));
    const float inv = m > 0.f ? 127.f / m : 0.f;
    GAS unsigned* p = (GAS unsigned*)row8 + lane;
#pragma unroll
    for (int j = 0; j < 4; ++j) p[64 * j] = q8x4(v[4 * j] * inv, v[4 * j + 1] * inv, v[4 * j + 2] * inv, v[4 * j + 3] * inv);
    if (lane == 0) *scale = m * (1.f / 127.f);
}
__device__ __forceinline__ void phase_convert(Frame& F, int li, bool do_i8, int parts, int vcu, int G) {
    LAS float* scr = (LAS float*)(F.lds + F.wave * 17408);
    const int gw = vcu * NWAVES + F.wave, NGW = G * NWAVES, lane = F.lane;
    const int kind = li % 3, j = li / 3;
    bf16* Wm = (bf16*)(F.ws + WS_W);
    {
        const float* w1 = F.in[I_EW1] + (size_t)li * NEXP * 1024 * 512; const float* w3 = F.in[I_EW3] + (size_t)li * NEXP * 1024 * 512; const float* w2 = F.in[I_EW2] + (size_t)li * NEXP * 512 * 1024;
        bf16* W13 = (bf16*)(F.ws + WS_W13); bf16* W2t = (bf16*)(F.ws + WS_W2);
        LAS float* scr64 = (LAS float*)(F.lds + F.wave * 17408);
        const int mode = (parts & 3) == 3 ? 0 : ((parts & 1) ? 1 : 2), nitems = (parts & 3) == 0 ? 0 : NEXP * (mode == 0 ? 384 : (mode == 1 ? 256 : 128));
#define MW_ER(it_) const int e_ = mode == 0 ? (it_) / 384 : (mode == 1 ? (it_) >> 8 : (it_) >> 7), r_ = mode == 0 ? (it_) % 384 : (mode == 1 ? ((it_) & 255) : 256 + ((it_) & 127))
#define MW_LOAD(it_, v_) do { MW_ER(it_); \
            if (r_ < 256) { const int w3s = r_ >> 7, q_ = r_ & 127; cv_load64((w3s ? w3 : w1) + (size_t)e_ * 1024 * 512, 512, 64 * (q_ >> 3), 64 * (q_ & 7), lane, v_); } \
            else { const int q_ = r_ - 256; cv_load64(w2 + (size_t)e_ * 512 * 1024, 1024, 64 * (q_ >> 4), 64 * (q_ & 15), lane, v_); } } while (0)
#define MW_FIN(it_, v_) do { MW_ER(it_); \
            if (r_ < 256) { const int w3s = r_ >> 7, q_ = r_ & 127, n0_ = 64 * (q_ & 7); const size_t drow = (size_t)e_ * 1024 + (n0_ >> 7) * 256 + (n0_ & 127) + (w3s ? 128 : 0); \
                cv_finish64<true>(v_, 64 * (q_ >> 3), n0_, W13, drow, 1024, F.ctl + CW_CMAX + 16384 + li * 16384 + drow - n0_, (float*)(F.ws + WS_SB13) + drow - n0_, scr64, lane); } \
            else { const int q_ = r_ - 256; cv_finish64<false>(v_, 64 * (q_ >> 4), 64 * (q_ & 15), W2t, (size_t)e_ * 1024 + 64 * (q_ & 15), 512, nullptr, nullptr, scr64, lane); } } while (0)
        { f32x4 va[16], vb[16]; int it = gw;
          if (it < nitems) MW_LOAD(it, va);
          while (it < nitems) {
              const int it1 = it + NGW, it2 = it + 2 * NGW;
              if (it1 < nitems) MW_LOAD(it1, vb);
              MW_FIN(it, va);
              if (it1 >= nitems) break;
              if (it2 < nitems) MW_LOAD(it2, va);
              MW_FIN(it1, vb);
              it = it2; } }
#undef MW_LOAD
#undef MW_FIN
#undef MW_ER
    }
    if (!(parts & 4)) return;
    if (kind == 0) {
        const float* win = F.in[I_AWIN] + (size_t)j * 1024 * A_INW; const float* wout = F.in[I_AWOUT] + (size_t)j * 1024 * 1024;
        bf16* Win = Wm; bf16* Wout = Wm + (size_t)4128 * 1024;
        for (int it = (gw + NGW - (9 * NGW) / 32) % NGW; it < 16 * 32; it += NGW) { const int kb = it >> 5, nb = it & 31; q8_item(wout, 1024, 64 * kb, 32 * nb, (unsigned char*)Wout, (size_t)32 * nb, 1024, F.ctl + CW_CMAX + 81920 + j * 1024, (float*)(F.ws + WS_SBO), scr, lane); }
        for (int idx = gw * 64 + lane; idx < 16 * 1024; idx += NGW * 64) { const int n = idx >> 10, k = idx & 1023; Win[(size_t)(4096 + n) * 1024 + k] = f2bf(win[(size_t)k * A_INW + 4096 + n]); }
    } else if (kind == 1) {
        const float* win = F.in[I_BWIN] + (size_t)j * 1024 * 3072; const float* wout = F.in[I_BWOUT] + (size_t)j * 1024 * 1024;
        bf16* Win = Wm; bf16* Wout = Wm + (size_t)4128 * 1024;
        for (int it = (gw + NGW - (9 * NGW) / 32) % NGW; it < 16 * 32; it += NGW) { const int kb = it >> 5, nb = it & 31; q8_item(wout, 1024, 64 * kb, 32 * nb, (unsigned char*)Wout, (size_t)32 * nb, 1024, F.ctl + CW_CMAX + 81920 + 2048, (float*)(F.ws + WS_SBO), scr, lane); }
        float* lut = (float*)(F.ws + WS_LUT); const float* rb = F.in[I_REL];
        for (int idx = gw * 64 + lane; idx < 8 * 384; idx += NGW * 64) { const int h = idx / 384, n = idx % 384;
            int bk = n; if (n >= 16) { bk = 16 + (int)(logf((float)n / 16.0f) / logf(8.0f) * 16.0f); bk = bk > 31 ? 31 : bk; }
            lut[idx] = (rb[bk * 8 + h] - rb[31 * 8 + h]) * 1.4426950408889634f; }
    } else {
        const float* win = F.in[I_CWIN] + (size_t)j * 1024 * 4096; const float* wout = F.in[I_CWOUT] + (size_t)j * 2048 * 1024;
        bf16* Win = Wm; bf16* Wout = Wm + (size_t)4128 * 1024;
        for (int it = (gw + NGW - (9 * NGW) / 32) % NGW; it < 32 * 32; it += NGW) tr_matrix_item(wout, 2048, 1024, 1024, Wout, scr, it, lane);
        bf16* wsb = (bf16*)(F.ws + WS_WSB); const float* wsrc = F.in[I_CWS] + (size_t)j * 8 * 128 * 128;
        for (int idx = gw * 64 + lane; idx < 8 * 128 * 128; idx += NGW * 64) { const int t = (idx >> 7) & 127, s = idx & 127; wsb[idx] = f2bf(t >= s ? wsrc[idx] : 0.f); }
        float* wsum = (float*)(F.ws + WS_WSUM);
        for (int rid = gw; rid < 8 * 128; rid += NGW) { const int t = rid & 127; float sacc = 0.f;
            for (int s = lane; s < 128; s += 64) sacc += (t >= s) ? bf1(f2bf(wsrc[rid * 128 + s])) : 0.f;
            sacc = wave_sum(sacc); if (lane == 0) wsum[rid] = sacc; }
    }
    if (do_i8) phase_quant_inproj(F, li, vcu, G);
}
__device__ __forceinline__ void thin_gemm16(Frame& F, const bf16* A, const bf16* Wt, float* out) {
    const int gw = F.vcu * NWAVES + F.wave, NGW = F.G * NWAVES, lane = F.lane, fr = lane & 15, fq = lane >> 4;
    for (int rg = gw; rg < T / 16; rg += NGW) {
        const bf16* ap = A + (size_t)(rg * 16 + fr) * 1024 + 8 * fq; const bf16* bp = Wt + (size_t)fr * 1024 + 8 * fq;
        f32x4 acc = {0.f, 0.f, 0.f, 0.f};
#pragma unroll 8
        for (int s = 0; s < 32; ++s) { const bf16x8 a = *(const GAS bf16x8*)(ap + 32 * s), b = *(const GAS bf16x8*)(bp + 32 * s); acc = MFMA16(a, b, acc); }
#pragma unroll
        for (int r = 0; r < 4; ++r) out[(size_t)(rg * 16 + 4 * fq + r) * 16 + fr] = acc[r];
    }
}

__device__ __forceinline__ void ld_row_bf16(const bf16* row, int lane, float (&v)[16]) {
    const GAS v2u* p = (const GAS v2u*)row + lane;
#pragma unroll
    for (int j = 0; j < 4; ++j) { const v2u w = p[64 * j]; v[4 * j] = bflo(w.x); v[4 * j + 1] = bfhi(w.x); v[4 * j + 2] = bflo(w.y); v[4 * j + 3] = bfhi(w.y); }
}
__device__ __forceinline__ void ld_vec_f32(const float* p, int lane, float (&v)[16]) {
    const GAS f32x4* q = (const GAS f32x4*)p + lane;
#pragma unroll
    for (int j = 0; j < 4; ++j) { const f32x4 w = q[64 * j]; v[4 * j] = w.x; v[4 * j + 1] = w.y; v[4 * j + 2] = w.z; v[4 * j + 3] = w.w; }
}
__device__ __forceinline__ void ln16(float (&v)[16], const float (&g)[16], const float (&b)[16]) {
    float s = 0.f;
#pragma unroll
    for (int k = 0; k < 16; ++k) s += v[k];
    const float mean = wave_sum(s) * (1.f / 1024.f); float q = 0.f;
#pragma unroll
    for (int k = 0; k < 16; ++k) { v[k] -= mean; q += v[k] * v[k]; }
    const float rstd = rsqrtf_(wave_sum(q) * (1.f / 1024.f) + LN_EPS);
#pragma unroll
    for (int k = 0; k < 16; ++k) v[k] = v[k] * rstd * g[k] + b[k];
}
__device__ __forceinline__ void st_row_bf16(bf16* row, int lane, const float (&v)[16]) {
    GAS v2u* p = (GAS v2u*)row + lane;
#pragma unroll
    for (int j = 0; j < 4; ++j) { v2u o; o.x = pk2(v[4 * j], v[4 * j + 1]); o.y = pk2(v[4 * j + 2], v[4 * j + 3]); p[64 * j] = o; }
}
__device__ __forceinline__ void phase_init(Frame& F) {
    const int lane = F.lane, gw = F.vcu * NWAVES + F.wave, NGW = F.G * NWAVES;
    bf16* H = (bf16*)(F.ws + WS_H); unsigned char* H8 = F.ws + WS_H8; float* HS = (float*)(F.ws + WS_HS);
    for (int row0 = gw; row0 < T; row0 += 2 * NGW) {
        float v[2][16];
#pragma unroll
        for (int q = 0; q < 2; ++q) { const int row = (row0 + q * NGW < T) ? row0 + q * NGW : row0; ld_vec_f32(F.in[I_X] + (size_t)row * 1024, lane, v[q]); }
#pragma unroll
        for (int q = 0; q < 2; ++q) { const int row = row0 + q * NGW; if (row >= T) break;
            st_row_bf16(H + (size_t)row * 1024, lane, v[q]); st_row_i8(H8 + (size_t)row * 1024, HS + row, lane, v[q]); }
    }
}

__device__ __forceinline__ void phase_ln_mix(Frame& F, int li, const unsigned char* y, const float* ysc, bool use_y) {
    constexpr int WP = 2064;
    LAS unsigned char* wrb = F.lds;
    LAS float* lg_ = (LAS float*)(F.lds + 33792);
    LAS float* lb_ = lg_ + 1024;
    LAS float* tbuf = lb_ + 1024;
    LAS int* lcnt = (LAS int*)(tbuf + 8 * 256);
    LAS int* lbase = lcnt + 16;
    LAS int* rinfo = lcnt + 64;
    LAS float* rw = (LAS float*)(rinfo + 512);
    const int tid = F.tid, lane = F.lane, wave = F.wave, fr = lane & 15, fq = lane >> 4;
    const float* wrg = F.in[I_WR];
    for (int idx = tid; idx < 16384; idx += NTHR) { const int c = idx >> 4, e = idx & 15; *(LAS bf16*)(wrb + e * WP + c * 2) = f2bf(wrg[idx]); }
    for (int idx = tid; idx < 1024; idx += NTHR) { lg_[idx] = F.in[I_LNMG][li * 1024 + idx]; lb_[idx] = F.in[I_LNMB][li * 1024 + idx]; }
    bf16* H = (bf16*)(F.ws + WS_H);
    unsigned* gcnt = F.ctl + CW_CNT + li * 1024;
    int* toke = (int*)(F.ws + WS_TOKE); int* tokp = (int*)(F.ws + WS_TOKP); float* tokw = (float*)(F.ws + WS_TOKW);
    const float* rbg = F.in[I_RB];
    __syncthreads();
    LAS float* gbmax = (LAS float*)(rw + 256);
    if (wave == 0) { float gm = 0.f, bm = 0.f; for (int i = lane; i < 1024; i += 64) { gm = fmaxf(gm, fabsf(lg_[i])); bm = fmaxf(bm, fabsf(lb_[i])); }
#pragma unroll
        for (int o = 1; o < 64; o <<= 1) { gm = fmaxf(gm, __shfl_xor(gm, o)); bm = fmaxf(bm, __shfl_xor(bm, o)); }
        if (lane == 0) { gbmax[0] = gm; gbmax[1] = bm; } }
    __syncthreads();
    for (int rg = F.vcu; rg < T / 128; rg += F.G) {
        if (tid < 16) lcnt[tid] = 0;
        __syncthreads();
        const size_t row = (size_t)rg * 128 + wave * 16 + fr;
        const bf16* hp = H + row * 1024 + 8 * fq; const unsigned char* yp = y + row * 1024 + 8 * fq; const float* ysr = ysc + row * 16;
        float sum = 0.f, sq = 0.f, vmx = -INFINITY, vmn = INFINITY;
#pragma unroll 2
        for (int sc = 0; sc < 8; ++sc) {
            v4u hq[4]; v2u yq[4]; float ys2[2];
#pragma unroll
            for (int k = 0; k < 4; ++k) { hq[k] = *(const GAS v4u*)(hp + 32 * (4 * sc + k)); if (use_y) yq[k] = *(const GAS v2u*)(yp + 32 * (4 * sc + k)); else yq[k] = (v2u){0x80808080u, 0x80808080u}; }
#pragma unroll
            for (int k = 0; k < 2; ++k) ys2[k] = use_y ? *(const GAS float*)(ysr + 2 * sc + k) : 0.f;
#pragma unroll
            for (int k = 0; k < 4; ++k) { const unsigned hw[4] = {hq[k].x, hq[k].y, hq[k].z, hq[k].w}; const float ys = ys2[k >> 1], yc = -128.f * ys;
#pragma unroll
                for (int e = 0; e < 4; ++e) { const unsigned yw = ((e < 2) ? yq[k].x : yq[k].y) ^ 0x80808080u; const int sh = 16 * (e & 1);
                    const float a = fmaf(ys, (float)((yw >> sh) & 255u), fmaf(DN_ALPHA, bflo(hw[e]), yc)), c = fmaf(ys, (float)((yw >> (sh + 8)) & 255u), fmaf(DN_ALPHA, bfhi(hw[e]), yc));
                    sum += a + c; sq += a * a + c * c; vmx = fmaxf(vmx, fmaxf(a, c)); vmn = fminf(vmn, fminf(a, c)); } }
        }
        sum += __shfl_xor(sum, 16); sum += __shfl_xor(sum, 32); sq += __shfl_xor(sq, 16); sq += __shfl_xor(sq, 32);
        vmx = fmaxf(vmx, __shfl_xor(vmx, 16)); vmx = fmaxf(vmx, __shfl_xor(vmx, 32)); vmn = fminf(vmn, __shfl_xor(vmn, 16)); vmn = fminf(vmn, __shfl_xor(vmn, 32));
        const float mean = sum * (1.f / 1024.f); const float rstd = rsqrtf_(fmaxf(sq * (1.f / 1024.f) - mean * mean, 0.f) + LN_EPS);
        const float qmax = fmaxf(vmx - mean, mean - vmn) * rstd * gbmax[0] + gbmax[1]; const float qinv = qmax > 0.f ? 127.f / qmax : 0.f;
        if (fq == 0) ((float*)(F.ws + WS_HS))[row] = qmax * (1.f / 127.f);
        bf16* hrow = H + row * 1024 + 8 * fq; unsigned char* r8 = F.ws + WS_H8 + row * 1024 + 8 * fq;
        f32x4 acc = {0.f, 0.f, 0.f, 0.f};
        v4u hq2[2][4]; v2u yq2[2][4]; float ys22[2][2];
#define LM_LOAD(sc_) do { _Pragma("unroll") for (int k = 0; k < 4; ++k) { hq2[(sc_) & 1][k] = *(const GAS v4u*)(hp + 32 * (4 * (sc_) + k)); if (use_y) yq2[(sc_) & 1][k] = *(const GAS v2u*)(yp + 32 * (4 * (sc_) + k)); else yq2[(sc_) & 1][k] = (v2u){0x80808080u, 0x80808080u}; } \
            _Pragma("unroll") for (int k = 0; k < 2; ++k) ys22[(sc_) & 1][k] = use_y ? *(const GAS float*)(ysr + 2 * (sc_) + k) : 0.f; } while (0)
        LM_LOAD(0);
#pragma unroll
        for (int sc = 0; sc < 8; ++sc) {
            if (sc + 1 < 8) LM_LOAD(sc + 1);
            const v4u (&hq)[4] = hq2[sc & 1]; const v2u (&yq)[4] = yq2[sc & 1];
#pragma unroll
            for (int k = 0; k < 4; ++k) { const int s = 4 * sc + k; const int c0 = 32 * s + 8 * fq;
                const f32x4 g0 = *(const LAS f32x4*)(lg_ + c0), g1 = *(const LAS f32x4*)(lg_ + c0 + 4), b0 = *(const LAS f32x4*)(lb_ + c0), b1 = *(const LAS f32x4*)(lb_ + c0 + 4);
                const float gg[8] = {g0.x, g0.y, g0.z, g0.w, g1.x, g1.y, g1.z, g1.w}, bb[8] = {b0.x, b0.y, b0.z, b0.w, b1.x, b1.y, b1.z, b1.w};
                const unsigned hw[4] = {hq[k].x, hq[k].y, hq[k].z, hq[k].w}; float ov[8]; unsigned ow[4]; const float ys = ys22[sc & 1][k >> 1], yc = -128.f * ys;
#pragma unroll
                for (int e = 0; e < 4; ++e) { const unsigned yw = ((e < 2) ? yq[k].x : yq[k].y) ^ 0x80808080u; const int sh = 16 * (e & 1);
                    const float a = fmaf(ys, (float)((yw >> sh) & 255u), fmaf(DN_ALPHA, bflo(hw[e]), yc)), c = fmaf(ys, (float)((yw >> (sh + 8)) & 255u), fmaf(DN_ALPHA, bfhi(hw[e]), yc));
                    ov[2 * e] = (a - mean) * rstd * gg[2 * e] + bb[2 * e]; ov[2 * e + 1] = (c - mean) * rstd * gg[2 * e + 1] + bb[2 * e + 1]; ow[e] = pk2(ov[2 * e], ov[2 * e + 1]); }
                const v4u o = {ow[0], ow[1], ow[2], ow[3]};
                *(GAS v4u*)(hrow + 32 * s) = o;
                v2u q; q.x = q8x4(ov[0] * qinv, ov[1] * qinv, ov[2] * qinv, ov[3] * qinv); q.y = q8x4(ov[4] * qinv, ov[5] * qinv, ov[6] * qinv, ov[7] * qinv);
                *(GAS v2u*)(r8 + 32 * s) = q;
                const bf16x8 bfrag = *(const LAS bf16x8*)(wrb + fr * WP + c0 * 2);
                acc = MFMA16(__builtin_bit_cast(bf16x8, o), bfrag, acc); }
            __builtin_amdgcn_sched_barrier(0);
        }
#undef LM_LOAD
        LAS float* tb = tbuf + wave * 256;
#pragma unroll
        for (int r = 0; r < 4; ++r) tb[(4 * fq + r) * 16 + fr] = acc[r];
        asm volatile("s_waitcnt lgkmcnt(0)" ::: "memory");
        float lg[16];
        { const LAS f32x4* tp = (const LAS f32x4*)(tb + fr * 16);
#pragma unroll
          for (int q = 0; q < 4; ++q) { const f32x4 t4 = tp[q]; lg[4 * q] = t4.x; lg[4 * q + 1] = t4.y; lg[4 * q + 2] = t4.z; lg[4 * q + 3] = t4.w; } }
        float sc[16], sel[16];
#pragma unroll
        for (int e = 0; e < 16; ++e) { sc[e] = sigmoidf_(lg[e]); sel[e] = sc[e] + rbg[e]; }
        int best = 0; float bestv = -INFINITY;
#pragma unroll
        for (int gq = 0; gq < 4; ++gq) { const float a0 = sel[4 * gq], a1 = sel[4 * gq + 1], a2 = sel[4 * gq + 2], a3 = sel[4 * gq + 3];
            const float mx = fmaxf(fmaxf(a0, a1), fmaxf(a2, a3));
            const float second = fmaxf(fmaxf(fminf(a0, a1), fminf(a2, a3)), fminf(fmaxf(a0, a1), fmaxf(a2, a3)));
            const float gs = mx + second;
            if (gs > bestv) { bestv = gs; best = gq; } }
        float c0v = -INFINITY, c1v = -INFINITY; int e0 = 0, e1 = 0; float s0 = 0.f, s1 = 0.f;
#pragma unroll
        for (int e = 0; e < 16; ++e) { const bool ing = (e >> 2) == best; const float x = sel[e];
            if (ing) { if (x > c0v) { c1v = c0v; e1 = e0; s1 = s0; c0v = x; e0 = e; s0 = sc[e]; } else if (x > c1v) { c1v = x; e1 = e; s1 = sc[e]; } } }
        const float inv = 1.f / (s0 + s1);
        if (lane < 16) { const int lr = wave * 16 + lane;
            const int p0 = __hip_atomic_fetch_add(&lcnt[e0], 1, __ATOMIC_RELAXED, __HIP_MEMORY_SCOPE_WORKGROUP), p1 = __hip_atomic_fetch_add(&lcnt[e1], 1, __ATOMIC_RELAXED, __HIP_MEMORY_SCOPE_WORKGROUP);
            rinfo[lr * 4] = e0; rinfo[lr * 4 + 1] = e1; rinfo[lr * 4 + 2] = p0; rinfo[lr * 4 + 3] = p1; rw[lr * 2] = s0 * inv; rw[lr * 2 + 1] = s1 * inv; }
        __syncthreads();
        if (tid < 16) lbase[tid] = (int)__hip_atomic_fetch_add(gcnt + tid * 64, (unsigned)lcnt[tid], RLX_AGENT);
        __syncthreads();
        if (tid < 128) { const size_t r2 = (size_t)rg * 128 + tid; const int q0 = rinfo[tid * 4], q1 = rinfo[tid * 4 + 1];
            toke[r2 * 2] = q0; toke[r2 * 2 + 1] = q1; tokp[r2 * 2] = lbase[q0] + rinfo[tid * 4 + 2]; tokp[r2 * 2 + 1] = lbase[q1] + rinfo[tid * 4 + 3];
            tokw[r2 * 2] = rw[tid * 2]; tokw[r2 * 2 + 1] = rw[tid * 2 + 1]; }
        __syncthreads();
    }
}
__device__ __forceinline__ void moe_tables(Frame& F, int li) {
    LAS int* seg = (LAS int*)(F.lds + MOE_TAB_OFF); LAS int* cnt = seg + 32;
    unsigned* gcnt = F.ctl + CW_CNT + li * 1024;
    if (F.tid < 16) cnt[F.tid] = (int)__hip_atomic_load(gcnt + F.tid * 64, RLX_AGENT);
    __syncthreads();
    if (F.tid == 0) { int o = 0; for (int e = 0; e < 16; ++e) { seg[e] = o; o += (cnt[e] + 255) & ~255; } seg[16] = o; }
    __syncthreads();
}
__device__ __forceinline__ void phase_gather(Frame& F, int li, unsigned char* Xs8) {
    moe_tables(F, li);
    const LAS int* seg = (const LAS int*)(F.lds + MOE_TAB_OFF); const LAS int* cnt = seg + 32;
    const int lane = F.lane, gw = F.vcu * NWAVES + F.wave, NGW = F.G * NWAVES;
    const int* toke = (const int*)(F.ws + WS_TOKE); const int* tokp = (const int*)(F.ws + WS_TOKP);
    const unsigned char* H8 = F.ws + WS_H8; const float* HS = (const float*)(F.ws + WS_HS); float* XSC = (float*)(F.ws + WS_XSC);
    for (int base = gw; base < 2 * T; base += 64 * NGW) {
        const int myslot = base + lane * NGW; int my_r = 0;
        if (myslot < 2 * T) my_r = seg[toke[myslot]] + tokp[myslot];
        int nk = (2 * T - base + NGW - 1) / NGW; nk = nk > 64 ? 64 : nk;
        for (int k0 = 0; k0 < nk; k0 += 4) {
            v4u d[4]; float ds[4]; int rr[4];
#pragma unroll
            for (int q = 0; q < 4; ++q) { const int k = k0 + q; rr[q] = __shfl(my_r, k < nk ? k : 0); const int slot = base + (k < nk ? k : 0) * NGW;
                const GAS v4u* src = (const GAS v4u*)(H8 + (size_t)(slot >> 1) * 1024); d[q] = src[lane]; ds[q] = HS[slot >> 1]; }
#pragma unroll
            for (int q = 0; q < 4; ++q) if (k0 + q < nk) { GAS v4u* dst = (GAS v4u*)(Xs8 + (size_t)rr[q] * 1024); dst[lane] = d[q]; if (lane == 0) XSC[rr[q]] = ds[q]; }
        }
    }
    for (int pr = gw; pr < 16 * 256; pr += NGW) { const int e = pr >> 8, i = pr & 255; const int r = seg[e] + cnt[e] + i;
        if (r < seg[e + 1]) { GAS v4u* dst = (GAS v4u*)(Xs8 + (size_t)r * 1024); const v4u z = {0u, 0u, 0u, 0u}; dst[lane] = z; if (lane == 0) XSC[r] = 0.f; } }
}
__device__ __forceinline__ void phase_ln_ffn(Frame& F, int li, const unsigned char* Y2, const float* Y2S, bool use_m, bool last) {
    const int lane = F.lane, gw = F.vcu * NWAVES + F.wave, NGW = F.G * NWAVES;
    float g[16], b[16];
    ld_vec_f32(F.in[I_LNFG] + li * 1024, lane, g); ld_vec_f32(F.in[I_LNFB] + li * 1024, lane, b);
    bf16* H = (bf16*)(F.ws + WS_H);
    const int* toke = (const int*)(F.ws + WS_TOKE); const int* tokp = (const int*)(F.ws + WS_TOKP); const float* tokw = (const float*)(F.ws + WS_TOKW);
    if (use_m) moe_tables(F, li);
    const LAS int* seg = (const LAS int*)(F.lds + MOE_TAB_OFF);
    for (int base = gw; base < T; base += 64 * NGW) {
        const int myrow = base + lane * NGW; int my_r0 = 0, my_r1 = 0; float my_w0 = 0.f, my_w1 = 0.f;
        if (use_m && myrow < T) { my_r0 = seg[toke[2 * myrow]] + tokp[2 * myrow]; my_r1 = seg[toke[2 * myrow + 1]] + tokp[2 * myrow + 1]; my_w0 = tokw[2 * myrow]; my_w1 = tokw[2 * myrow + 1]; }
        int nk = (T - base + NGW - 1) / NGW; nk = nk > 64 ? 64 : nk;
        for (int k0 = 0; k0 < nk; k0 += 2) {
            float v[2][16]; unsigned qa[2][4], qc[2][4]; float sa[2][4], sc[2][4]; float w0[2], w1[2]; int rows[2];
#pragma unroll
            for (int q = 0; q < 2; ++q) { const int k = (k0 + q < nk) ? k0 + q : k0; rows[q] = base + k * NGW;
                ld_row_bf16(H + (size_t)rows[q] * 1024, lane, v[q]);
                if (use_m) { const int r0 = __shfl(my_r0, k), r1 = __shfl(my_r1, k); w0[q] = __shfl(my_w0, k); w1[q] = __shfl(my_w1, k);
                    const GAS unsigned* pa = (const GAS unsigned*)(Y2 + (size_t)r0 * 1024) + lane; const GAS unsigned* pc = (const GAS unsigned*)(Y2 + (size_t)r1 * 1024) + lane;
                    const GAS float* sap = (const GAS float*)(Y2S + (size_t)r0 * 16) + (lane >> 4); const GAS float* scp = (const GAS float*)(Y2S + (size_t)r1 * 16) + (lane >> 4);
#pragma unroll
                    for (int j = 0; j < 4; ++j) { qa[q][j] = pa[64 * j]; qc[q][j] = pc[64 * j]; sa[q][j] = sap[4 * j]; sc[q][j] = scp[4 * j]; } } }
#pragma unroll
            for (int q = 0; q < 2; ++q) {
                if (q == 1 && k0 + 1 >= nk) break;
                if (use_m) {
#pragma unroll
                    for (int j = 0; j < 4; ++j) { const float A = w0[q] * sa[q][j], C = w1[q] * sc[q][j], cj = -128.f * (A + C);
                        const unsigned xa = qa[q][j] ^ 0x80808080u, xc = qc[q][j] ^ 0x80808080u;
#pragma unroll
                        for (int i = 0; i < 4; ++i) v[q][4 * j + i] = fmaf(DN_ALPHA, v[q][4 * j + i], cj) + A * (float)((xa >> (8 * i)) & 255u) + C * (float)((xc >> (8 * i)) & 255u); } }
                else {
#pragma unroll
                    for (int k = 0; k < 16; ++k) v[q][k] = DN_ALPHA * v[q][k]; }
                ln16(v[q], g, b);
                if (last) { GAS f32x4* o = (GAS f32x4*)(F.out + (size_t)rows[q] * 1024) + lane;
#pragma unroll
                    for (int jq = 0; jq < 4; ++jq) o[64 * jq] = (f32x4){v[q][4 * jq], v[q][4 * jq + 1], v[q][4 * jq + 2], v[q][4 * jq + 3]}; }
                else { st_row_bf16(H + (size_t)rows[q] * 1024, lane, v[q]); st_row_i8(F.ws + WS_H8 + (size_t)rows[q] * 1024, (float*)(F.ws + WS_HS) + rows[q], lane, v[q]); }
            }
        }
    }
}
namespace pg8 {
struct MoeOrder : StaticOrder {
    const PG8_LAS int* seg; const PG8_LAS int* cnt; size_t estride; const int* rowtok; unsigned rowbytes;
    __device__ __forceinline__ int expert(int pm) const { int e = 0;
#pragma unroll
        for (int q = 1; q < 16; ++q) if (seg[q] <= pm * 256) e = q;
        return e; }
    __device__ __forceinline__ size_t boff(const Unit& u, size_t tstepB) const { return (size_t)expert(u.pm) * estride + (size_t)u.pn * tstepB; }
    __device__ __forceinline__ int token(const Unit& u, int r) const { const int e = expert(u.pm), p = u.pm * 256 - seg[e] + r; return p < cnt[e] ? rowtok[(size_t)e * 32768 + p] : 0; }
    __device__ __forceinline__ unsigned arow_off(const Unit& u, int r) const { return (unsigned)token(u, r) * rowbytes; }
};
struct EpiSwiGLU {
    static constexpr int PERM = 1, AFTER_DRAIN = false; static constexpr int NSTORE = 8;
    bf16_t* O; const float* sa; const float* sb13; MoeOrder S;
    __device__ __forceinline__ void stage_scales(PG8_LAS unsigned char* ldsc, const Unit& u, int lane) const { stage_scales_dma(ldsc, sa + u.pm * BM, sb13 + (size_t)S.expert(u.pm) * 1024 + u.pn * BM, lane); }
    __device__ __forceinline__ void operator()(const f32x4 (&acc)[2][2][4][2], const Unit& u, int wr, int wc, int fr, int fq, const PG8_LAS unsigned char* ldsc) const {
        const int row0 = u.pm * BM + wr * 64 + fr, col0 = u.pn * 128 + wc * 32 + 8 * fq;
        f32x4 s1[2], s3[2]; float srw[2][4];
        { const PG8_LAS float* lr = (const PG8_LAS float*)ldsc + wr * 64 + fr; const PG8_LAS float* lc = (const PG8_LAS float*)(ldsc + 1024) + wc * 32 + 8 * fq;
#pragma unroll
          for (int n = 0; n < 2; ++n) { s1[n] = *(const PG8_LAS f32x4*)(lc + 4 * n); s3[n] = *(const PG8_LAS f32x4*)(lc + HALF + 4 * n); }
#pragma unroll
          for (int ai = 0; ai < 2; ++ai)
#pragma unroll
              for (int m = 0; m < 4; ++m) srw[ai][m] = lr[ai * HALF + m * 16]; }
#pragma unroll
        for (int ai = 0; ai < 2; ++ai)
#pragma unroll
            for (int m = 0; m < 4; ++m) { bf16_t* rowp = O + (size_t)(row0 + ai * HALF + m * 16) * 512 + col0;
                float h[8];
                const float sr = srw[ai][m];
#pragma unroll
                for (int n = 0; n < 2; ++n) { const f32x4 av = dq4(acc[ai][0][m][n], sr, s1[n]), bvv = dq4(acc[ai][1][m][n], sr, s3[n]);
#pragma unroll
                    for (int q = 0; q < 4; ++q) { const float a = av[q], b = bvv[q]; h[4 * n + q] = a * __builtin_amdgcn_rcpf(1.f + __builtin_amdgcn_exp2f(-1.4426950408889634f * a)) * b; } }
                u32x4 w; w.x = cvt_pk_bf16(h[0], h[1]); w.y = cvt_pk_bf16(h[2], h[3]); w.z = cvt_pk_bf16(h[4], h[5]); w.w = cvt_pk_bf16(h[6], h[7]);
                *(u32x4*)rowp = w; }
    }
};
typedef short s16x2 __attribute__((ext_vector_type(2)));
__device__ __forceinline__ unsigned q8n4(const f32x4& x) {
    s16x2 lo = __builtin_amdgcn_cvt_pknorm_i16(x[0], x[1]), hi = __builtin_amdgcn_cvt_pknorm_i16(x[2], x[3]);
    lo = lo + (s16x2){128, 128}; hi = hi + (s16x2){128, 128};
    return __builtin_amdgcn_perm(__builtin_bit_cast(unsigned, hi), __builtin_bit_cast(unsigned, lo), 0x07050301u);
}
struct EpiI8Blk {
    static constexpr int PERM = 2; static constexpr bool AFTER_DRAIN = false; static constexpr int NSTORE = 16;
    unsigned char* O8; float* SC; int ldc; const float* bias; const float* sa = nullptr; const float* sb = nullptr;
    __device__ __forceinline__ void stage_scales(PG8_LAS unsigned char* ldsc, const Unit& u, int lane) const { if (sa) stage_scales_dma(ldsc, sa + u.pm * BM, sb + u.pn * BM, lane); }
    __device__ __forceinline__ void operator()(const f32x4 (&acc)[2][2][4][2], const Unit& u, int wr, int wc, int fr, int fq, const PG8_LAS unsigned char* ldsc) const {
        const int row0 = u.pm * BM + wr * 64 + fr, col0 = u.pn * BM + wc * 64 + 16 * fq, nblk = ldc >> 6, blk = u.pn * 4 + wc;
        f32x4 bv[2][2], scl[2][2]; float srw[2][4];
#pragma unroll
        for (int bj = 0; bj < 2; ++bj)
#pragma unroll
            for (int n = 0; n < 2; ++n) { bv[bj][n] = bias ? *(const f32x4*)(bias + col0 + 8 * bj + 4 * n) : (f32x4){0.f, 0.f, 0.f, 0.f};
                scl[bj][n] = sa ? *(const PG8_LAS f32x4*)((const PG8_LAS float*)(ldsc + 1024) + wc * 64 + 16 * fq + 8 * bj + 4 * n) : (f32x4){1.f, 1.f, 1.f, 1.f}; }
#pragma unroll
        for (int ai = 0; ai < 2; ++ai)
#pragma unroll
            for (int m = 0; m < 4; ++m) srw[ai][m] = sa ? ((const PG8_LAS float*)ldsc)[wr * 64 + fr + ai * HALF + m * 16] : 1.f;
#pragma unroll
        for (int ai = 0; ai < 2; ++ai)
#pragma unroll
            for (int m = 0; m < 4; ++m) { const size_t row = (size_t)(row0 + ai * HALF + m * 16);
                f32x4 v[4]; float mx = 0.f;
#pragma unroll
                for (int bj = 0; bj < 2; ++bj)
#pragma unroll
                    for (int n = 0; n < 2; ++n) { f32x4 t = sa ? dq4(acc[ai][bj][m][n], srw[ai][m], scl[bj][n]) + bv[bj][n] : acc[ai][bj][m][n] + bv[bj][n]; v[2 * bj + n] = t;
                        mx = fmaxf(fmaxf(mx, fmaxf(fabsf(t[0]), fabsf(t[1]))), fmaxf(fabsf(t[2]), fabsf(t[3]))); }
                mx = fmaxf(mx, __shfl_xor(mx, 16)); mx = fmaxf(mx, __shfl_xor(mx, 32)); mx = fmaxf(mx, 1e-30f);
                const float inv = 0.996f * __builtin_amdgcn_rcpf(mx);
                u32x4 w; w.x = q8n4(v[0] * inv); w.y = q8n4(v[1] * inv); w.z = q8n4(v[2] * inv); w.w = q8n4(v[3] * inv);
                *(u32x4*)(O8 + row * ldc + col0) = w;
                if (fq == 0) SC[row * nblk + blk] = mx * (256.f / (0.996f * 32767.f)); }
    }
};
struct EpiSplitHalo {
    static constexpr int PERM = 1, AFTER_DRAIN = false; static constexpr int NSTORE = 16;
    bf16_t* O; size_t split_stride; bf16_t* halo; size_t halo_stride; float scale0; const float* sa; const float* sb;
    __device__ __forceinline__ void stage_scales(PG8_LAS unsigned char* ldsc, const Unit& u, int lane) const { if (sa) stage_scales_dma(ldsc, sa + u.pm * BM, sb + u.pn * BM, lane); }
    __device__ __forceinline__ void operator()(const f32x4 (&acc)[2][2][4][2], const Unit& u, int wr, int wc, int fr, int fq, const PG8_LAS unsigned char* ldsc) const {
        const int row0 = u.pm * BM + wr * 64 + fr; const int t = (u.pn * BM) >> 10; const int colt = (u.pn * BM) & 1023;
        bf16_t* base = O + (size_t)t * split_stride; const int col0 = colt + wc * 32 + 8 * fq; const float sc = (t == 0) ? scale0 : 1.f;
        float srw[2][4]; f32x4 scl[2][2];
        { const PG8_LAS float* lr = (const PG8_LAS float*)ldsc + wr * 64 + fr; const PG8_LAS float* lc = (const PG8_LAS float*)(ldsc + 1024) + wc * 32 + 8 * fq;
#pragma unroll
          for (int ai = 0; ai < 2; ++ai)
#pragma unroll
              for (int m = 0; m < 4; ++m) srw[ai][m] = sa ? lr[ai * HALF + m * 16] * sc : 1.f;
#pragma unroll
          for (int bj = 0; bj < 2; ++bj)
#pragma unroll
              for (int n = 0; n < 2; ++n) scl[bj][n] = sa ? *(const PG8_LAS f32x4*)(lc + bj * HALF + 4 * n) : (f32x4){1.f, 1.f, 1.f, 1.f}; }
#pragma unroll
        for (int ai = 0; ai < 2; ++ai)
#pragma unroll
            for (int m = 0; m < 4; ++m) { const int row = row0 + ai * HALF + m * 16; bf16_t* rowp = base + (size_t)row * 1024 + col0;
#pragma unroll
                for (int bj = 0; bj < 2; ++bj) { f32x4 v0, v1; if (sa) { const float sr = srw[ai][m]; v0 = dq4(acc[ai][bj][m][0], sr, scl[bj][0]); v1 = dq4(acc[ai][bj][m][1], sr, scl[bj][1]); } else { v0 = acc[ai][bj][m][0] * sc; v1 = acc[ai][bj][m][1] * sc; }
                    u32x4 w; w.x = cvt_pk_bf16(v0[0], v0[1]); w.y = cvt_pk_bf16(v0[2], v0[3]); w.z = cvt_pk_bf16(v1[0], v1[1]); w.w = cvt_pk_bf16(v1[2], v1[3]);
                    *(u32x4*)(rowp + bj * HALF) = w;
                    if (halo != nullptr && m == 3 && fr >= 13 && t < 3) *(u32x4*)(halo + (size_t)t * halo_stride + ((size_t)(row >> 6) * 3 + ((row & 63) - 61)) * 1024 + col0 + bj * HALF) = w; } }
    }
};
}

namespace dn {
constexpr int QS = 272, TS = 144;
constexpr int L_QS = 0, L_KS = 17408, L_VS = 34816, L_AT = 52224, L_AN = 61440, L_AD = 70656, L_TB = 74752, L_TAB = 76800, L_CW = 78336, L_RAW = 84480;
}
__device__ __forceinline__ void ld_frag8(const LAS unsigned char* rowp, int c1, float (&x)[8]) {
    const v2u lo = *(const LAS v2u*)(rowp + 2 * c1), hi = *(const LAS v2u*)(rowp + 2 * c1 + 32);
    x[0] = bflo(lo.x); x[1] = bfhi(lo.x); x[2] = bflo(lo.y); x[3] = bfhi(lo.y); x[4] = bflo(hi.x); x[5] = bfhi(hi.x); x[6] = bflo(hi.y); x[7] = bfhi(hi.y);
}
__device__ __forceinline__ v4u pack8(const float (&x)[8]) { v4u o; o.x = pk2(x[0], x[1]); o.y = pk2(x[2], x[3]); o.z = pk2(x[4], x[5]); o.w = pk2(x[6], x[7]); return o; }
__device__ __forceinline__ bf16x8 frag_lohi(v2u lo, v2u hi) { v4u p; p.x = lo.x; p.y = lo.y; p.z = hi.x; p.w = hi.y; return __builtin_bit_cast(bf16x8, p); }
__device__ __forceinline__ v2u pack4(const f32x4& v) { v2u o; o.x = pk2(v[0], v[1]); o.y = pk2(v[2], v[3]); return o; }

__device__ __forceinline__ void phase_delta_local(Frame& F, int j) {
    using namespace dn;
    LAS unsigned char* L = F.lds;
    LAS float* gcs = (LAS float*)(L + L_TAB); LAS float* betas = gcs + 64; LAS float* egs = gcs + 128; LAS float* eks = gcs + 192; LAS float* bscs = gcs + 256;
    LAS float* Ad = (LAS float*)(L + L_AD); LAS float* cwl = (LAS float*)(L + L_CW);
    const int tid = F.tid, lane = F.lane, wave = F.wave, fr = lane & 15, fq = lane >> 4;
    bf16* Qp = (bf16*)(F.ws + WS_R); bf16* Kp = (bf16*)(F.ws + WS_R + TD2); bf16* Vp = (bf16*)(F.ws + WS_R + 2 * TD2);
    bf16* Ub = (bf16*)(F.ws + WS_R + 4 * TD2); bf16* ATb = (bf16*)(F.ws + WS_R + 5 * TD2);
    const bf16* halo = (const bf16*)(F.ws + WS_HALO); const float* AB = (const float*)(F.ws + WS_AB);
    const float* convw = F.in[I_ACONV] + (size_t)j * 4 * 3072; float* EGL = (float*)(F.ws + WS_EGL);
    const int bh = F.vcu >> 3, h = bh & 7, b = bh >> 3;
    if (bh >= 32) return;
    for (int idx = tid; idx < 3 * 4 * 128; idx += NTHR) { const int c = idx & 127, xj = idx >> 7, x = xj >> 2, jj = xj & 3; cwl[idx] = convw[(size_t)jj * 3072 + x * 1024 + h * 128 + c]; }
    const float alog = -__expf(F.in[I_AALOG][j * 8 + h]), dtb = F.in[I_ADT][j * 8 + h];
#define DL_DMA(n_) do { const int ch_ = b * 128 + (n_); const size_t c0_ = (size_t)ch_ * 64; \
        for (int idx = wave; idx < 51; idx += 8) { const int x_ = idx / 17, i_ = idx % 17, ri = 4 * i_ + (lane >> 4); \
            const bf16* X_ = x_ == 0 ? Qp : (x_ == 1 ? Kp : Vp); \
            const bf16* src = (ri >= 3) ? X_ + (c0_ + ri - 3) * 1024 + h * 128 + (lane & 15) * 8 : halo + (size_t)x_ * HALO_T + ((size_t)((n_) > 0 ? ch_ - 1 : ch_) * 3 + ri) * 1024 + h * 128 + (lane & 15) * 8; \
            __builtin_amdgcn_global_load_lds((const unsigned*)src, (LAS unsigned*)(L + L_RAW + x_ * 17408 + i_ * 1024), 16, 0, 0); } } while (0)
#define DL_BAR() do { asm volatile("s_waitcnt lgkmcnt(0)" ::: "memory"); __builtin_amdgcn_s_barrier(); asm volatile("" ::: "memory"); } while (0)
    __syncthreads();
    DL_DMA((F.vcu & 7) * 16);
    for (int k = 0; k < 16; ++k) {
        const int n = (F.vcu & 7) * 16 + k, unit = bh * 128 + n, ch = b * 128 + n; const size_t c0 = (size_t)ch * 64;
        asm volatile("s_waitcnt vmcnt(0)" ::: "memory"); DL_BAR();
#define DL_COMP(XX) do { \
        _Pragma("unroll") for (int ii = 0; ii < 2; ++ii) { const int it = tid + NTHR * ii, r = it >> 4, gq = it & 15; \
            float acc[8] = {0.f, 0.f, 0.f, 0.f, 0.f, 0.f, 0.f, 0.f}; \
            _Pragma("unroll") for (int jj = 0; jj < 4; ++jj) { v4u w = *(const LAS v4u*)(L + L_RAW + (XX) * 17408 + (r + jj) * 256 + gq * 16); if (n == 0 && r + jj < 3) w = (v4u){0u, 0u, 0u, 0u}; \
                const LAS f32x4* cw = (const LAS f32x4*)(cwl + ((XX) * 4 + jj) * 128 + gq * 8); const f32x4 w0 = cw[0], w1 = cw[1]; \
                acc[0] += bflo(w.x) * w0.x; acc[1] += bfhi(w.x) * w0.y; acc[2] += bflo(w.y) * w0.z; acc[3] += bfhi(w.y) * w0.w; \
                acc[4] += bflo(w.z) * w1.x; acc[5] += bfhi(w.z) * w1.y; acc[6] += bflo(w.w) * w1.z; acc[7] += bfhi(w.w) * w1.w; } \
            float ss = 0.f; \
            _Pragma("unroll") for (int e = 0; e < 8; ++e) { acc[e] = siluf_(acc[e]); ss += acc[e] * acc[e]; } \
            if ((XX) < 2) { ss += __shfl_xor(ss, 1); ss += __shfl_xor(ss, 2); ss += __shfl_xor(ss, 4); ss += __shfl_xor(ss, 8); \
                float rs = rsqrtf_(ss + 1e-6f); if ((XX) == 0) rs *= 0.08838834764831845f; \
                _Pragma("unroll") for (int e = 0; e < 8; ++e) acc[e] *= rs; } \
            *(LAS v4u*)(L + ((XX) == 0 ? L_QS : ((XX) == 1 ? L_KS : L_VS)) + r * QS + gq * 16) = pack8(acc); } } while (0)
        float ga = 0.f, gb = 0.f;
        if (wave == 0) { ga = AB[(c0 + lane) * 16 + h]; gb = AB[(c0 + lane) * 16 + 8 + h]; }
        DL_COMP(0); DL_COMP(1); DL_COMP(2);
#undef DL_COMP
        if (wave == 0) {
            const float xs = ga + dtb; const float sp = xs > 20.f ? xs : log1pf(__expf(xs));
            float gi = alog * sp;
#pragma unroll
            for (int o = 1; o < 64; o <<= 1) { const float t = __shfl_up(gi, o); if (lane >= o) gi += t; }
            const float gl = __shfl(gi, 63); const float be = sigmoidf_(gb), eg = __expf(gi);
            gcs[lane] = gi; betas[lane] = be; egs[lane] = eg; eks[lane] = __expf(gl - gi); bscs[lane] = be * eg;
            if (lane == 0) EGL[bh * 128 + n] = __expf(gl);
        }
        DL_BAR();
        if (k + 1 < 16) DL_DMA(n + 1);
#pragma unroll
        for (int tt = 0; tt < 2; ++tt) {
            const int id = 2 * wave + tt, it = id >> 2, jt = id & 3;
            f32x4 kk = {0.f, 0.f, 0.f, 0.f}, qk = {0.f, 0.f, 0.f, 0.f};
            if (jt <= it) {
#pragma unroll
                for (int s = 0; s < 4; ++s) {
                    const bf16x8 bk = *(const LAS bf16x8*)(L + L_KS + (16 * jt + fr) * QS + (32 * s + 8 * fq) * 2);
                    const bf16x8 ak = *(const LAS bf16x8*)(L + L_KS + (16 * it + fr) * QS + (32 * s + 8 * fq) * 2);
                    const bf16x8 aq = *(const LAS bf16x8*)(L + L_QS + (16 * it + fr) * QS + (32 * s + 8 * fq) * 2);
                    kk = MFMA16(ak, bk, kk); qk = MFMA16(aq, bk, qk); } }
            const int jc = 16 * jt + fr; const float gj = gcs[jc];
#pragma unroll
            for (int r = 0; r < 4; ++r) { const int i = 16 * it + 4 * fq + r; const float dec = __expf(fminf(gcs[i] - gj, 0.f));
                const float av = (i > jc) ? betas[i] * kk[r] * dec : 0.f;
                if (it == jt) Ad[it * 256 + (4 * fq + r) * 16 + fr] = av;
                else if (jt < it) *(LAS bf16*)(L + L_AN + i * TS + jc * 2) = f2bf(-av);
                *(LAS bf16*)(L + L_AT + i * TS + jc * 2) = f2bf((i >= jc) ? qk[r] * dec : 0.f); }
        }
        DL_BAR();
        if (wave < 4) {
            const LAS float* A = Ad + wave * 256; float Tr[16];
#pragma unroll
            for (int r = 0; r < 16; ++r) {
                float t0 = (fr == r) ? 1.f : 0.f, t1 = 0.f;
#pragma unroll
                for (int q4 = 0; q4 < (r + 3) / 4; ++q4) { const f32x4 a = *(const LAS f32x4*)(A + r * 16 + 4 * q4);
                    if (4 * q4 + 0 < r) t0 -= a.x * Tr[4 * q4 + 0];
                    if (4 * q4 + 1 < r) t1 -= a.y * Tr[4 * q4 + 1];
                    if (4 * q4 + 2 < r) t0 -= a.z * Tr[4 * q4 + 2];
                    if (4 * q4 + 3 < r) t1 -= a.w * Tr[4 * q4 + 3]; }
                Tr[r] = t0 + t1;
            }
            if (lane < 16) {
#pragma unroll
                for (int r = 0; r < 16; ++r) *(LAS bf16*)(L + L_TB + wave * 512 + r * 32 + lane * 2) = f2bf(Tr[r]); }
        }
        for (int f = (wave + 4) & 7; f < 40; f += 8) {
            float x[8]; GAS v4u* dst;
            if (f < 16) { const int mt = f >> 2, s = f & 3, row = 16 * mt + fr; ld_frag8(L + L_QS + row * QS, 32 * s + 4 * fq, x); const float e = egs[row];
#pragma unroll
                for (int q = 0; q < 8; ++q) x[q] *= e;
                dst = (GAS v4u*)(Qp + (c0 + 4 * f + fq) * 1024 + h * 128 + fr * 8); }
            else if (f < 32) { const int g = f - 16, mt = g >> 1, s = g & 1, d = 16 * mt + fr, c1 = 32 * s + 4 * fq;
#pragma unroll
                for (int q = 0; q < 8; ++q) { const int c = c1 + (q & 3) + 16 * (q >> 2); x[q] = bf1(*(const LAS bf16*)(L + L_KS + c * QS + d * 2)) * eks[c]; }
                dst = (GAS v4u*)(Kp + (c0 + 4 * g + fq) * 1024 + h * 128 + fr * 8); }
            else { const int g = f - 32, mt = g >> 1, s = g & 1, row = 16 * mt + fr; ld_frag8(L + L_AT + row * TS, 32 * s + 4 * fq, x);
                dst = (GAS v4u*)(ATb + ((size_t)unit * 8 + g) * 512 + lane * 8); }
            *dst = pack8(x);
        }
        DL_BAR();
#pragma unroll
        for (int t2 = 0; t2 < 2; ++t2) {
            const int ct = 2 * wave + t2, isw = ct >> 3, nt = ct & 7; const LAS unsigned char* src = L + (isw ? L_KS : L_VS) + (16 * nt + fr) * 2; const LAS float* sc = isw ? bscs : betas;
            v2u X[4];
#pragma unroll
            for (int bb = 0; bb < 4; ++bb) {
                f32x4 acc;
#pragma unroll
                for (int r = 0; r < 4; ++r) { const int row = 16 * bb + 4 * fq + r; acc[r] = bf1(*(const LAS bf16*)(src + row * QS)) * sc[row]; }
#pragma unroll
                for (int s = 0; s < (bb + 1) / 2; ++s) {
                    const LAS unsigned char* ap = L + L_AN + (16 * bb + fr) * TS + (32 * s + 4 * fq) * 2;
                    const v2u alo = *(const LAS v2u*)ap; v2u ahi = {0u, 0u}, xhi = {0u, 0u};
                    if (2 * s + 1 < bb) { ahi = *(const LAS v2u*)(ap + 32); xhi = X[2 * s + 1]; }
                    acc = MFMA16(frag_lohi(alo, ahi), frag_lohi(X[2 * s], xhi), acc); }
                const v2u tlo = *(const LAS v2u*)(L + L_TB + bb * 512 + fr * 32 + fq * 8); const v2u z2 = {0u, 0u};
                const f32x4 zero = {0.f, 0.f, 0.f, 0.f};
                const f32x4 xb = MFMA16(frag_lohi(tlo, z2), frag_lohi(pack4(acc), z2), zero);
                X[bb] = pack4(xb);
                if (!isw) *(GAS v2u*)(Ub + (((size_t)unit * 8 + nt) * 4 + bb) * 256 + lane * 4) = X[bb];
                else {
#pragma unroll
                    for (int r = 0; r < 4; ++r) *(LAS bf16*)(L + L_QS + (16 * bb + 4 * fq + r) * QS + (16 * nt + fr) * 2) = f2bf(xb[r]); }
            }
        }
        DL_BAR();
#pragma unroll
        for (int kf = 0; kf < 2; ++kf) { const int f = wave * 2 + kf, mt = f >> 2, s = f & 3, row = 16 * mt + fr; float x[8]; ld_frag8(L + L_QS + row * QS, 32 * s + 4 * fq, x);
            *(GAS v4u*)(Vp + (c0 + 4 * f + fq) * 1024 + h * 128 + fr * 8) = pack8(x); }
    }
    asm volatile("s_waitcnt vmcnt(0)" ::: "memory"); DL_BAR();
#undef DL_DMA
#undef DL_BAR
}
__device__ __forceinline__ void phase_delta_scan(Frame& F, unsigned long long& pollt) {
    const int lane = F.lane, wave = F.wave, fr = lane & 15, fq = lane >> 4;
    const int bh = F.vcu >> 3, sl = F.vcu & 7, h = bh & 7; const size_t cb = (size_t)(bh >> 3) * SEQ;
    LAS unsigned char* L = F.lds;
    constexpr int SLOT = 59392;
    constexpr int HRING = 2 * SLOT + 256, HENT = 6144, HDEPTH = 4;
    volatile LAS unsigned* flags = (volatile LAS unsigned*)(L + 2 * SLOT);
    if (F.tid < 64) flags[F.tid] = 0u;
    __syncthreads();
    if (bh >= 32) return;
    const bf16* Qp = (const bf16*)(F.ws + WS_R); const bf16* Kp = (const bf16*)(F.ws + WS_R + TD2); const bf16* Vp = (const bf16*)(F.ws + WS_R + 2 * TD2);
    const bf16* Ub = (const bf16*)(F.ws + WS_R + 4 * TD2); const bf16* ATb = (const bf16*)(F.ws + WS_R + 5 * TD2); bf16* Ob = (bf16*)(F.ws + WS_R + 5 * TD2 + 32 * MiB);
#define DS_SPIN(cond) do { unsigned sp_ = 0; while (cond) { __builtin_amdgcn_s_sleep(1); if (++sp_ > (1u << 24)) break; } asm volatile("" ::: "memory"); } while (0)
    if (wave >= 2) {
        const size_t lrow = (size_t)fq * 1024 + h * 128 + fr * 8;
        for (int c = wave - 2; c < 128; c += 6) {
            const size_t r0 = cb + (size_t)c * 64;
            v4u R[56]; v2u U[4];
#pragma unroll
            for (int f = 0; f < 16; ++f) R[f] = *(const GAS v4u*)(Vp + (r0 + 4 * f) * 1024 + lrow);
#pragma unroll
            for (int f = 0; f < 16; ++f) R[16 + f] = *(const GAS v4u*)(Qp + (r0 + 4 * f) * 1024 + lrow);
#pragma unroll
            for (int f = 0; f < 16; ++f) R[32 + f] = *(const GAS v4u*)(Kp + (r0 + 4 * f) * 1024 + lrow);
            const bf16* at = ATb + ((size_t)(bh * 128 + c) * 8) * 512 + lane * 8;
#pragma unroll
            for (int f = 0; f < 8; ++f) R[48 + f] = *(const GAS v4u*)(at + f * 512);
            const bf16* up = Ub + (((size_t)(bh * 128 + c) * 8 + sl) * 4) * 256 + lane * 4;
#pragma unroll
            for (int t = 0; t < 4; ++t) U[t] = *(const GAS v2u*)(up + t * 256);
            LAS unsigned char* d = L + (c & 1) * SLOT + lane * 16;
            if (c >= 2) DS_SPIN(flags[16] < (unsigned)(c - 1));
#pragma unroll
            for (int f = 0; f < 16; ++f) *(LAS v4u*)(d + f * 1024) = R[f];
#pragma unroll
            for (int f = 32; f < 48; ++f) *(LAS v4u*)(d + f * 1024) = R[f];
#pragma unroll
            for (int t = 0; t < 4; ++t) *(LAS v2u*)(L + (c & 1) * SLOT + 57344 + t * 512 + lane * 8) = U[t];
            asm volatile("s_waitcnt lgkmcnt(0)" ::: "memory");
            if (lane == 0) flags[(c & 1) * 8] = (unsigned)(c + 1);
            if (c >= 2) DS_SPIN(flags[24] < (unsigned)(c - 1));
#pragma unroll
            for (int f = 16; f < 32; ++f) *(LAS v4u*)(d + f * 1024) = R[f];
#pragma unroll
            for (int f = 48; f < 56; ++f) *(LAS v4u*)(d + f * 1024) = R[f];
            asm volatile("s_waitcnt lgkmcnt(0)" ::: "memory");
            if (lane == 0) flags[48 + (c & 1) * 8] = (unsigned)(c + 1);
        }
        return;
    }
    if (wave == 1) {
        for (int n = 0; n < 128; ++n) {
            const int slot = n & 1;
            DS_SPIN(flags[32] < (unsigned)(n + 1) || flags[48 + slot * 8] != (unsigned)(n + 1));
            const LAS unsigned char* P = L + slot * SLOT + lane * 16; const LAS unsigned char* Hh = L + HRING + (n & (HDEPTH - 1)) * HENT + lane * 16;
            bf16x8 Sb[4], vb[2], qf[16], af[8];
#pragma unroll
            for (int s = 0; s < 4; ++s) Sb[s] = *(const LAS bf16x8*)(Hh + s * 1024);
#pragma unroll
            for (int s = 0; s < 4; ++s)
#pragma unroll
                for (int t = 0; t < 4; ++t) qf[t * 4 + s] = *(const LAS bf16x8*)(P + 16384 + (t * 4 + s) * 1024);
#pragma unroll
            for (int s = 0; s < 2; ++s) vb[s] = *(const LAS bf16x8*)(Hh + 4096 + s * 1024);
#pragma unroll
            for (int s = 0; s < 2; ++s)
#pragma unroll
                for (int t = 0; t < 4; ++t) af[t * 2 + s] = *(const LAS bf16x8*)(P + 49152 + (t * 2 + s) * 1024);
            __builtin_amdgcn_sched_barrier(0);
            f32x4 qs_[4];
#pragma unroll
            for (int t = 0; t < 4; ++t) qs_[t] = (f32x4){0.f, 0.f, 0.f, 0.f};
#pragma unroll
            for (int s = 0; s < 4; ++s)
#pragma unroll
                for (int t = 0; t < 4; ++t) qs_[t] = MFMA16(Sb[s], qf[t * 4 + s], qs_[t]);
#pragma unroll
            for (int s = 0; s < 2; ++s)
#pragma unroll
                for (int t = 0; t < 4; ++t) qs_[t] = MFMA16(vb[s], af[t * 2 + s], qs_[t]);
            asm volatile("s_waitcnt lgkmcnt(0)" ::: "memory");
            if (lane == 0) { flags[24] = (unsigned)(n + 1); flags[40] = (unsigned)(n + 1); }
#pragma unroll
            for (int t = 0; t < 4; ++t) *(GAS v2u*)(Ob + (cb + (size_t)n * 64 + 16 * t + fr) * 1024 + h * 128 + sl * 16 + 4 * fq) = pack4(qs_[t]);
        }
        return;
    }
    __builtin_amdgcn_s_setprio(3);
    const float* EGL = (const float*)(F.ws + WS_EGL) + bh * 128;
    const float egl_lo = EGL[lane], egl_hi = EGL[64 + lane];
    f32x4 Sa[8];
#pragma unroll
    for (int m = 0; m < 8; ++m) Sa[m] = (f32x4){0.f, 0.f, 0.f, 0.f};
    bf16x8 Sb[4];
#pragma unroll
    for (int s = 0; s < 4; ++s) Sb[s] = (bf16x8){0, 0, 0, 0, 0, 0, 0, 0};
    for (int n = 0; n < 128; ++n) {
        const int slot = n & 1;
        const unsigned long long tp0 = PROBE_MASK ? __builtin_amdgcn_s_memrealtime() : 0ull;
        DS_SPIN(flags[slot * 8] != (unsigned)(n + 1));
        if (n >= HDEPTH) DS_SPIN(flags[40] < (unsigned)(n - HDEPTH + 1));
        if (PROBE_MASK) pollt += __builtin_amdgcn_s_memrealtime() - tp0;
        const LAS unsigned char* P = L + slot * SLOT + lane * 16; LAS unsigned char* Hh = L + HRING + (n & (HDEPTH - 1)) * HENT + lane * 16;
        const float egl = __builtin_bit_cast(float, __builtin_amdgcn_readlane(__builtin_bit_cast(int, n < 64 ? egl_lo : egl_hi), n & 63));
        bf16x8 wf[16], kf[16]; v2u ucur[4];
#pragma unroll
        for (int s = 0; s < 4; ++s)
#pragma unroll
            for (int t = 0; t < 4; ++t) wf[t * 4 + s] = *(const LAS bf16x8*)(P + (t * 4 + s) * 1024);
#pragma unroll
        for (int t = 0; t < 4; ++t) ucur[t] = *(const LAS v2u*)(L + slot * SLOT + 57344 + t * 512 + lane * 8);
#pragma unroll
        for (int s = 0; s < 2; ++s)
#pragma unroll
            for (int m = 0; m < 8; ++m) kf[m * 2 + s] = *(const LAS bf16x8*)(P + 32768 + (m * 2 + s) * 1024);
#pragma unroll
        for (int s = 0; s < 4; ++s) *(LAS bf16x8*)(Hh + s * 1024) = Sb[s];
        __builtin_amdgcn_sched_barrier(0);
        f32x4 ws_[4];
#pragma unroll
        for (int t = 0; t < 4; ++t) ws_[t] = (f32x4){0.f, 0.f, 0.f, 0.f};
#pragma unroll
        for (int s = 0; s < 4; ++s)
#pragma unroll
            for (int t = 0; t < 4; ++t) ws_[t] = MFMA16(wf[t * 4 + s], Sb[s], ws_[t]);
        f32x4 vn[4];
#pragma unroll
        for (int t = 0; t < 4; ++t) { vn[t][0] = bflo(ucur[t].x) - ws_[t][0]; vn[t][1] = bfhi(ucur[t].x) - ws_[t][1]; vn[t][2] = bflo(ucur[t].y) - ws_[t][2]; vn[t][3] = bfhi(ucur[t].y) - ws_[t][3]; }
        bf16x8 vb[2];
#pragma unroll
        for (int s = 0; s < 2; ++s) { vb[s] = frag_lohi(pack4(vn[2 * s]), pack4(vn[2 * s + 1])); *(LAS bf16x8*)(Hh + 4096 + s * 1024) = vb[s]; }
        asm volatile("s_waitcnt lgkmcnt(0)" ::: "memory");
        if (lane == 0) { flags[32] = (unsigned)(n + 1); flags[16] = (unsigned)(n + 1); }
#pragma unroll
        for (int m = 0; m < 8; ++m) Sa[m] = Sa[m] * egl;
#pragma unroll
        for (int s = 0; s < 2; ++s)
#pragma unroll
            for (int m = 0; m < 8; ++m) Sa[m] = MFMA16(kf[m * 2 + s], vb[s], Sa[m]);
#pragma unroll
        for (int s = 0; s < 4; ++s) Sb[s] = frag_lohi(pack4(Sa[2 * s]), pack4(Sa[2 * s + 1]));
    }
    __builtin_amdgcn_s_setprio(0);
#undef DS_SPIN
}
__device__ __forceinline__ void phase_delta_normgate(Frame& F, int j, const bf16* O, const bf16* G, bf16* ON) {
    const int lane = F.lane, gw = F.vcu * NWAVES + F.wave, NGW = F.G * NWAVES;
    float ng[16];
#pragma unroll
    for (int k = 0; k < 16; ++k) ng[k] = F.in[I_ANG][j * 128 + (lane & 7) * 16 + k];
    for (int row0 = gw; row0 < T; row0 += 4 * NGW) {
      v4u po0[4], po1[4], pg0[4], pg1[4];
#pragma unroll
      for (int q = 0; q < 4; ++q) { const int row = (row0 + q * NGW < T) ? row0 + q * NGW : row0; const GAS v4u* op = (const GAS v4u*)(O + (size_t)row * 1024 + lane * 16); const GAS v4u* gp = (const GAS v4u*)(G + (size_t)row * 1024 + lane * 16);
          po0[q] = op[0]; po1[q] = op[1]; pg0[q] = gp[0]; pg1[q] = gp[1]; }
#pragma unroll
      for (int q = 0; q < 4; ++q) { const int row = row0 + q * NGW; if (row >= T) break;
        const v4u o0 = po0[q], o1 = po1[q], g0 = pg0[q], g1 = pg1[q];
        const unsigned ow[8] = {o0.x, o0.y, o0.z, o0.w, o1.x, o1.y, o1.z, o1.w}, gwv[8] = {g0.x, g0.y, g0.z, g0.w, g1.x, g1.y, g1.z, g1.w};
        float v[16], gt[16]; float ss = 0.f;
#pragma unroll
        for (int k = 0; k < 8; ++k) { v[2 * k] = bflo(ow[k]); v[2 * k + 1] = bfhi(ow[k]); gt[2 * k] = bflo(gwv[k]); gt[2 * k + 1] = bfhi(gwv[k]); ss += v[2 * k] * v[2 * k] + v[2 * k + 1] * v[2 * k + 1]; }
        ss += __shfl_xor(ss, 1); ss += __shfl_xor(ss, 2); ss += __shfl_xor(ss, 4);
        const float rs = rsqrtf_(ss * (1.f / 128.f) + LN_EPS);
        float ov[16]; float m = 0.f;
#pragma unroll
        for (int k = 0; k < 16; ++k) { ov[k] = v[k] * rs * ng[k] * siluf_(gt[k]); m = fmaxf(m, fabsf(ov[k])); }
#pragma unroll
        for (int o = 1; o < 64; o <<= 1) m = fmaxf(m, __shfl_xor(m, o));
        const float inv = m > 0.f ? 127.f / m : 0.f;
        *(GAS v4u*)((unsigned char*)ON + (size_t)row * 1024 + lane * 16) = (v4u){q8x4(ov[0] * inv, ov[1] * inv, ov[2] * inv, ov[3] * inv), q8x4(ov[4] * inv, ov[5] * inv, ov[6] * inv, ov[7] * inv), q8x4(ov[8] * inv, ov[9] * inv, ov[10] * inv, ov[11] * inv), q8x4(ov[12] * inv, ov[13] * inv, ov[14] * inv, ov[15] * inv)};
        if (lane == 0) ((float*)(F.ws + WS_ONS))[row] = m * (1.f / 127.f);
      }
    }
}
__device__ __forceinline__ void phase_diff_combine(Frame& F, int j, int li, const bf16* O0, const bf16* O1, bf16* ON) {
    const int lane = F.lane, gw = F.vcu * NWAVES + F.wave, NGW = F.G * NWAVES;
    const float* lam = F.in[I_BLAM] + j * 256;
    float p01 = lam[lane] * lam[64 + lane], p23 = lam[128 + lane] * lam[192 + lane];
    p01 = wave_sum(p01); p23 = wave_sum(p23);
    const float lambda_init = 0.8f - 0.6f * expf(-0.3f * (float)li);
    const float lamf = expf(p01) - expf(p23) + lambda_init, osc = 1.f - lambda_init;
    float ng[16];
#pragma unroll
    for (int k = 0; k < 16; ++k) ng[k] = F.in[I_BNG][j * 128 + (lane & 7) * 16 + k] * osc;
    for (int row0 = gw; row0 < T; row0 += 4 * NGW) {
      v4u pa0[4], pa1[4], pb0[4], pb1[4];
#pragma unroll
      for (int q = 0; q < 4; ++q) { const int row = (row0 + q * NGW < T) ? row0 + q * NGW : row0; const GAS v4u* ap = (const GAS v4u*)(O0 + (size_t)row * 1024 + lane * 16); const GAS v4u* bp = (const GAS v4u*)(O1 + (size_t)row * 1024 + lane * 16);
          pa0[q] = ap[0]; pa1[q] = ap[1]; pb0[q] = bp[0]; pb1[q] = bp[1]; }
#pragma unroll
      for (int q = 0; q < 4; ++q) { const int row = row0 + q * NGW; if (row >= T) break;
        const v4u a0 = pa0[q], a1 = pa1[q], b0 = pb0[q], b1 = pb1[q];
        const unsigned aw[8] = {a0.x, a0.y, a0.z, a0.w, a1.x, a1.y, a1.z, a1.w}, bw[8] = {b0.x, b0.y, b0.z, b0.w, b1.x, b1.y, b1.z, b1.w};
        float v[16]; float ss = 0.f;
#pragma unroll
        for (int k = 0; k < 8; ++k) { v[2 * k] = bflo(aw[k]) - lamf * bflo(bw[k]); v[2 * k + 1] = bfhi(aw[k]) - lamf * bfhi(bw[k]); ss += v[2 * k] * v[2 * k] + v[2 * k + 1] * v[2 * k + 1]; }
        ss += __shfl_xor(ss, 1); ss += __shfl_xor(ss, 2); ss += __shfl_xor(ss, 4);
        const float rs = rsqrtf_(ss * (1.f / 128.f) + LN_EPS);
        float ov[16]; float m = 0.f;
#pragma unroll
        for (int k = 0; k < 16; ++k) { ov[k] = v[k] * rs * ng[k]; m = fmaxf(m, fabsf(ov[k])); }
#pragma unroll
        for (int o = 1; o < 64; o <<= 1) m = fmaxf(m, __shfl_xor(m, o));
        const float inv = m > 0.f ? 127.f / m : 0.f;
        *(GAS v4u*)((unsigned char*)ON + (size_t)row * 1024 + lane * 16) = (v4u){q8x4(ov[0] * inv, ov[1] * inv, ov[2] * inv, ov[3] * inv), q8x4(ov[4] * inv, ov[5] * inv, ov[6] * inv, ov[7] * inv), q8x4(ov[8] * inv, ov[9] * inv, ov[10] * inv, ov[11] * inv), q8x4(ov[12] * inv, ov[13] * inv, ov[14] * inv, ov[15] * inv)};
        if (lane == 0) ((float*)(F.ws + WS_ONS))[row] = m * (1.f / 127.f);
      }
    }
}
__device__ __forceinline__ void phase_gmlp_spatial(Frame& F, int j, const bf16* U, const bf16* V, bf16* UG) {
    LAS unsigned char* L = F.lds;
    constexpr int VT = 272;
    constexpr int L_ST = 69632, L_VN = 70656;
    LAS float* st = (LAS float*)(L + L_ST);
    const int tid = F.tid, lane = F.lane, wave = F.wave, fr = lane & 15, fq = lane >> 4;
    const float* lng = F.in[I_CLNG] + j * 2048; const float* lnb = F.in[I_CLNB] + j * 2048; const float* bs = F.in[I_CBS] + j * 8 * 128;
    const bf16* wsb = (const bf16*)(F.ws + WS_WSB); const float* wsum = (const float*)(F.ws + WS_WSUM);
    for (int unit = F.vcu; unit < T / 128; unit += F.G) {
        const size_t R0 = (size_t)unit * 128;
#define GM_DMA(g_) do { _Pragma("unroll") for (int q = 0; q < 8; ++q) { const int s_ = 16 * wave + 2 * q + (lane >> 5); \
            __builtin_amdgcn_global_load_lds((const unsigned*)(V + (R0 + s_) * 2048 + (g_) * 256 + (((lane & 31) ^ (s_ & 31)) * 8)), (LAS unsigned*)(L + L_VN + (16 * wave + 2 * q) * 512), 16, 0, 0); } } while (0)
        GM_DMA(0);
        for (int i0 = 0; i0 < 16; i0 += 4) {
            v4u raw[4][4];
#pragma unroll
            for (int i = 0; i < 4; ++i) { const GAS v4u* p = (const GAS v4u*)(V + (R0 + wave * 16 + i0 + i) * 2048) + lane;
#pragma unroll
                for (int q = 0; q < 4; ++q) raw[i][q] = p[64 * q]; }
#pragma unroll
            for (int i = 0; i < 4; ++i) { float s = 0.f, s2 = 0.f;
#pragma unroll
                for (int q = 0; q < 4; ++q) { const unsigned ww[4] = {raw[i][q].x, raw[i][q].y, raw[i][q].z, raw[i][q].w};
#pragma unroll
                    for (int e = 0; e < 4; ++e) { const float a = bflo(ww[e]), c2 = bfhi(ww[e]); s += a + c2; s2 += a * a + c2 * c2; } }
                s = wave_sum(s); s2 = wave_sum(s2);
                const float mean = s * (1.f / 2048.f); const float rstd = rsqrtf_(fmaxf(s2 * (1.f / 2048.f) - mean * mean, 0.f) + LN_EPS);
                if (lane == 0) { st[2 * (wave * 16 + i0 + i)] = mean; st[2 * (wave * 16 + i0 + i) + 1] = rstd; } }
        }
        for (int g = 0; g < 8; ++g) {
            bf16x8 af[4];
#pragma unroll
            for (int s = 0; s < 4; ++s) af[s] = *(const GAS bf16x8*)(wsb + ((size_t)g * 128 + 16 * wave + fr) * 128 + 32 * s + 8 * fq);
            float bt[4], wsr[4], gc[16], bc[16];
#pragma unroll
            for (int r = 0; r < 4; ++r) { bt[r] = bs[g * 128 + 16 * wave + 4 * fq + r]; wsr[r] = wsum[g * 128 + 16 * wave + 4 * fq + r]; }
#pragma unroll
            for (int nt = 0; nt < 16; ++nt) { gc[nt] = lng[g * 256 + 16 * nt + fr]; bc[nt] = lnb[g * 256 + 16 * nt + fr]; }
            asm volatile("s_waitcnt vmcnt(0)" ::: "memory");
            __syncthreads();
#pragma unroll 2
            for (int k = 0; k < 8; ++k) { const int it = tid + NTHR * k, s = it & 127, cg = it >> 7;
                const v4u w = *(const LAS v4u*)(L + L_VN + s * 512 + ((cg ^ (s & 31)) * 16)); const unsigned ww[4] = {w.x, w.y, w.z, w.w};
                const float mean = st[2 * s], rstd = st[2 * s + 1];
                LAS unsigned char* tb = L + (cg * 8) * VT + s * 2;
#pragma unroll
                for (int e = 0; e < 4; ++e) { *(LAS bf16*)(tb + (2 * e) * VT) = f2bf((bflo(ww[e]) - mean) * rstd); *(LAS bf16*)(tb + (2 * e + 1) * VT) = f2bf((bfhi(ww[e]) - mean) * rstd); } }
            __syncthreads();
            if (g + 1 < 8) GM_DMA(g + 1);
            f32x4 acc[16];
#pragma unroll
            for (int nt = 0; nt < 16; ++nt) { acc[nt] = (f32x4){0.f, 0.f, 0.f, 0.f};
#pragma unroll
                for (int s = 0; s < 4; ++s) { const bf16x8 bfr = *(const LAS bf16x8*)(L + (16 * nt + fr) * VT + (32 * s + 8 * fq) * 2); acc[nt] = MFMA16(af[s], bfr, acc[nt]); } }
            asm volatile("s_waitcnt lgkmcnt(0)" ::: "memory");
            __builtin_amdgcn_s_barrier();
            asm volatile("" ::: "memory");
#pragma unroll
            for (int nt = 0; nt < 16; ++nt)
#pragma unroll
                for (int r = 0; r < 4; ++r) *(LAS bf16*)(L + (16 * wave + 4 * fq + r) * 528 + (16 * nt + fr) * 2) = f2bf(gc[nt] * acc[nt][r] + bc[nt] * wsr[r] + bt[r]);
            asm volatile("s_waitcnt lgkmcnt(0)" ::: "memory");
            __builtin_amdgcn_s_barrier();
            asm volatile("" ::: "memory");
            v4u uu[8];
#pragma unroll
            for (int k = 0; k < 8; ++k) { const int it = tid + NTHR * k, t = it >> 5, cg = it & 31; uu[k] = *(const GAS v4u*)(U + (R0 + t) * 2048 + g * 256 + cg * 8); }
#pragma unroll
            for (int k = 0; k < 8; ++k) { const int it = tid + NTHR * k, t = it >> 5, cg = it & 31; const size_t go = (R0 + t) * 2048 + g * 256 + cg * 8;
                const v4u m = *(const LAS v4u*)(L + t * 528 + cg * 16); const v4u u = uu[k];
                v4u o; o.x = pk2(bflo(m.x) * bflo(u.x), bfhi(m.x) * bfhi(u.x)); o.y = pk2(bflo(m.y) * bflo(u.y), bfhi(m.y) * bfhi(u.y));
                o.z = pk2(bflo(m.z) * bflo(u.z), bfhi(m.z) * bfhi(u.z)); o.w = pk2(bflo(m.w) * bflo(u.w), bfhi(m.w) * bfhi(u.w));
                *(GAS v4u*)(UG + go) = o; }
        }
        asm volatile("s_waitcnt vmcnt(0) lgkmcnt(0)" ::: "memory");
        __syncthreads();
#undef GM_DMA
    }
}
#ifndef MK_FUSED
#define MK_FUSED 1
#endif
#ifndef MK_ENABLE
#define MK_ENABLE 15
#endif
#ifndef PROBE_MASK
#define PROBE_MASK 0
#endif
#ifndef PROBE_MULT
#define PROBE_MULT 1
#endif
enum { PT_INIT = 0, PT_CONV, PT_GIN, PT_DLOC, PT_DSCAN, PT_DNG, PT_ATTN, PT_COMB, PT_GGELU, PT_GMLP, PT_GOUT, PT_LNMIX, PT_GATH, PT_G1, PT_G2, PT_LNFFN };
#define PB() asm volatile("v_mbcnt_lo_u32_b32 %0, -1, 0\n\tv_mbcnt_hi_u32_b32 %0, -1, %0" : "=v"(F.lane)); F.tid = F.wave * 64 + F.lane; const unsigned long long _t0 = PROBE_MASK ? __builtin_amdgcn_s_memrealtime() : 0ull
#define PE(type) do { if ((PROBE_MASK >> (type)) & 1) pacc += __builtin_amdgcn_s_memrealtime() - _t0; } while (0)
constexpr int PH_PER_LAYER = 16, NPH = 1 + DEPTH * PH_PER_LAYER;
struct Args { const float* in[27]; float* out; unsigned char* ws; int ph_lo, ph_hi; };
__host__ __device__ inline bool phase_valid(int p) {
    if (p == 0) return true;
    const int li = (p - 1) / PH_PER_LAYER, lp = (p - 1) % PH_PER_LAYER, kind = li % 3;
    if (lp == 0) return false;
    if (lp >= 1 && lp <= 5) { if (!((MK_ENABLE >> kind) & 1)) return false; return kind == 0 ? true : (kind == 1 ? lp <= 4 : lp <= 3); }
    if (lp == 8 || lp == 12) return true;
    if (lp >= 9 && lp <= 11) return (MK_ENABLE & 8) != 0;
    return false;
}
#define IN(p) (lo <= (p) && (p) < hi && phase_valid(p))
#define SEAM() do { if (fused) xcd_barrier(bar); } while (0)
#define TAIL_CONVERT(ncol_, li_, i8_, parts_) do { const int nun_ = (__builtin_amdgcn_readfirstlane(((const LAS int*)(F.lds + MOE_TAB_OFF))[16]) >> 8) * (ncol_)  , rem_ = nun_ % F.G, c_ = (int)blockIdx.x; \
        if (c_ >= rem_) { asm volatile("v_mbcnt_lo_u32_b32 %0, -1, 0\n\tv_mbcnt_hi_u32_b32 %0, -1, %0" : "=v"(F.lane)); F.tid = F.wave * 64 + F.lane; phase_convert(F, (li_), (i8_), (parts_), c_ - rem_, F.G - rem_); } } while (0)
template <int LI> __device__ __forceinline__ void layer_body(Frame& F, const XcdBarrier& bar, unsigned char* ldsg, const int lo, const int hi, const bool fused, unsigned long long& pacc) {
    bf16* H = (bf16*)(F.ws + WS_H); bf16* Wm = (bf16*)(F.ws + WS_W); bf16* Wout = Wm + (size_t)4128 * 1024;
    unsigned char* R = F.ws + WS_R;
        constexpr int li = LI, kind = LI % 3, j = LI / 3, pb = 1 + LI * PH_PER_LAYER;
        const bool mix_on = ((MK_ENABLE >> kind) & 1) != 0, moe_on = (MK_ENABLE & 8) != 0;
        unsigned char* Y = R + (kind == 1 ? 0 : 2 * TD2); float* YS = (float*)(Y + 32 * MiB);
        if (kind != 2 && IN(pb + 1)) { PB();
            const int N = (kind == 0) ? 4096 : 3072;
            pg8::Gemm g{(const bf16*)(F.ws + WS_H8), Wm, T, N, D / 2}; pg8::StaticOrder S; S.init(T, N, F.G, (int)blockIdx.x);
            pg8::EpiSplitHalo E{(bf16*)R, (size_t)T * D, kind == 0 ? (bf16*)(F.ws + WS_HALO) : nullptr, HALO_T, kind == 0 ? 1.f : attn_body::C2, (const float*)(F.ws + WS_HS), (const float*)(F.ws + WS_SBW)};
            pg8::gemm_phase<pg8::EpiSplitHalo, pg8::StaticOrder, true, true, true>(F.lds, g, S, E, F.tid);
            if (kind == 0) thin_gemm16(F, H, Wm + (size_t)4096 * 1024, (float*)(F.ws + WS_AB));
            SEAM(); PE(PT_GIN);
        }
        if (kind == 0) {
            if (IN(pb + 2)) { PB(); phase_delta_local(F, j); SEAM(); PE(PT_DLOC); }
            if (IN(pb + 3)) { PB(); unsigned long long pollt = 0ull; phase_delta_scan(F, pollt); SEAM(); PE(PT_DSCAN); if ((PROBE_MASK >> 16) & 1) pacc += pollt; }
            if (IN(pb + 4)) { PB(); phase_delta_normgate(F, j, (const bf16*)(R + 5 * TD2 + 32 * MiB), (const bf16*)(R + 3 * TD2), (bf16*)(R + TD2)); SEAM(); PE(PT_DNG); }
        } else if (kind == 1) {
            if (IN(pb + 2)) { PB();
                const attn_body::AttnTensors AT{(const attn_body::bf16*)R, (const attn_body::bf16*)(R + TD2), (const attn_body::bf16*)(R + 2 * TD2), (attn_body::bf16*)(R + 3 * TD2), (attn_body::bf16*)(R + 4 * TD2), (const float*)(F.ws + WS_LUT)};
                const attn_body::StaticOrder S((int)F.G, (int)blockIdx.x);
                attn_body::attn_phase<attn_body::StaticOrder>((char*)ldsg, AT, S, F.tid);
                SEAM(); PE(PT_ATTN);
            }
            if (IN(pb + 3)) { PB(); phase_diff_combine(F, j, li, (const bf16*)(R + 3 * TD2), (const bf16*)(R + 4 * TD2), (bf16*)(R + 5 * TD2)); SEAM(); PE(PT_COMB); }
        } else {
            if (IN(pb + 1)) { PB();
                pg8::Gemm g{(const bf16*)(F.ws + WS_H8), Wm, T, 4096, D / 2}; pg8::StaticOrder S; S.init(T, 4096, F.G, (int)blockIdx.x);
                pg8::EpiBf16<1> E{(bf16*)R, 2048, nullptr, 2048, (size_t)T * 2048, 1.f, (const float*)(F.ws + WS_HS), (const float*)(F.ws + WS_SBW)};
                pg8::gemm_phase<pg8::EpiBf16<1>, pg8::StaticOrder, true, true, true>(F.lds, g, S, E, F.tid);
                SEAM(); PE(PT_GGELU);
            }
            if (IN(pb + 2)) { PB(); phase_gmlp_spatial(F, j, (const bf16*)R, (const bf16*)(R + 2 * TD2), (bf16*)(R + 4 * TD2)); SEAM(); PE(PT_GMLP); }
        }
        { const int po = pb + (kind == 0 ? 5 : (kind == 1 ? 4 : 3));
          if (IN(po)) { PB();
            const bf16* A = (const bf16*)(R + (kind == 0 ? TD2 : (kind == 1 ? 5 * TD2 : 4 * TD2))); const int K = (kind == 2) ? 2048 : 1024;
            pg8::StaticOrder S; S.init(T, D, F.G, (int)blockIdx.x);
            if constexpr (kind == 2) { pg8::Gemm g{A, Wout, T, D, K}; pg8::EpiI8Blk E{Y, YS, D, nullptr};
                pg8::gemm_phase<pg8::EpiI8Blk, pg8::StaticOrder, true, true>(F.lds, g, S, E, F.tid); }
            else { pg8::Gemm g{A, Wout, T, D, 512}; pg8::EpiI8Blk E{Y, YS, D, nullptr, (const float*)(F.ws + WS_ONS), (const float*)(F.ws + WS_SBO)};
                pg8::gemm_phase<pg8::EpiI8Blk, pg8::StaticOrder, true, true, true>(F.lds, g, S, E, F.tid); }
            SEAM(); PE(PT_GOUT);
          } }
        if (IN(pb + 8)) { PB(); phase_ln_mix(F, li, Y, YS, mix_on); SEAM(); PE(PT_LNMIX); }
        bf16* H1 = (bf16*)(R + 136 * MiB); unsigned char* Y2 = R + 204 * MiB; float* Y2S = (float*)(R + 276 * MiB);
        if (IN(pb + 9)) { PB(); phase_gather(F, li, (unsigned char*)R); SEAM(); PE(PT_GATH); }
        if (IN(pb + 10)) { PB();
            moe_tables(F, li);
            pg8::MoeOrder S; S.seg = (const LAS int*)(F.lds + MOE_TAB_OFF); S.cnt = S.seg + 32; const int nt = __builtin_amdgcn_readfirstlane(S.seg[16]) >> 8;
            S.init(nt * 256, 1024, F.G, (int)blockIdx.x); S.estride = (size_t)1024 * 1024; S.rowtok = nullptr; S.rowbytes = 0u;
            pg8::Gemm g{(const bf16*)R, (const bf16*)(F.ws + WS_W13), nt * 256, 1024, 512};
            pg8::EpiSwiGLU E{H1, (const float*)(F.ws + WS_XSC), (const float*)(F.ws + WS_SB13), S};
            pg8::gemm_phase<pg8::EpiSwiGLU, pg8::MoeOrder, true, true, true>(F.lds, g, S, E, F.tid);
            TAIL_CONVERT(4, li, false, 2); if (li != DEPTH - 1) TAIL_CONVERT(4, li + 1, true, 4);
            SEAM(); PE(PT_G1);
        }
        if (IN(pb + 11)) { PB();
            moe_tables(F, li);
            pg8::MoeOrder S; S.seg = (const LAS int*)(F.lds + MOE_TAB_OFF); S.cnt = S.seg + 32; const int nt = __builtin_amdgcn_readfirstlane(S.seg[16]) >> 8;
            S.init(nt * 256, 1024, F.G, (int)blockIdx.x); S.estride = (size_t)1024 * 512 * 2; S.rowtok = nullptr; S.rowbytes = 0u;
            pg8::Gemm g{H1, (const bf16*)(F.ws + WS_W2), nt * 256, 1024, 512};
            pg8::EpiI8Blk E{Y2, Y2S, D, nullptr};
            pg8::gemm_phase<pg8::EpiI8Blk, pg8::MoeOrder, true, true>(F.lds, g, S, E, F.tid);
            if (li != DEPTH - 1) TAIL_CONVERT(4, li + 1, true, 1);
            SEAM(); PE(PT_G2);
        }
        if (IN(pb + 12)) { PB(); phase_ln_ffn(F, li, Y2, Y2S, moe_on, li == DEPTH - 1); if (li != DEPTH - 1) { SEAM(); } PE(PT_LNFFN); }
}
__global__ void __launch_bounds__(NTHR, 2) mk_fwd(Args args) {
    extern __shared__ __attribute__((aligned(16))) unsigned char lds[];
    Frame F;
    F.lds = (LAS unsigned char*)lds;
    F.wave = __builtin_amdgcn_readfirstlane((int)threadIdx.x >> 6); asm volatile("v_mbcnt_lo_u32_b32 %0, -1, 0\n\tv_mbcnt_hi_u32_b32 %0, -1, %0" : "=v"(F.lane)); F.tid = F.wave * 64 + F.lane;
    F.G = gridDim.x; { const int bx = blockIdx.x; F.vcu = (F.G % 8 == 0) ? (bx % 8) * (F.G / 8) + bx / 8 : bx; }
    F.ws = args.ws; F.ctl = (unsigned*)(args.ws + WS_CTL); F.out = args.out;
#pragma unroll
    for (int i = 0; i < 27; ++i) F.in[i] = args.in[i];
    volatile LAS unsigned* MISC = (volatile LAS unsigned*)(F.lds + MISC_OFF);
    for (int u = F.tid; u < (LDS_BYTES - RING_BYTES) / 4; u += NTHR) ((LAS unsigned*)(F.lds + RING_BYTES))[u] = 0u;
    __syncthreads();
    const int lo = args.ph_lo, hi = args.ph_hi; const bool fused = (hi - lo) > 1;
    XcdBarrier bar; bar.bar = F.ctl + CW_BAR; bar.x = 0; bar.st = nullptr; bar.wave = F.wave;
    if (fused) bar = xcd_barrier_post(F.ctl + CW_BAR, MISC + 8, F.wave);
    bf16* H = (bf16*)(F.ws + WS_H); bf16* Wm = (bf16*)(F.ws + WS_W); bf16* Wout = Wm + (size_t)4128 * 1024;
    unsigned char* R = F.ws + WS_R;

    unsigned long long pacc = 0ull;
    if (IN(0)) { PB(); phase_init(F); phase_colmax_all(F); SEAM(); phase_convert(F, 0, true, 5, F.vcu, F.G); SEAM(); PE(PT_INIT); }
    layer_body<0>(F, bar, lds, lo, hi, fused, pacc);
    layer_body<1>(F, bar, lds, lo, hi, fused, pacc);
    layer_body<2>(F, bar, lds, lo, hi, fused, pacc);
    layer_body<3>(F, bar, lds, lo, hi, fused, pacc);
    if (PROBE_MASK != 0 && blockIdx.x == 0 && F.tid == 0) { const unsigned long long te = __builtin_amdgcn_s_memrealtime(); while (__builtin_amdgcn_s_memrealtime() - te < (unsigned long long)PROBE_MULT * pacc) __builtin_amdgcn_s_sleep(8); }
#undef IN
#undef SEAM
}

extern "C" void kernel_launch(void* const* d_in, const int* in_sizes, int n_in, void* d_out, int out_size, void* d_ws, size_t ws_size, hipStream_t stream) {
    static int grid = 0;
    if (grid == 0) {
        if (n_in != 27 || in_sizes[0] != T * D || out_size != T * D || ws_size < WS_END) { fprintf(stderr, "kernel_launch: unexpected shapes (n_in %d, in0 %d, out %d, ws %zu < %zu); nothing launched\n", n_in, n_in > 0 ? in_sizes[0] : -1, out_size, ws_size, (size_t)WS_END); grid = -1; return; }
        int dev = 0, cus = 0;
        if (hipGetDevice(&dev) != hipSuccess || hipDeviceGetAttribute(&cus, hipDeviceAttributeMultiprocessorCount, dev) != hipSuccess) { grid = -1; return; }
        if (hipFuncSetAttribute((const void*)mk_fwd, hipFuncAttributeMaxDynamicSharedMemorySize, LDS_BYTES) != hipSuccess) { fprintf(stderr, "kernel_launch: hipFuncSetAttribute failed\n"); grid = -1; return; }
        int per_cu = 0;
        if (hipOccupancyMaxActiveBlocksPerMultiprocessor(&per_cu, (const void*)mk_fwd, NTHR, LDS_BYTES) != hipSuccess || per_cu < 1) fprintf(stderr, "kernel_launch: occupancy query reports %d\n", per_cu);
        (void)hipGetLastError();
        grid = cus;
        if (grid != 256) fprintf(stderr, "kernel_launch: %d CUs (built for 256)\n", grid);
    }
    if (grid < 0) return;
    if (hipMemsetAsync((char*)d_ws + WS_CTL, 0, CTL_ZERO_BYTES, stream) != hipSuccess) return;
    Args a{};
    for (int i = 0; i < 27; ++i) a.in[i] = (const float*)d_in[i];
    a.out = (float*)d_out; a.ws = (unsigned char*)d_ws;
#if MK_FUSED
    a.ph_lo = 0; a.ph_hi = NPH;
    hipLaunchKernelGGL(mk_fwd, dim3(grid), dim3(NTHR), LDS_BYTES, stream, a);
#else
    for (int p = 0; p < NPH; ++p) { if (!phase_valid(p)) continue; a.ph_lo = p; a.ph_hi = p + 1; hipLaunchKernelGGL(mk_fwd, dim3(grid), dim3(NTHR), LDS_BYTES, stream, a); }
#endif
}
```
